# Optimizing an MI355X kernel written in HIP

```python
import math
import jax
import jax.numpy as jnp
from jax import lax
import numpy as np

D_MODEL = 4096
BATCH = 1
SEQ = 16384
DEPTH = 2

HEAD_DIM = 128
BLOCK = 128
SUPER_BLOCK = 1024
EPS = 1e-6
A_HEADS = D_MODEL // 512
A_KV_HEADS = max(A_HEADS // 4, 1)
A_GROUP = A_HEADS // A_KV_HEADS
A_WIDTH = A_HEADS * HEAD_DIM
A_KV_WIDTH = A_KV_HEADS * HEAD_DIM
WINDOW = 128
NUM_BUCKETS = 32
MAX_DISTANCE = 128
B_HEADS = D_MODEL // 1024
B_Q_LORA = D_MODEL // 4
B_KV_LORA = 512
B_NOPE_DIM = 128
B_ROPE_DIM = 64
B_V_DIM = 128
B_QK_DIM = B_NOPE_DIM + B_ROPE_DIM
B_WIDTH = B_HEADS * B_V_DIM
ROPE_THETA = 10000.0
C_HEADS = D_MODEL // 1024
C_WIDTH = C_HEADS * HEAD_DIM
IN_SIZES = (A_WIDTH, A_KV_WIDTH, A_KV_WIDTH, A_WIDTH,
            B_Q_LORA, B_KV_LORA, B_ROPE_DIM, B_WIDTH,
            C_WIDTH, C_WIDTH, C_WIDTH, C_WIDTH,
            D_MODEL, D_MODEL, D_MODEL)
IN_COLS = sum(IN_SIZES)

kernel_name = "hybrid_swa_mla_stickbreaking_block"


def rms_norm(x, g):
    xf = x.astype(jnp.float32)
    y = xf * lax.rsqrt(jnp.mean(xf * xf, axis=-1, keepdims=True) + EPS)
    return (y * g.astype(jnp.float32)).astype(x.dtype)


def t5_bucket(rel):
    n = jnp.maximum(rel, 0)
    max_exact = NUM_BUCKETS // 2
    logn = jnp.log(jnp.maximum(n, 1).astype(jnp.float32) / max_exact)
    large = max_exact + (logn / math.log(MAX_DISTANCE / max_exact) * (NUM_BUCKETS - max_exact)).astype(jnp.int32)
    large = jnp.minimum(large, NUM_BUCKETS - 1)
    return jnp.where(n < max_exact, n, large)


def swa_bias_and_mask(rel_bias, n_blocks):
    t = jnp.arange(BLOCK)[:, None]
    s = jnp.arange(2 * BLOCK)[None, :]
    rel = BLOCK + t - s
    bias = rel_bias[t5_bucket(rel)]
    bias = bias.reshape(BLOCK, 2 * BLOCK, A_KV_HEADS, A_GROUP).transpose(2, 3, 0, 1)
    key_abs = jnp.arange(n_blocks)[:, None, None] * BLOCK + s[None] - BLOCK
    mask = (rel >= 0)[None] & (rel < WINDOW)[None] & (key_abs >= 0)
    return bias, mask


def swa_sink_attention(q, k, v, sinks, bias, mask):
    B, S, HQ, D = q.shape
    nb = S // BLOCK
    qb = q.reshape(B, nb, BLOCK, A_KV_HEADS, A_GROUP, D)

    def band(t):
        tb = t.reshape(B, nb, BLOCK, A_KV_HEADS, D)
        prev = jnp.concatenate([jnp.zeros_like(tb[:, :1]), tb[:, :-1]], axis=1)
        return jnp.concatenate([prev, tb], axis=2)

    kk, vv = band(k), band(v)
    s = jnp.einsum('bnqhgd,bnkhd->bnhgqk', qb, kk).astype(jnp.float32) * (D ** -0.5)
    s = s + bias.astype(jnp.float32)
    s = jnp.where(mask[None, :, None, None], s, -jnp.inf)
    sink = sinks.astype(jnp.float32).reshape(A_KV_HEADS, A_GROUP)[:, :, None, None]
    sink = jnp.broadcast_to(sink, s.shape[:-1] + (1,))
    p = jax.nn.softmax(jnp.concatenate([s, sink], axis=-1), axis=-1)[..., :-1]
    out = jnp.einsum('bnhgqk,bnkhd->bnqhgd', p.astype(v.dtype), vv)
    return out.reshape(B, S, HQ, D)


def rope_tables(seq):
    pos = jnp.arange(seq, dtype=jnp.float32)
    inv = ROPE_THETA ** (-jnp.arange(0, B_ROPE_DIM, 2, dtype=jnp.float32) / B_ROPE_DIM)
    ang = pos[:, None] * inv[None, :]
    return jnp.cos(ang), jnp.sin(ang)


def apply_rope(x, cos, sin):
    half = x.shape[-1] // 2
    x1, x2 = x[..., :half], x[..., half:]
    c, s = cos.astype(x.dtype), sin.astype(x.dtype)
    return jnp.concatenate([x1 * c - x2 * s, x2 * c + x1 * s], axis=-1)


def to_blocks(t, start, end):
    B = t.shape[0]
    n = (end - start) // BLOCK
    return t[:, start:end].reshape(B, n, BLOCK, *t.shape[2:]).transpose(1, 0, 2, 3, 4)


def from_blocks(t):
    n, B = t.shape[0], t.shape[1]
    return t.transpose(1, 0, 2, 3, 4).reshape(B, n * BLOCK, *t.shape[3:])


def mla_attention(q_nope, q_rope, k_nope, k_rope, v):
    S = q_nope.shape[1]
    scale = B_QK_DIM ** -0.5
    outs = []
    for start in range(0, S, SUPER_BLOCK):
        end = min(start + SUPER_BLOCK, S)
        kn, kr, vv = k_nope[:, :end], k_rope[:, :end], v[:, :end]
        key_pos = jnp.arange(end)
        n = (end - start) // BLOCK

        def one_block(args, kn=kn, kr=kr, vv=vv, key_pos=key_pos, start=start):
            i, qn_b, qr_b = args
            s = (jnp.einsum('bqhd,bkhd->bhqk', qn_b, kn)
                 + jnp.einsum('bqhd,bkd->bhqk', qr_b, kr)).astype(jnp.float32) * scale
            q_pos = start + i * BLOCK + jnp.arange(BLOCK)
            s = jnp.where(key_pos[None, :] <= q_pos[:, None], s, -jnp.inf)
            p = jax.nn.softmax(s, axis=-1)
            return jnp.einsum('bhqk,bkhd->bqhd', p.astype(vv.dtype), vv)

        out = lax.map(one_block, (jnp.arange(n), to_blocks(q_nope, start, end), to_blocks(q_rope, start, end)))
        outs.append(from_blocks(out))
    return jnp.concatenate(outs, axis=1)


def stick_breaking_attention(q, k, v):
    B, S, H, D = q.shape
    scale = D ** -0.5
    outs = []
    for start in range(0, S, SUPER_BLOCK):
        end = min(start + SUPER_BLOCK, S)
        kk, vv = k[:, :end], v[:, :end]
        key_pos = jnp.arange(end)
        n = (end - start) // BLOCK
        n_kb = end // BLOCK

        def one_block(args, kk=kk, vv=vv, key_pos=key_pos, start=start, n_kb=n_kb):
            i, q_blk = args
            z = jnp.einsum('bqhd,bkhd->bhqk', q_blk, kk).astype(jnp.float32) * scale
            q_pos = start + i * BLOCK + jnp.arange(BLOCK)
            past = key_pos[None, :] < q_pos[:, None]
            log_keep = jnp.where(past, jax.nn.log_sigmoid(-z), 0.0)
            lk = log_keep.reshape(z.shape[:-1] + (n_kb, BLOCK))
            within = lax.cumsum(lk, axis=lk.ndim - 1, reverse=True) - lk
            tot = jnp.sum(lk, axis=-1)
            offset = lax.cumsum(tot, axis=tot.ndim - 1, reverse=True) - tot
            log_between = (within + offset[..., None]).reshape(z.shape)
            w = jnp.where(past, jnp.exp(jax.nn.log_sigmoid(z) + log_between), 0.0)
            return jnp.einsum('bhqk,bkhd->bqhd', w.astype(vv.dtype), vv)

        out = lax.map(one_block, (jnp.arange(n), to_blocks(q, start, end)))
        outs.append(from_blocks(out))
    return jnp.concatenate(outs, axis=1)


def setup_inputs(seed: int = 0) -> dict:
    key = jax.random.key(seed)
    ks = jax.random.split(key, 16)
    f32 = jnp.float32
    nrm = lambda k, shape, scale: jax.random.normal(k, shape, f32) * scale
    gain = lambda k, shape: 1.0 + 0.02 * jax.random.normal(k, shape, f32)
    return {
        "x": nrm(ks[0], (BATCH, SEQ, D_MODEL), 1.0),
        "norm_g": gain(ks[1], (DEPTH, D_MODEL)),
        "w_in": nrm(ks[2], (DEPTH, D_MODEL, IN_COLS), D_MODEL ** -0.5),
        "attn_sinks": nrm(ks[3], (DEPTH, A_HEADS), 0.5),
        "rel_bias": nrm(ks[4], (NUM_BUCKETS, A_HEADS), 0.5),
        "g_q_lora": gain(ks[5], (DEPTH, B_Q_LORA)),
        "w_q_up": nrm(ks[6], (DEPTH, B_Q_LORA, B_HEADS * B_QK_DIM), B_Q_LORA ** -0.5),
        "g_kv_lora": gain(ks[7], (DEPTH, B_KV_LORA)),
        "w_kv_up": nrm(ks[8], (DEPTH, B_KV_LORA, B_HEADS * (B_NOPE_DIM + B_V_DIM)), B_KV_LORA ** -0.5),
        "w_proj_a": nrm(ks[9], (DEPTH, A_WIDTH, D_MODEL), A_WIDTH ** -0.5),
        "w_proj_b": nrm(ks[10], (DEPTH, B_WIDTH, D_MODEL), B_WIDTH ** -0.5),
        "w_proj_c": nrm(ks[11], (DEPTH, C_WIDTH, D_MODEL), C_WIDTH ** -0.5),
        "w_out": nrm(ks[12], (DEPTH, D_MODEL, D_MODEL), D_MODEL ** -0.5),
        "final_g": gain(ks[13], (D_MODEL,)),
    }


def reference(x, norm_g, w_in, attn_sinks, rel_bias, g_q_lora, w_q_up, g_kv_lora, w_kv_up,
              w_proj_a, w_proj_b, w_proj_c, w_out, final_g):
    B, S, _ = x.shape
    nb = S // BLOCK
    split_points = np.cumsum(IN_SIZES)[:-1].tolist()
    swa_bias, swa_mask = swa_bias_and_mask(rel_bias, nb)
    cos, sin = rope_tables(S)

    for l in range(DEPTH):
        h = rms_norm(x, norm_g[l])
        p = jnp.einsum('bsd,de->bse', h, w_in[l])
        (qa, ka, va, za, cq, ckv, kr, zb, qc, kc, vc, zc, ga, gb, gc) = jnp.split(p, split_points, axis=-1)

        ya = swa_sink_attention(qa.reshape(B, S, A_HEADS, HEAD_DIM),
                                ka.reshape(B, S, A_KV_HEADS, HEAD_DIM),
                                va.reshape(B, S, A_KV_HEADS, HEAD_DIM),
                                attn_sinks[l], swa_bias, swa_mask)
        ya = ya.reshape(B, S, A_WIDTH) * jax.nn.silu(za)

        q = (rms_norm(cq, g_q_lora[l]) @ w_q_up[l]).reshape(B, S, B_HEADS, B_QK_DIM)
        q_nope = q[..., :B_NOPE_DIM]
        q_rope = apply_rope(q[..., B_NOPE_DIM:], cos[:, None, :], sin[:, None, :])
        kv = (rms_norm(ckv, g_kv_lora[l]) @ w_kv_up[l]).reshape(B, S, B_HEADS, B_NOPE_DIM + B_V_DIM)
        k_nope, vb = kv[..., :B_NOPE_DIM], kv[..., B_NOPE_DIM:]
        k_rope = apply_rope(kr, cos, sin)
        yb = mla_attention(q_nope, q_rope, k_nope, k_rope, vb)
        yb = yb.reshape(B, S, B_WIDTH) * jax.nn.silu(zb)

        yc = stick_breaking_attention(qc.reshape(B, S, C_HEADS, HEAD_DIM),
                                      kc.reshape(B, S, C_HEADS, HEAD_DIM),
                                      vc.reshape(B, S, C_HEADS, HEAD_DIM))
        yc = yc.reshape(B, S, C_WIDTH) * jax.nn.silu(zc)

        merged = (jax.nn.sigmoid(ga) * (ya @ w_proj_a[l])
                  + jax.nn.sigmoid(gb) * (yb @ w_proj_b[l])
                  + jax.nn.sigmoid(gc) * (yc @ w_proj_c[l]))
        x = x + merged @ w_out[l]

    return rms_norm(x, final_g)
```

```cpp
#include <hip/hip_runtime.h>
#include <cstdio>
#include <cstdint>

#ifndef MK_PER_PHASE
#define MK_PER_PHASE 0
#endif
#ifndef ATTN_MFMA_MASK
#define ATTN_MFMA_MASK 7
#endif

namespace pg8 {
#define PG8_LAS __attribute__((address_space(3)))
typedef unsigned short bf16_t;
typedef short bf16x8 __attribute__((ext_vector_type(8)));
typedef float f32x4 __attribute__((ext_vector_type(4)));
typedef float f32x2 __attribute__((ext_vector_type(2)));
typedef unsigned u32x4 __attribute__((ext_vector_type(4)));
typedef unsigned u32x2 __attribute__((ext_vector_type(2)));
typedef int i32x4 __attribute__((ext_vector_type(4)));
constexpr int BM = 256, BK = 64, HALF = 128, HTB = HALF * BK * 2, STAGE_BYTES = 8 * HTB, NXCD = 8, WGM = 8;

__host__ __device__ __forceinline__ int lds_byte(int r, int c) { const int st = (r >> 4) * 2 + (c >> 5), rr = r & 15, cc = c & 31, ob = rr * 64 + cc * 2; return st * 1024 + (ob ^ (((ob >> 9) & 1) << 5)); }
__host__ __device__ __forceinline__ void stage_rc(int b, int& R, int& C) { const int st = b / 1024, sb = b % 1024, swz = sb ^ (((sb >> 9) & 1) << 5); R = (st >> 1) * 16 + swz / 64; C = (st & 1) * 32 + (swz % 64) / 2; }
__host__ __device__ __forceinline__ int perm32(int rho) { const int n = rho >> 4, i = rho & 15; return 8 * (i >> 2) + 4 * n + (i & 3); }

struct Unit { int pm, pn; };
struct Gemm { const bf16_t* A; const bf16_t* Bt; int M, N, K, lda, ldb; };

struct StaticOrder {
    int nM, nN, nwg, G, c;
    __host__ __device__ void init(int M, int N, int G_, int c_) { nM = M / BM; nN = N / BM; nwg = nM * nN; G = G_; c = c_; }
    __host__ __device__ bool next(int i, Unit& u) const {
        const long L = (long)i * G + c; if (L >= nwg) return false;
        int wgid = (int)L; { const int q = nwg / NXCD, r = nwg % NXCD, xcd = wgid % NXCD, off = wgid / NXCD; wgid = (xcd < r ? xcd * (q + 1) : r * (q + 1) + (xcd - r) * q) + off; }
        const int nig = WGM * nN, gid = wgid / nig, fm = gid * WGM, gsz = (nM - fm) < WGM ? (nM - fm) : WGM;
        u.pm = fm + ((wgid % nig) % gsz); u.pn = (wgid % nig) / gsz; return true;
    }
    __device__ __forceinline__ void a_ready(const Unit&) const {}
    __device__ __forceinline__ void done(const Unit&) const {}
};

__device__ __forceinline__ unsigned cvt_pk_bf16(float lo, float hi) { unsigned r; asm volatile("v_cvt_pk_bf16_f32 %0, %1, %2" : "=v"(r) : "v"(lo), "v"(hi)); return r; }
__device__ __forceinline__ unsigned cvt_pk_f16(float lo, float hi) { typedef _Float16 h2 __attribute__((ext_vector_type(2))); h2 v; v.x = (_Float16)lo; v.y = (_Float16)hi; return __builtin_bit_cast(unsigned, v); }
__device__ __forceinline__ float bf_lo(unsigned w) { return __uint_as_float(w << 16); }
__device__ __forceinline__ float bf_hi(unsigned w) { return __uint_as_float(w & 0xffff0000u); }

__device__ __forceinline__ f32x4 mma16(bf16x8 b, bf16x8 a, f32x4 c) { return __builtin_amdgcn_mfma_f32_16x16x32_bf16(b, a, c, 0, 0, 0); }
__device__ __forceinline__ i32x4 mma16(bf16x8 b, bf16x8 a, i32x4 c) { return __builtin_amdgcn_mfma_i32_16x16x64_i8(__builtin_bit_cast(i32x4, b), __builtin_bit_cast(i32x4, a), c, 0, 0, 0); }
template <class Epi, class Sched, bool ALIGN_EPI = false, bool SP2 = false>
__device__ __forceinline__ void gemm_phase(PG8_LAS unsigned char* lds, const Gemm g, const Sched& S, const Epi& E) {
    int tid = threadIdx.x; asm volatile("" : "+v"(tid));
    const int wid = __builtin_amdgcn_readfirstlane(tid >> 6), lane = tid & 63, wr = wid >> 2, wc = wid & 3, fr = lane & 15, fq = lane >> 4;
    const int K = g.K, nt = K / BK;
    unsigned voffA[2], voffB[2];
#pragma unroll
    for (int i = 0; i < 2; ++i) { int R, C; stage_rc(tid * 16 + i * 8192, R, C); const int Rb = Epi::PERM ? ((R & ~31) + perm32(R & 31)) : R;
        voffA[i] = (unsigned)(R * g.lda + C) * 2u; voffB[i] = (unsigned)(Rb * g.ldb + C) * 2u; }
    const size_t kstep = (size_t)(BK * 2);
    const size_t hstepA = (size_t)HALF * g.lda * 2, hstepB = (size_t)HALF * g.ldb * 2;
    const size_t tstepA = 2 * hstepA, tstepB = 2 * hstepB;
    const unsigned ldsw = (unsigned)wid * 1024u;
    const int aoff = lds_byte(wr * 64 + fr, fq * 8), boff = lds_byte(wc * 32 + fr, fq * 8);
#define PG8_SA(b, h) (((b) * 2 + (h)) * HTB)
#define PG8_SB(b, h) ((4 + (b) * 2 + (h)) * HTB)
#define PG8_STAGE(bufoff, gbase, voff) do { _Pragma("unroll") for (int _i = 0; _i < 2; ++_i) \
        __builtin_amdgcn_global_load_lds((const unsigned*)((const char*)(gbase) + (voff)[_i]), (PG8_LAS unsigned*)(lds + (bufoff) + ldsw + _i * 8192), 16, 0, 0); } while (0)
#define PG8_LDA(dst, b, h) do { _Pragma("unroll") for (int m = 0; m < 4; ++m) _Pragma("unroll") for (int k = 0; k < 2; ++k) dst[m][k] = *(const PG8_LAS bf16x8*)(lds + PG8_SA(b, h) + aoff + m * 2048 + k * 1024); } while (0)
#define PG8_LDB(dst, b, h) do { _Pragma("unroll") for (int n = 0; n < 2; ++n) _Pragma("unroll") for (int k = 0; k < 2; ++k) dst[n][k] = *(const PG8_LAS bf16x8*)(lds + PG8_SB(b, h) + boff + n * 2048 + k * 1024); } while (0)
#define PG8_MMA(ai, bj, At, Bt) do { __builtin_amdgcn_s_setprio(1); _Pragma("unroll") for (int m = 0; m < 4; ++m) _Pragma("unroll") for (int n = 0; n < 2; ++n) _Pragma("unroll") for (int k = 0; k < 2; ++k) \
        acc[ai][bj][m][n] = mma16(Bt[n][k], At[m][k], acc[ai][bj][m][n]); __builtin_amdgcn_s_setprio(0); } while (0)
#define PG8_WAIT_V(n) asm volatile("s_waitcnt vmcnt(" #n ")" ::: "memory")
#define PG8_WAIT_L(n) asm volatile("s_waitcnt lgkmcnt(" #n ")" ::: "memory")
#define PG8_BAR __builtin_amdgcn_s_barrier()
#define PG8_SCHED __builtin_amdgcn_sched_barrier(0)
    Unit cur, nxt; int ui = 0;
    if (!S.next(0, cur)) return;
    typedef typename Epi::acc_t acc_t;
    acc_t acc[2][2][4][2];
#pragma unroll
    for (int a = 0; a < 2; ++a)
#pragma unroll
        for (int b = 0; b < 2; ++b)
#pragma unroll
            for (int m = 0; m < 4; ++m)
#pragma unroll
                for (int n = 0; n < 2; ++n) acc[a][b][m][n] = (acc_t){0, 0, 0, 0};
    bf16x8 At[4][2], B0[2][2], B1[2][2];
    const char* cA = (const char*)g.A + (size_t)cur.pm * tstepA; const char* cB = (const char*)g.Bt + (size_t)cur.pn * tstepB;
    S.a_ready(cur);
    if constexpr (SP2) {
        PG8_STAGE(PG8_SB(0, 0), cB, voffB); PG8_STAGE(PG8_SB(0, 1), cB + hstepB, voffB); PG8_STAGE(PG8_SA(0, 0), cA, voffA); PG8_STAGE(PG8_SA(0, 1), cA + hstepA, voffA);
        if (wr == 1) PG8_BAR;
        PG8_WAIT_V(2); PG8_BAR;
        PG8_STAGE(PG8_SB(1, 0), cB + kstep, voffB); PG8_STAGE(PG8_SA(1, 0), cA + kstep, voffA); PG8_STAGE(PG8_SB(1, 1), cB + hstepB + kstep, voffB);
        PG8_WAIT_V(6); PG8_BAR;
    } else {
        PG8_STAGE(PG8_SB(0, 0), cB, voffB); PG8_STAGE(PG8_SA(0, 0), cA, voffA); PG8_STAGE(PG8_SB(0, 1), cB + hstepB, voffB); PG8_STAGE(PG8_SA(0, 1), cA + hstepA, voffA);
        if (wr == 1) PG8_BAR;
        PG8_WAIT_V(4); PG8_BAR;
        PG8_STAGE(PG8_SB(1, 0), cB + kstep, voffB); PG8_STAGE(PG8_SA(1, 0), cA + kstep, voffA); PG8_STAGE(PG8_SB(1, 1), cB + hstepB + kstep, voffB);
        PG8_WAIT_V(6); PG8_BAR;
    }
    for (;;) {
        const bool has_next = S.next(ui + 1, nxt);
        const char* nA = has_next ? (const char*)g.A + (size_t)nxt.pm * tstepA : cA; const char* nB = has_next ? (const char*)g.Bt + (size_t)nxt.pn * tstepB : cB;
        for (int t = 0; t < nt; t += 2) {
            const bool last = (t == nt - 2);
            const char* a1 = cA + (size_t)(t + 1) * kstep;
            const char* a2 = last ? nA : cA + (size_t)(t + 2) * kstep; const char* b2 = last ? nB : cB + (size_t)(t + 2) * kstep;
            const char* a3 = a2 + kstep; const char* b3 = b2 + kstep;
            if (last && has_next) S.a_ready(nxt);
            if constexpr (Epi::MID) { if (t == E.t1 || t == E.t2) E.mid(acc, cur, t == E.t2, wr, wc, fr, fq); }
            if constexpr (SP2) {
            PG8_LDB(B0, 0, 0); PG8_LDB(B1, 0, 1); PG8_SCHED; PG8_LDA(At, 0, 0); PG8_STAGE(PG8_SA(1, 1), a1 + hstepA, voffA);
            PG8_WAIT_V(8); PG8_WAIT_L(0); PG8_BAR; PG8_MMA(0, 0, At, B0); PG8_MMA(0, 1, At, B1); PG8_BAR; PG8_SCHED;
            PG8_LDA(At, 0, 1); PG8_STAGE(PG8_SB(0, 0), b2, voffB); PG8_STAGE(PG8_SB(0, 1), b2 + hstepB, voffB); PG8_STAGE(PG8_SA(0, 0), a2, voffA);
            PG8_WAIT_V(8); PG8_WAIT_L(0); PG8_BAR; PG8_MMA(1, 0, At, B0); PG8_MMA(1, 1, At, B1); PG8_BAR; PG8_SCHED;
            PG8_LDB(B0, 1, 0); PG8_LDB(B1, 1, 1); PG8_SCHED; PG8_LDA(At, 1, 0); PG8_STAGE(PG8_SA(0, 1), a2 + hstepA, voffA);
            PG8_WAIT_V(8); PG8_WAIT_L(0); PG8_BAR; PG8_MMA(0, 0, At, B0); PG8_MMA(0, 1, At, B1); PG8_BAR; PG8_SCHED;
            PG8_LDA(At, 1, 1); PG8_STAGE(PG8_SB(1, 0), b3, voffB); PG8_STAGE(PG8_SB(1, 1), b3 + hstepB, voffB); PG8_STAGE(PG8_SA(1, 0), a3, voffA);
            PG8_WAIT_V(8); PG8_WAIT_L(0); PG8_BAR; PG8_MMA(1, 0, At, B0); PG8_MMA(1, 1, At, B1); PG8_BAR; PG8_SCHED;
            } else {
            PG8_LDB(B0, 0, 0); PG8_SCHED; PG8_LDA(At, 0, 0); PG8_STAGE(PG8_SA(1, 1), a1 + hstepA, voffA);
            PG8_WAIT_L(8); PG8_BAR; PG8_WAIT_L(0); PG8_MMA(0, 0, At, B0); PG8_BAR; PG8_SCHED;
            PG8_LDB(B1, 0, 1); PG8_STAGE(PG8_SB(0, 0), b2, voffB);
            PG8_BAR; PG8_WAIT_L(0); PG8_MMA(0, 1, At, B1); PG8_BAR;
            PG8_LDA(At, 0, 1); PG8_STAGE(PG8_SA(0, 0), a2, voffA);
            PG8_BAR; PG8_WAIT_L(0); PG8_MMA(1, 0, At, B0); PG8_BAR; PG8_SCHED;
            PG8_STAGE(PG8_SB(0, 1), b2 + hstepB, voffB);
            PG8_WAIT_V(6); PG8_BAR; PG8_MMA(1, 1, At, B1); PG8_BAR;
            PG8_LDB(B0, 1, 0); PG8_SCHED; PG8_LDA(At, 1, 0); PG8_STAGE(PG8_SA(0, 1), a2 + hstepA, voffA);
            PG8_WAIT_L(8); PG8_BAR; PG8_WAIT_L(0); PG8_MMA(0, 0, At, B0); PG8_BAR; PG8_SCHED;
            PG8_LDB(B1, 1, 1); PG8_STAGE(PG8_SB(1, 0), b3, voffB);
            PG8_BAR; PG8_WAIT_L(0); PG8_MMA(0, 1, At, B1); PG8_BAR;
            PG8_LDA(At, 1, 1); PG8_STAGE(PG8_SA(1, 0), a3, voffA);
            PG8_BAR; PG8_WAIT_L(0); PG8_MMA(1, 0, At, B0); PG8_BAR; PG8_SCHED;
            PG8_STAGE(PG8_SB(1, 1), b3 + hstepB, voffB);
            PG8_WAIT_V(6); PG8_BAR; PG8_MMA(1, 1, At, B1); PG8_BAR;
            }
        }
        if constexpr (ALIGN_EPI) { if (wr == 0) PG8_BAR; }
        E(acc, cur, wr, wc, fr, fq); S.done(cur);
        if (!has_next) break;
#pragma unroll
        for (int a = 0; a < 2; ++a)
#pragma unroll
            for (int b = 0; b < 2; ++b)
#pragma unroll
                for (int m = 0; m < 4; ++m)
#pragma unroll
                    for (int n = 0; n < 2; ++n) acc[a][b][m][n] = (acc_t){0, 0, 0, 0};
        cur = nxt; cA = nA; cB = nB; ++ui;
        if constexpr (ALIGN_EPI) { if (wr == 1) PG8_BAR; }
    }
    PG8_WAIT_V(0);
    if constexpr (!ALIGN_EPI) { if (wr == 0) PG8_BAR; }
    PG8_BAR;
#undef PG8_SA
#undef PG8_SB
#undef PG8_STAGE
#undef PG8_LDA
#undef PG8_LDB
#undef PG8_MMA
#undef PG8_WAIT_V
#undef PG8_WAIT_L
#undef PG8_BAR
#undef PG8_SCHED
}
}

constexpr int NWAVES = 8;
constexpr int S = 16384, DM = 4096, DEPTH = 2;
constexpr int PP = 6656;
constexpr int NP = 19200;
constexpr int IN_COLS = 19008;
constexpr int NB = 3840;
constexpr int NG = 15360;
__host__ __device__ constexpr int bf_tile_col(int t) { return t < 5 ? 1280 + 256 * t : t < 9 ? 3584 + 256 * (t - 5) : 5120 + 256 * (t - 9); }
constexpr int C_QA = 0, C_KA = 1024, C_VA = 1280, C_ZA = 1536, C_CQ = 2560, C_CKV = 3584, C_ZB = 4096, C_QC = 4608, C_KC = 5120, C_VC = 5632, C_ZC = 6144,
              C_GA = 6656, C_GB = 10752, C_GC = 14848, C_KR = 18944;
constexpr float EPS = 1e-6f;
constexpr float LOG2E = 1.4426950408889634f;
constexpr float SC128 = 0.08838834764831845f * LOG2E;
constexpr float SC192 = 0.07216878364870322f * LOG2E;
constexpr int YW = 2048;

constexpr size_t MiB = 1u << 20;
constexpr size_t WS_CTL = 0, CTL_ZERO_BYTES = 1 * MiB;
constexpr size_t WS_RS = 1 * MiB;
constexpr size_t WS_RSQ = WS_RS + 65536, WS_RSKV = WS_RSQ + 65536;
constexpr size_t WS_ROPEC = 2 * MiB, WS_ROPES = 4 * MiB;
constexpr size_t WS_WQ = 6 * MiB;
constexpr size_t WS_WKV = 10 * MiB;
constexpr size_t WS_WPROJ = 16 * MiB;
constexpr size_t WS_WOUT = 48 * MiB;
constexpr size_t WS_WIN = 112 * MiB;
constexpr size_t WS_WG8 = 224 * MiB;
constexpr size_t WS_XQ = 344 * MiB;
constexpr size_t WS_SA = WS_RS + 3 * 65536;
constexpr size_t WS_SB = WS_RS + 4 * 65536;
constexpr size_t WS_XB = 416 * MiB;
constexpr size_t WS_P = 544 * MiB;
constexpr size_t WS_GT = 752 * MiB;
constexpr size_t WS_QM = 1144 * MiB;
constexpr size_t WS_KVM = 1168 * MiB;
constexpr size_t WS_KRM = 1200 * MiB;
constexpr size_t WS_Y = 1204 * MiB;
constexpr size_t WS_MBF = 1524 * MiB;
constexpr size_t WS_X1 = 1652 * MiB;
constexpr size_t WS_OPART = 1908 * MiB;
constexpr size_t WS_ML = 2036 * MiB;
constexpr size_t WS_END = 2040 * MiB;
static_assert(WS_WIN + (size_t)2 * NB * DM * 2 <= WS_WG8 && WS_WG8 + (size_t)2 * NG * DM <= WS_XQ && WS_XQ + (size_t)S * DM <= WS_XB && WS_P + (size_t)S * PP * 2 <= WS_GT && WS_GT + (size_t)3 * S * DM * 2 <= WS_QM && WS_SB + 2 * NG * 4 <= WS_ROPEC, "ws map");
constexpr int CW_TMO = 0, CW_CODE = 1;
constexpr int CW_BAR = 4096;
constexpr int CW_MLACNT = 20480;
constexpr int CW_QUEUE = 16384;
constexpr size_t CTL_COLMAX = 640 * 1024;
constexpr size_t CTL_BLUT = 896 * 1024;
constexpr size_t CTL_ROWMAX = 768 * 1024;
constexpr size_t CTL_SSQ_Q = 256 * 1024, CTL_SSQ_KV = 384 * 1024, CTL_SSQ_X = 512 * 1024;

constexpr int RING_OFF = 0, RING_BYTES = 131072;
constexpr int LDSCTL_OFF = RING_BYTES, MISC_OFF = LDSCTL_OFF + 320;
constexpr int LDS_BYTES = 147456;

#define GAS __attribute__((address_space(1)))
#define LAS __attribute__((address_space(3)))
typedef unsigned short bf16;
typedef unsigned v4u __attribute__((ext_vector_type(4)));
typedef unsigned v2u __attribute__((ext_vector_type(2)));
typedef float f32x4 __attribute__((ext_vector_type(4)));
typedef float f32x2 __attribute__((ext_vector_type(2)));
typedef short bf16x8 __attribute__((ext_vector_type(8)));
typedef GAS unsigned gu32;
#define RLX_AGENT __ATOMIC_RELAXED, __HIP_MEMORY_SCOPE_AGENT
#define LDS_WAIT() asm volatile("s_waitcnt lgkmcnt(0)" ::: "memory")
#define VM_WAIT() asm volatile("s_waitcnt vmcnt(0)" ::: "memory")
__device__ __forceinline__ unsigned f2bf(float f) { unsigned u = __builtin_bit_cast(unsigned, f); return (u + 0x7fffu + ((u >> 16) & 1u)) >> 16; }
__device__ __forceinline__ unsigned pk2(float lo, float hi) { return f2bf(lo) | (f2bf(hi) << 16); }
__device__ __forceinline__ float bf2f(unsigned short b) { return __uint_as_float(((unsigned)b) << 16); }

#define XB_TMO      128
#define XB_XCNT(j)  (256  + 64 * (j))
#define XB_XSUB(j)  (1280 + 64 * (j))
#define XB_XGEN(j)  (2304 + 64 * (j))
#define XB_TOP      3328
#define XB_TOPGEN   3392
#define XCD_BAR_WORDS 3456
#define XB_SPIN_CAP (1u << 18)
__device__ __forceinline__ unsigned xb_ld(unsigned* p)              { return __hip_atomic_load(p, __ATOMIC_RELAXED, __HIP_MEMORY_SCOPE_AGENT); }
__device__ __forceinline__ unsigned xb_add(unsigned* p, unsigned v) { return __hip_atomic_fetch_add(p, v, __ATOMIC_RELAXED, __HIP_MEMORY_SCOPE_AGENT); }
__device__ __forceinline__ unsigned xb_xcc_id() { return (unsigned)__builtin_amdgcn_s_getreg((3 << 11) | 20) & 0xFu; }
#define XB_SPIN(cond, bar) do { unsigned _sp = 0; while (cond) { __builtin_amdgcn_s_sleep(1); \
    if ((++_sp & 255u) == 0u) { if (xb_ld(&(bar)[XB_TMO])) break; if (_sp > XB_SPIN_CAP) { atomicAdd(&(bar)[XB_TMO], 1u); break; } } } } while (0)
struct XcdBarrier { unsigned* bar; unsigned x; volatile LAS unsigned* st; };
__device__ __forceinline__ XcdBarrier xcd_barrier_post(unsigned* bar, volatile LAS unsigned* st) {
    XcdBarrier b; b.bar = bar; b.x = xb_xcc_id(); b.st = st;
    if (threadIdx.x == 0) (void)xb_add(&bar[XB_XCNT(b.x)], 1u);
    return b;
}
__device__ __forceinline__ void xcd_barrier_complete(unsigned* bar, unsigned x, unsigned& nloc, unsigned& nx) {
    const unsigned G = gridDim.x * gridDim.y * gridDim.z;
    unsigned sum, cnt, mine, sp = 0u;
    for (;;) {
        sum = 0u; cnt = 0u; mine = 0u;
#pragma unroll
        for (unsigned j = 0; j < 16; ++j) { const unsigned c = xb_ld(&bar[XB_XCNT(j)]); sum += c; cnt += (c > 0u) ? 1u : 0u; mine = (j == x) ? c : mine; }
        if (sum == G) break;
        __builtin_amdgcn_s_sleep(1);
        if ((++sp & 255u) == 0u) { if (xb_ld(&bar[XB_TMO])) break; if (sp > XB_SPIN_CAP) { atomicAdd(&bar[XB_TMO], 1u); break; } }
    }
    nloc = mine > 0u ? mine : 1u; nx = cnt > 0u ? cnt : 1u;
}
__device__ __forceinline__ void xcd_barrier(const XcdBarrier& b) {
    asm volatile("s_waitcnt vmcnt(0)" ::: "memory");
    __syncthreads();
    if (threadIdx.x == 0) {
        unsigned* bar = b.bar;
        __builtin_amdgcn_s_waitcnt(0);
        unsigned nloc = b.st[0], nx = b.st[1];
        if (nloc == 0u) { xcd_barrier_complete(bar, b.x, nloc, nx); b.st[0] = nloc; b.st[1] = nx; }
        const unsigned old = xb_add(&bar[XB_XSUB(b.x)], 1u);
        const unsigned gen = old / nloc;
        if (old + 1u == (gen + 1u) * nloc) {
            __builtin_amdgcn_fence(__ATOMIC_RELEASE, "agent");
            asm volatile("s_waitcnt vmcnt(0)" ::: "memory");
            const unsigned og = xb_add(&bar[XB_TOP], 1u);
            const unsigned tg = og / nx;
            if (og + 1u == (tg + 1u) * nx) xb_add(&bar[XB_TOPGEN], 1u);
            else XB_SPIN(xb_ld(&bar[XB_TOPGEN]) == tg, bar);
            __builtin_amdgcn_fence(__ATOMIC_ACQUIRE, "agent");
            xb_add(&bar[XB_XGEN(b.x)], 1u);
            asm volatile("s_waitcnt vmcnt(0)" ::: "memory");
        } else {
            XB_SPIN(xb_ld(&bar[XB_XGEN(b.x)]) == gen, bar);
            __builtin_amdgcn_fence(__ATOMIC_ACQUIRE, "agent");
            asm volatile("s_waitcnt vmcnt(0)" ::: "memory");
        }
    }
    __syncthreads();
}

struct Args {
    const float* x; const float* norm_g; const float* w_in; const float* sinks; const float* rel_bias; const float* g_q; const float* w_q_up; const float* g_kv; const float* w_kv_up;
    const float* w_pa; const float* w_pb; const float* w_pc; const float* w_out; const float* final_g;
    float* out; unsigned char* ws; int ph_lo, ph_hi;
};
struct Frame {
    LAS unsigned char* lds;
    gu32* ctl;
    int tid, lane, wave, G, gw, NGW;
    bf16 *Win, *Wout, *Wproj, *Wq, *Wkv, *XB, *P, *QM, *KVM, *KRM, *Y, *MBF; unsigned char* GT; signed char *WG8, *XQ; float *SA, *SB; unsigned* COLMAX;
    float *RS, *RSQ, *RSKV, *ROPEC, *ROPES, *X1, *OPART, *ML, *SSQ_Q, *SSQ_KV, *SSQ_X, *BLUT; unsigned* ROWMAX;
};
__device__ __forceinline__ void set_ptrs(Frame& F, unsigned char* ws_) {
    GAS unsigned char* wsg = (GAS unsigned char*)ws_; asm volatile("" : "+s"(wsg)); unsigned char* ws = (unsigned char*)wsg;
    { int t = threadIdx.x; asm volatile("" : "+v"(t)); F.tid = t; F.lane = t & 63; F.wave = __builtin_amdgcn_readfirstlane(t >> 6); F.gw = blockIdx.x * NWAVES + F.wave; }
    F.ctl = (gu32*)(ws + WS_CTL);
    F.Win = (bf16*)(ws + WS_WIN); F.Wout = (bf16*)(ws + WS_WOUT); F.Wproj = (bf16*)(ws + WS_WPROJ); F.Wq = (bf16*)(ws + WS_WQ); F.Wkv = (bf16*)(ws + WS_WKV);
    F.XB = (bf16*)(ws + WS_XB); F.P = (bf16*)(ws + WS_P); F.QM = (bf16*)(ws + WS_QM); F.KVM = (bf16*)(ws + WS_KVM); F.KRM = (bf16*)(ws + WS_KRM); F.Y = (bf16*)(ws + WS_Y); F.MBF = (bf16*)(ws + WS_MBF); F.GT = ws + WS_GT;
    F.RS = (float*)(ws + WS_RS); F.RSQ = (float*)(ws + WS_RSQ); F.RSKV = (float*)(ws + WS_RSKV); F.ROPEC = (float*)(ws + WS_ROPEC); F.ROPES = (float*)(ws + WS_ROPES);
    F.X1 = (float*)(ws + WS_X1); F.OPART = (float*)(ws + WS_OPART); F.ML = (float*)(ws + WS_ML);
    F.WG8 = (signed char*)(ws + WS_WG8); F.XQ = (signed char*)(ws + WS_XQ); F.SA = (float*)(ws + WS_SA); F.SB = (float*)(ws + WS_SB); F.COLMAX = (unsigned*)(ws + WS_CTL + CTL_COLMAX);
    F.SSQ_Q = (float*)(ws + WS_CTL + CTL_SSQ_Q); F.SSQ_KV = (float*)(ws + WS_CTL + CTL_SSQ_KV); F.SSQ_X = (float*)(ws + WS_CTL + CTL_SSQ_X); F.ROWMAX = (unsigned*)(ws + WS_CTL + CTL_ROWMAX); F.BLUT = (float*)(ws + WS_CTL + CTL_BLUT);
}
__device__ __forceinline__ float wave_sum(float v) {
#pragma unroll
    for (int o = 1; o < 64; o <<= 1) v += __shfl_xor(v, o);
    return v;
}
__device__ __forceinline__ float wave_max(float v) {
#pragma unroll
    for (int o = 1; o < 64; o <<= 1) v = fmaxf(v, __shfl_xor(v, o));
    return v;
}

__device__ const unsigned char T5B[128] = {0, 1, 2, 3, 4, 5, 6, 7, 8, 9, 10, 11, 12, 13, 14, 15, 16, 16, 16, 17, 17, 18, 18, 18, 19, 19, 19, 20, 20, 20, 20, 21, 21, 21, 21, 22, 22, 22, 22, 22, 23, 23, 23, 23, 23, 23, 24, 24, 24, 24, 24, 24, 25, 25, 25, 25, 25, 25, 25, 26, 26, 26, 26, 26, 26, 26, 26, 27, 27, 27, 27, 27, 27, 27, 27, 27, 27, 28, 28, 28, 28, 28, 28, 28, 28, 28, 28, 29, 29, 29, 29, 29, 29, 29, 29, 29, 29, 29, 29, 30, 30, 30, 30, 30, 30, 30, 30, 30, 30, 30, 30, 30, 30, 31, 31, 31, 31, 31, 31, 31, 31, 31, 31, 31, 31, 31, 31, 31};

__device__ const float ROPE_INV[32] = {1.000000000e+00f, 7.498942614e-01f, 5.623413324e-01f, 4.216965139e-01f, 3.162277639e-01f, 2.371373773e-01f, 1.778279394e-01f, 1.333521307e-01f, 1.000000015e-01f, 7.498941571e-02f, 5.623413250e-02f, 4.216965288e-02f, 3.162277490e-02f, 2.371373773e-02f, 1.778279431e-02f, 1.333521493e-02f, 9.999999776e-03f, 7.498941850e-03f, 5.623413250e-03f, 4.216964822e-03f, 3.162277630e-03f, 2.371373586e-03f, 1.778279431e-03f, 1.333521446e-03f, 1.000000047e-03f, 7.498942432e-04f, 5.623413017e-04f, 4.216965172e-04f, 3.162277571e-04f, 2.371373703e-04f, 1.778279402e-04f, 1.333521504e-04f};
template <int MAP> __device__ __forceinline__ int src_col(int n) {
    if (MAP == 1) { const int pc = bf_tile_col(n >> 8) + (n & 255); return pc < 4096 ? pc : pc + 64; }
    if (MAP == 3) {
        if (n < 12288) return 6720 + n; if (n < 13312) return n - 12288; if (n < 14336) return 2560 + (n - 13312); if (n < 14592) return 1024 + (n - 14336); if (n < 15104) return 4672 + (n - 14592);
        const int r = n - 15104; return r < 64 ? 4096 + ((r & 1) ? 32 + (r >> 1) : (r >> 1)) : -1; }
    if (MAP == 2) { const int h = n / 192, c = n % 192; if (c < 128) return n; const int j = c - 128; return h * 192 + 128 + ((j & 1) ? 32 + (j >> 1) : (j >> 1)); }
    return n;
}
template <int MAP>
__device__ __forceinline__ void conv_item(const float* W, int Nsrc, const float* g, bf16* WT, int ldd, int dk0, int nblk, LAS float* scr, int item, int lane) {
    const int kb = item / nblk, nb = item % nblk, k0 = 64 * kb, n0 = 32 * nb;
    const int sc = src_col<MAP>(n0 + (lane & 31));
    const GAS float* wp = (const GAS float*)W + (size_t)(k0 + (lane >> 5)) * Nsrc + (sc >= 0 ? sc : 0);
    float v[32];
#pragma unroll
    for (int i = 0; i < 32; ++i) v[i] = __builtin_nontemporal_load(wp + (size_t)(2 * i) * Nsrc);
    const int c = lane & 7;
    f32x4 g0 = {1.f, 1.f, 1.f, 1.f}, g1 = {1.f, 1.f, 1.f, 1.f};
    if (g) { g0 = *(const GAS f32x4*)(g + k0 + 8 * c); g1 = *(const GAS f32x4*)(g + k0 + 8 * c + 4); }
#pragma unroll
    for (int i = 0; i < 32; ++i) scr[(2 * i + (lane >> 5)) * 33 + (lane & 31)] = (sc >= 0) ? v[i] : 0.f;
    LDS_WAIT(); asm volatile("" ::: "memory");
#pragma unroll
    for (int j = 0; j < 4; ++j) { const int n = (lane >> 3) + 8 * j; const LAS float* s = scr + (8 * c) * 33 + n;
        v4u o; o.x = pk2(s[0 * 33] * g0[0], s[1 * 33] * g0[1]); o.y = pk2(s[2 * 33] * g0[2], s[3 * 33] * g0[3]); o.z = pk2(s[4 * 33] * g1[0], s[5 * 33] * g1[1]); o.w = pk2(s[6 * 33] * g1[2], s[7 * 33] * g1[3]);
        *(GAS v4u*)(WT + (size_t)(n0 + n) * ldd + dk0 + k0 + 8 * c) = o; }
    LDS_WAIT(); asm volatile("" ::: "memory");
}
__device__ __forceinline__ void gate_max_item(const float* W, const float* g, unsigned* colmax, int item, int lane) {
    const int kb = item / (NG / 64), nb = item % (NG / 64), k0 = 32 * kb, n0 = 64 * nb;
    const int sc = src_col<3>(n0 + lane);
    const GAS float* wp = (const GAS float*)W + (size_t)k0 * IN_COLS + (sc >= 0 ? sc : 0);
    float v[32];
#pragma unroll
    for (int i = 0; i < 32; ++i) v[i] = __builtin_nontemporal_load(wp + (size_t)i * IN_COLS);
    float m = 0.f;
#pragma unroll
    for (int i = 0; i < 32; ++i) m = fmaxf(m, fabsf(v[i] * g[k0 + i]));
    if (sc < 0) m = 0.f;
    atomicMax(colmax + n0 + lane, __float_as_uint(m));
}
__device__ __forceinline__ void gate_quant_item(const float* W, const float* g, const unsigned* colmax, signed char* WQ, float* sb, LAS float* scr, int item, int lane) {
    const int kb = item / (NG / 32), nb = item % (NG / 32), k0 = 64 * kb, n0 = 32 * nb;
    const int sc = src_col<3>(n0 + (lane & 31));
    const GAS float* wp = (const GAS float*)W + (size_t)(k0 + (lane >> 5)) * IN_COLS + (sc >= 0 ? sc : 0);
    float v[32];
#pragma unroll
    for (int i = 0; i < 32; ++i) v[i] = __builtin_nontemporal_load(wp + (size_t)(2 * i) * IN_COLS);
    if (sc < 0) {
#pragma unroll
        for (int i = 0; i < 32; ++i) v[i] = 0.f; }
    const float cm = __uint_as_float(colmax[n0 + (lane & 31)]); const float inv = cm > 0.f ? 127.0f / cm : 0.f;
    if (kb == 0 && lane < 32) sb[n0 + lane] = cm * (1.0f / 127.0f);
#pragma unroll
    for (int i = 0; i < 32; ++i) { const int kk = 2 * i + (lane >> 5); float q = __builtin_rintf(v[i] * g[k0 + kk] * inv); q = fminf(fmaxf(q, -127.f), 127.f); scr[kk * 33 + (lane & 31)] = q; }
    LDS_WAIT(); asm volatile("" ::: "memory");
    const int n = lane >> 1, hf = lane & 1;
    unsigned w[8];
#pragma unroll
    for (int d = 0; d < 8; ++d) { unsigned x = 0;
#pragma unroll
        for (int b = 0; b < 4; ++b) x |= ((unsigned)(int)scr[(32 * hf + 4 * d + b) * 33 + n] & 0xffu) << (8 * b);
        w[d] = x; }
    GAS v4u* dst = (GAS v4u*)(WQ + (size_t)(n0 + n) * DM + k0 + 32 * hf);
    dst[0] = (v4u){w[0], w[1], w[2], w[3]}; dst[1] = (v4u){w[4], w[5], w[6], w[7]};
    LDS_WAIT(); asm volatile("" ::: "memory");
}
__device__ __forceinline__ void sincos_d(double a, float& sn, float& cs) {
    const double q = __builtin_rint(a * 0.63661977236758134308);
    double r = __builtin_fma(-q, 1.57079632679489655800e+00, a); r = __builtin_fma(-q, 6.12323399573676603587e-17, r);
    const double r2 = r * r;
    double ps = r2 * (1.0 / 6227020800.0) - (1.0 / 39916800.0); ps = ps * r2 + (1.0 / 362880.0); ps = ps * r2 - (1.0 / 5040.0); ps = ps * r2 + (1.0 / 120.0); ps = ps * r2 - (1.0 / 6.0); ps = ps * r2 * r + r;
    double pc = r2 * (1.0 / 87178291200.0) - (1.0 / 479001600.0); pc = pc * r2 + (1.0 / 3628800.0); pc = pc * r2 - (1.0 / 40320.0); pc = pc * r2 + (1.0 / 720.0); pc = pc * r2 - (1.0 / 24.0); pc = pc * r2 + 0.5; pc = 1.0 - pc * r2;
    const int qi = ((int)q) & 3;
    const double s_ = (qi == 0) ? ps : (qi == 1) ? pc : (qi == 2) ? -ps : -pc;
    const double c_ = (qi == 0) ? pc : (qi == 1) ? -ps : (qi == 2) ? -pc : ps;
    sn = (float)s_; cs = (float)c_;
}
__device__ __forceinline__ void p0_prologue(Frame& F, const Args& A) {
    LAS float* scr = (LAS float*)(F.lds + RING_OFF + F.wave * 16384);
    constexpr int I_GM = 64 * (NG / 32), I_IN = 64 * (NB / 32), I_Q = 16 * (768 / 32), I_KV = 8 * (1024 / 32), I_PA = 16 * 128, I_PB = 8 * 128, I_PC = 8 * 128, I_O = 64 * 128;
    constexpr int PER_L = I_GM + I_IN + I_Q + I_KV + I_PA + I_PB + I_PC + I_O;
    for (int it = F.gw; it < DEPTH * PER_L; it += F.NGW) {
        const int l = it / PER_L; int r = it % PER_L;
        if (r < I_GM) { gate_max_item(A.w_in + (size_t)l * DM * IN_COLS, A.norm_g + l * DM, F.COLMAX + l * NG, r, F.lane); continue; } r -= I_GM;
        if (r < I_IN) { conv_item<1>(A.w_in + (size_t)l * DM * IN_COLS, IN_COLS, A.norm_g + l * DM, F.Win + (size_t)l * NB * DM, DM, 0, NB / 32, scr, r, F.lane); continue; } r -= I_IN;
        if (r < I_Q) { conv_item<2>(A.w_q_up + (size_t)l * 1024 * 768, 768, A.g_q + l * 1024, F.Wq + (size_t)l * 768 * 1024, 1024, 0, 768 / 32, scr, r, F.lane); continue; } r -= I_Q;
        if (r < I_KV) { conv_item<0>(A.w_kv_up + (size_t)l * 512 * 1024, 1024, A.g_kv + l * 512, F.Wkv + (size_t)l * 1024 * 512, 512, 0, 1024 / 32, scr, r, F.lane); continue; } r -= I_KV;
        if (r < I_PA) { conv_item<0>(A.w_pa + (size_t)l * 1024 * DM, DM, nullptr, F.Wproj + (size_t)l * DM * YW, YW, 0, 128, scr, r, F.lane); continue; } r -= I_PA;
        if (r < I_PB) { conv_item<0>(A.w_pb + (size_t)l * 512 * DM, DM, nullptr, F.Wproj + (size_t)l * DM * YW, YW, 1024, 128, scr, r, F.lane); continue; } r -= I_PB;
        if (r < I_PC) { conv_item<0>(A.w_pc + (size_t)l * 512 * DM, DM, nullptr, F.Wproj + (size_t)l * DM * YW, YW, 1536, 128, scr, r, F.lane); continue; } r -= I_PC;
        conv_item<0>(A.w_out + (size_t)l * DM * DM, DM, nullptr, F.Wout + (size_t)l * DM * DM, DM, 0, 128, scr, r, F.lane);
    }
    if (blockIdx.x == 0) { for (int i = threadIdx.x; i < 8 * 128; i += NWAVES * 64) F.BLUT[i] = A.rel_bias[(int)T5B[i & 127] * 8 + (i >> 7)] * LOG2E; }
    for (int i = F.gw * 64 + F.lane; i < S * 32; i += F.NGW * 64) {
        const int pos = i >> 5, j = i & 31;
        const float inv = ROPE_INV[j];
        const float ang = (float)pos * inv;
        float sn, cs; sincos_d((double)ang, sn, cs);
        F.ROPEC[i] = cs; F.ROPES[i] = sn;
    }
}
__device__ __forceinline__ void p0b_gate_quant(Frame& F, const Args& A) {
    LAS float* scr = (LAS float*)(F.lds + RING_OFF + F.wave * 16384);
    constexpr int I_GM = 64 * (NG / 32);
    for (int it = F.gw; it < DEPTH * I_GM; it += F.NGW) { const int l = it / I_GM, r = it % I_GM;
        gate_quant_item(A.w_in + (size_t)l * DM * IN_COLS, A.norm_g + l * DM, F.COLMAX + l * NG, F.WG8 + (size_t)l * NG * DM, F.SB + l * NG, scr, r, F.lane); }
}
template <int MODE>
__device__ __forceinline__ void prep_rows(Frame& F, const float* X, bf16* XBo, float* RSo, float* OUT, const float* gfin, signed char* XQo = nullptr, float* SAo = nullptr) {
    for (int m = F.gw; m < S; m += F.NGW) {
        const GAS f32x4* xr = (const GAS f32x4*)(X + (size_t)m * DM) + F.lane;
        f32x4 v[16]; float s = 0.f;
#pragma unroll
        for (int j = 0; j < 16; ++j) { v[j] = __builtin_nontemporal_load(xr + 64 * j); s += (v[j].x * v[j].x + v[j].y * v[j].y) + (v[j].z * v[j].z + v[j].w * v[j].w); }
        float mx = 0.f;
        if (MODE == 0) {
#pragma unroll
            for (int j = 0; j < 16; ++j) mx = fmaxf(fmaxf(mx, fmaxf(fabsf(v[j].x), fabsf(v[j].y))), fmaxf(fabsf(v[j].z), fabsf(v[j].w)));
            mx = wave_max(mx); }
        const float ssum = wave_sum(s); const float rs = 1.0f / sqrtf(ssum * (1.0f / DM) + EPS);
        if (MODE == 0) {
            if (F.lane == 0) RSo[m] = ssum;
            GAS v2u* o8 = (GAS v2u*)(XBo + (size_t)m * DM) + F.lane;
#pragma unroll
            for (int j = 0; j < 16; ++j) { v2u w; w.x = pk2(v[j].x, v[j].y); w.y = pk2(v[j].z, v[j].w); o8[64 * j] = w; }
            if (F.lane == 0) SAo[m] = mx * (1.0f / 127.0f);
            const float inv = mx > 0.f ? 127.0f / mx : 0.f;
            GAS unsigned* q4 = (GAS unsigned*)(XQo + (size_t)m * DM) + F.lane;
#pragma unroll
            for (int j = 0; j < 16; ++j) { const int a = (int)__builtin_rintf(v[j].x * inv), b = (int)__builtin_rintf(v[j].y * inv), c = (int)__builtin_rintf(v[j].z * inv), d = (int)__builtin_rintf(v[j].w * inv);
                q4[64 * j] = ((unsigned)a & 0xffu) | (((unsigned)b & 0xffu) << 8) | (((unsigned)c & 0xffu) << 16) | (((unsigned)d & 0xffu) << 24); }
        } else {
            GAS f32x4* o = (GAS f32x4*)(OUT + (size_t)m * DM) + F.lane; const GAS f32x4* gg = (const GAS f32x4*)gfin + F.lane;
#pragma unroll
            for (int j = 0; j < 16; ++j) { const f32x4 gv = gg[64 * j]; o[64 * j] = v[j] * rs * gv; }
        }
    }
}

__device__ __forceinline__ void prep_q8(Frame& F, const bf16* XBi, const float* ssx, const unsigned* rmx, float* RSo, float* SAo, signed char* XQo) {
    for (int m = F.gw; m < S; m += F.NGW) {
        const GAS v4u* xr = (const GAS v4u*)(XBi + (size_t)m * DM) + F.lane;
        v4u v[8];
#pragma unroll
        for (int j = 0; j < 8; ++j) v[j] = xr[64 * j];
        const float mx = __uint_as_float(rmx[m]), inv = mx > 0.f ? 127.0f / mx : 0.f;
        if (F.lane == 0) { RSo[m] = ssx[m]; SAo[m] = mx * (1.0f / 127.0f); }
        GAS v2u* q8 = (GAS v2u*)(XQo + (size_t)m * DM) + F.lane;
#pragma unroll
        for (int j = 0; j < 8; ++j) { unsigned o2[2];
#pragma unroll
            for (int h = 0; h < 2; ++h) { const unsigned w0 = h ? v[j].z : v[j].x, w1 = h ? v[j].w : v[j].y;
                const int a = (int)__builtin_rintf(pg8::bf_lo(w0) * inv), b = (int)__builtin_rintf(pg8::bf_hi(w0) * inv), c = (int)__builtin_rintf(pg8::bf_lo(w1) * inv), d = (int)__builtin_rintf(pg8::bf_hi(w1) * inv);
                o2[h] = ((unsigned)a & 0xffu) | (((unsigned)b & 0xffu) << 8) | (((unsigned)c & 0xffu) << 16) | (((unsigned)d & 0xffu) << 24); }
            v2u w; w.x = o2[0]; w.y = o2[1]; q8[64 * j] = w; }
    }
}

__device__ __forceinline__ void final_norm(Frame& F, const bf16* XBi, const float* ssx, float* OUT, const float* gfin) {
    f32x4 gk[8][2];
    { const GAS f32x4* gg = (const GAS f32x4*)gfin + 2 * F.lane;
#pragma unroll
      for (int j = 0; j < 8; ++j) { gk[j][0] = gg[128 * j]; gk[j][1] = gg[128 * j + 1]; } }
    for (int m = F.gw; m < S; m += F.NGW) {
        const GAS v4u* xr = (const GAS v4u*)(XBi + (size_t)m * DM) + F.lane;
        v4u v[8];
#pragma unroll
        for (int j = 0; j < 8; ++j) v[j] = xr[64 * j];
        const float rs = 1.0f / sqrtf(ssx[m] * (1.0f / DM) + EPS);
        GAS f32x4* o = (GAS f32x4*)(OUT + (size_t)m * DM) + 2 * F.lane;
#pragma unroll
        for (int j = 0; j < 8; ++j) { const f32x4 g0 = gk[j][0], g1 = gk[j][1];
            f32x4 a = {pg8::bf_lo(v[j].x), pg8::bf_hi(v[j].x), pg8::bf_lo(v[j].y), pg8::bf_hi(v[j].y)}, b = {pg8::bf_lo(v[j].z), pg8::bf_hi(v[j].z), pg8::bf_lo(v[j].w), pg8::bf_hi(v[j].w)};
            o[128 * j] = a * rs * g0; o[128 * j + 1] = b * rs * g1; }
    }
}

using pg8::f32x4; using pg8::Unit;
__device__ __forceinline__ float fast_sigmoid(float v) { return __builtin_amdgcn_rcpf(1.0f + __builtin_amdgcn_exp2f(-v * LOG2E)); }
__device__ __forceinline__ void atomic_addf(float* p, float v) { unsafeAtomicAdd(p, v); }
struct EpiInProj {
    static constexpr bool PERM = true, AFTER_DRAIN = false, MID = false; typedef pg8::f32x4 acc_t;
    bf16* P; const float* rs; bf16* KRM; const float* ropeC; const float* ropeS; float* ssq_q; float* ssq_kv; bool stats;
    __device__ __forceinline__ void operator()(const f32x4 (&acc)[2][2][4][2], const Unit& u, int wr, int wc, int fr, int fq) const {
        const int pn = u.pn;
        const int pcb = bf_tile_col(u.pn), po = pcb >> 8;
        const int ty = po < 4 ? 1 : po < 6 ? 0 : po < 10 ? 2 : po < 16 ? 0 : po < 18 ? 2 : po < 20 ? 1 : po < 24 ? 0 : 2;
        const int row0 = u.pm * 256 + wr * 64 + fr, col0 = pcb + wc * 32 + 8 * fq;
        float srow[2][4];
#pragma unroll
        for (int ai = 0; ai < 2; ++ai)
#pragma unroll
            for (int m = 0; m < 4; ++m) srow[ai][m] = rs[row0 + ai * 128 + m * 16];
#pragma unroll
        for (int ai = 0; ai < 2; ++ai)
#pragma unroll
            for (int m = 0; m < 4; ++m) srow[ai][m] = 1.0f / sqrtf(srow[ai][m] * (1.0f / DM) + EPS);
#pragma unroll
        for (int ai = 0; ai < 2; ++ai)
#pragma unroll
            for (int m = 0; m < 4; ++m) {
                const int row = row0 + ai * 128 + m * 16; const float s = srow[ai][m];
                bf16* rowp = P + (size_t)row * PP + col0; float ssl = 0.f;
#pragma unroll
                for (int bj = 0; bj < 2; ++bj) {
                    f32x4 v0 = acc[ai][bj][m][0] * s, v1 = acc[ai][bj][m][1] * s;
                    pg8::u32x4 w;
                    if (ty == 3) {
#pragma unroll
                        for (int j = 0; j < 4; ++j) { v0[j] = fast_sigmoid(v0[j]); v1[j] = fast_sigmoid(v1[j]); }
                        w.x = pg8::cvt_pk_f16(v0[0], v0[1]); w.y = pg8::cvt_pk_f16(v0[2], v0[3]); w.z = pg8::cvt_pk_f16(v1[0], v1[1]); w.w = pg8::cvt_pk_f16(v1[2], v1[3]);
                        *(pg8::u32x4*)(rowp + bj * 128) = w;
                    } else if (ty == 4) {
                        if (bj == 0 && wc < 2) {
                            const int j0 = wc * 16 + 4 * fq;
                            const f32x4 c = *(const f32x4*)(ropeC + (size_t)row * 32 + j0), sn = *(const f32x4*)(ropeS + (size_t)row * 32 + j0);
                            const float a0 = v0[0] * c[0] - v0[1] * sn[0], b0 = v0[1] * c[0] + v0[0] * sn[0];
                            const float a1 = v0[2] * c[1] - v0[3] * sn[1], b1 = v0[3] * c[1] + v0[2] * sn[1];
                            const float a2 = v1[0] * c[2] - v1[1] * sn[2], b2 = v1[1] * c[2] + v1[0] * sn[2];
                            const float a3 = v1[2] * c[3] - v1[3] * sn[3], b3 = v1[3] * c[3] + v1[2] * sn[3];
                            w.x = pg8::cvt_pk_bf16(a0, b0); w.y = pg8::cvt_pk_bf16(a1, b1); w.z = pg8::cvt_pk_bf16(a2, b2); w.w = pg8::cvt_pk_bf16(a3, b3);
                            *(pg8::u32x4*)(KRM + (size_t)row * 64 + wc * 32 + 8 * fq) = w;
                        }
                    } else {
                        if (po >= 10 && po < 16) ssl += (v0[0] * v0[0] + v0[1] * v0[1]) + (v0[2] * v0[2] + v0[3] * v0[3]) + (v1[0] * v1[0] + v1[1] * v1[1]) + (v1[2] * v1[2] + v1[3] * v1[3]);
                        if (ty == 1) { v0 = v0 * SC128; v1 = v1 * SC128; }
                        if (ty == 2) {
#pragma unroll
                            for (int j = 0; j < 4; ++j) { v0[j] = v0[j] * fast_sigmoid(v0[j]); v1[j] = v1[j] * fast_sigmoid(v1[j]); }
                        }
                        w.x = pg8::cvt_pk_bf16(v0[0], v0[1]); w.y = pg8::cvt_pk_bf16(v0[2], v0[3]); w.z = pg8::cvt_pk_bf16(v1[0], v1[1]); w.w = pg8::cvt_pk_bf16(v1[2], v1[3]);
                        *(pg8::u32x4*)(rowp + bj * 128) = w;
                    }
                }
                if (stats && po >= 10 && po < 16) { ssl += __shfl_xor(ssl, 16); ssl += __shfl_xor(ssl, 32); if (fq == 0) atomic_addf((po < 14 ? ssq_q : ssq_kv) + row, ssl); }
            }
    }
};
struct EpiGateI8 {
    static constexpr bool PERM = true, AFTER_DRAIN = false, MID = false; typedef pg8::i32x4 acc_t;
    bf16* P; const float* rs; const float* sa; const float* sb; float* ssq_q; bf16* KRM; const float* ropeC; const float* ropeS; unsigned char* GT;
    __device__ __forceinline__ void operator()(const pg8::i32x4 (&acc)[2][2][4][2], const Unit& u, int wr, int wc, int fr, int fq) const {
        const int t = u.pn;
        const int ty = t < 48 ? 0 : t < 52 ? 1 : t < 56 ? 2 : t < 57 ? 3 : t < 59 ? 1 : 4;
        const int row0 = u.pm * 256 + wr * 64 + fr, colw = wc * 32 + 8 * fq, col0 = t * 256 + colw;
        const int pcol = (t < 48 ? C_GA + t * 256 : t < 52 ? C_QA + (t - 48) * 256 : t < 56 ? C_CQ + (t - 52) * 256 : t < 57 ? C_KA : t < 59 ? C_QC + (t - 57) * 256 : 0) + colw;
        const float tsc = ty == 0 ? -LOG2E : ty == 1 ? SC128 : 1.0f;
        f32x4 cs[2][2];
#pragma unroll
        for (int bj = 0; bj < 2; ++bj) { cs[bj][0] = *(const f32x4*)(sb + col0 + bj * 128) * tsc; cs[bj][1] = *(const f32x4*)(sb + col0 + bj * 128 + 4) * tsc; }
        float srow[2][4], arow[2][4];
#pragma unroll
        for (int ai = 0; ai < 2; ++ai)
#pragma unroll
            for (int m = 0; m < 4; ++m) { srow[ai][m] = rs[row0 + ai * 128 + m * 16]; arow[ai][m] = sa[row0 + ai * 128 + m * 16]; }
#pragma unroll
        for (int ai = 0; ai < 2; ++ai)
#pragma unroll
            for (int m = 0; m < 4; ++m) srow[ai][m] = arow[ai][m] / sqrtf(srow[ai][m] * (1.0f / DM) + EPS);
#pragma unroll
        for (int ai = 0; ai < 2; ++ai)
#pragma unroll
            for (int m = 0; m < 4; ++m) {
                const int row = row0 + ai * 128 + m * 16; const float s = srow[ai][m];
                bf16* rowp = P + (size_t)row * PP + pcol; float ssl = 0.f;
#pragma unroll
                for (int bj = 0; bj < 2; ++bj) {
                    float v[8]; pg8::u32x4 w;
#pragma unroll
                    for (int j = 0; j < 8; ++j) v[j] = (float)acc[ai][bj][m][j >> 2][j & 3] * s * cs[bj][j >> 2][j & 3];
                    if (ty == 0) {
#pragma unroll
                        for (int j = 0; j < 8; ++j) v[j] = fminf(1.0f + __builtin_amdgcn_exp2f(v[j]), 65504.0f);
                        w.x = pg8::cvt_pk_f16(v[0], v[1]); w.y = pg8::cvt_pk_f16(v[2], v[3]); w.z = pg8::cvt_pk_f16(v[4], v[5]); w.w = pg8::cvt_pk_f16(v[6], v[7]);
                        *(GAS pg8::u32x4*)((GAS unsigned char*)GT + ((unsigned)(t * 64 + u.pm) * 131072u + (unsigned)((ai * 4 + m) * 2 + bj) * 8192u + (unsigned)(((wr * 4 + wc) * 64 + fq * 16 + fr) * 16))) = w;
                    } else if (ty == 4) {
                        if (bj == 0 && wc < 2) {
                            const int j0 = wc * 16 + 4 * fq;
                            const f32x4 c = *(const f32x4*)(ropeC + (size_t)row * 32 + j0), sn = *(const f32x4*)(ropeS + (size_t)row * 32 + j0);
                            w.x = pg8::cvt_pk_bf16(v[0] * c[0] - v[1] * sn[0], v[1] * c[0] + v[0] * sn[0]); w.y = pg8::cvt_pk_bf16(v[2] * c[1] - v[3] * sn[1], v[3] * c[1] + v[2] * sn[1]);
                            w.z = pg8::cvt_pk_bf16(v[4] * c[2] - v[5] * sn[2], v[5] * c[2] + v[4] * sn[2]); w.w = pg8::cvt_pk_bf16(v[6] * c[3] - v[7] * sn[3], v[7] * c[3] + v[6] * sn[3]);
                            *(pg8::u32x4*)(KRM + (size_t)row * 64 + wc * 32 + 8 * fq) = w;
                        }
                    } else {
                        if (ty == 2) ssl += (v[0] * v[0] + v[1] * v[1]) + (v[2] * v[2] + v[3] * v[3]) + (v[4] * v[4] + v[5] * v[5]) + (v[6] * v[6] + v[7] * v[7]);
                        w.x = pg8::cvt_pk_bf16(v[0], v[1]); w.y = pg8::cvt_pk_bf16(v[2], v[3]); w.z = pg8::cvt_pk_bf16(v[4], v[5]); w.w = pg8::cvt_pk_bf16(v[6], v[7]);
                        *(pg8::u32x4*)(rowp + bj * 128) = w;
                    }
                }
                if (ty == 2) { ssl += __shfl_xor(ssl, 16); ssl += __shfl_xor(ssl, 32); if (fq == 0) atomic_addf(ssq_q + row, ssl); }
            }
    }
};
struct EpiQUp {
    static constexpr bool PERM = true, AFTER_DRAIN = false, MID = false; typedef pg8::f32x4 acc_t;
    bf16* QM; const float* rsq; const float* ropeC; const float* ropeS;
    __device__ __forceinline__ void operator()(const f32x4 (&acc)[2][2][4][2], const Unit& u, int wr, int wc, int fr, int fq) const {
        const int row0 = u.pm * 256 + wr * 64 + fr, col0 = u.pn * 256 + wc * 32 + 8 * fq;
        float srow[2][4];
#pragma unroll
        for (int ai = 0; ai < 2; ++ai)
#pragma unroll
            for (int m = 0; m < 4; ++m) srow[ai][m] = rsq[row0 + ai * 128 + m * 16];
        const int cb0 = (u.pn * 256 + wc * 32) % 192, cb1 = (u.pn * 256 + wc * 32 + 128) % 192;
        const int rbj = __builtin_amdgcn_readfirstlane(cb0 >= 128 ? 0 : cb1 >= 128 ? 1 : -1);
        f32x4 ccv[2][4], snv[2][4];
        if (rbj >= 0) { const int j0r = (((rbj ? cb1 : cb0) - 128) >> 1) + 4 * fq;
#pragma unroll
            for (int ai = 0; ai < 2; ++ai)
#pragma unroll
                for (int m = 0; m < 4; ++m) { const size_t ro = (size_t)(row0 + ai * 128 + m * 16) * 32 + j0r; ccv[ai][m] = *(const f32x4*)(ropeC + ro); snv[ai][m] = *(const f32x4*)(ropeS + ro); } }
#pragma unroll
        for (int ai = 0; ai < 2; ++ai)
#pragma unroll
            for (int m = 0; m < 4; ++m) {
                const int row = row0 + ai * 128 + m * 16; const float s = SC192 / sqrtf(srow[ai][m] * (1.0f / 1024.0f) + EPS);
#pragma unroll
                for (int bj = 0; bj < 2; ++bj) {
                    const int col = col0 + bj * 128, c = col % 192;
                    f32x4 v0 = acc[ai][bj][m][0] * s, v1 = acc[ai][bj][m][1] * s;
                    pg8::u32x4 w;
                    if (bj == rbj) {
                        const f32x4 cc = ccv[ai][m], sn = snv[ai][m];
                        const float a0 = v0[0] * cc[0] - v0[1] * sn[0], b0 = v0[1] * cc[0] + v0[0] * sn[0];
                        const float a1 = v0[2] * cc[1] - v0[3] * sn[1], b1 = v0[3] * cc[1] + v0[2] * sn[1];
                        const float a2 = v1[0] * cc[2] - v1[1] * sn[2], b2 = v1[1] * cc[2] + v1[0] * sn[2];
                        const float a3 = v1[2] * cc[3] - v1[3] * sn[3], b3 = v1[3] * cc[3] + v1[2] * sn[3];
                        w.x = pg8::cvt_pk_bf16(a0, b0); w.y = pg8::cvt_pk_bf16(a1, b1); w.z = pg8::cvt_pk_bf16(a2, b2); w.w = pg8::cvt_pk_bf16(a3, b3);
                    } else {
                        w.x = pg8::cvt_pk_bf16(v0[0], v0[1]); w.y = pg8::cvt_pk_bf16(v0[2], v0[3]); w.z = pg8::cvt_pk_bf16(v1[0], v1[1]); w.w = pg8::cvt_pk_bf16(v1[2], v1[3]);
                    }
                    *(pg8::u32x4*)(QM + (size_t)row * 768 + col) = w;
                }
            }
    }
};
struct EpiKvUp {
    static constexpr bool PERM = true, AFTER_DRAIN = false, MID = false; typedef pg8::f32x4 acc_t;
    bf16* KVM; const float* rskv;
    __device__ __forceinline__ void operator()(const f32x4 (&acc)[2][2][4][2], const Unit& u, int wr, int wc, int fr, int fq) const {
        const int row0 = u.pm * 256 + wr * 64 + fr, col0 = u.pn * 256 + wc * 32 + 8 * fq;
        float srow[2][4];
#pragma unroll
        for (int ai = 0; ai < 2; ++ai)
#pragma unroll
            for (int m = 0; m < 4; ++m) srow[ai][m] = rskv[row0 + ai * 128 + m * 16];
#pragma unroll
        for (int ai = 0; ai < 2; ++ai)
#pragma unroll
            for (int m = 0; m < 4; ++m) {
                const int row = row0 + ai * 128 + m * 16; const float s = 1.0f / sqrtf(srow[ai][m] * (1.0f / 512.0f) + EPS);
#pragma unroll
                for (int bj = 0; bj < 2; ++bj) {
                    const f32x4 v0 = acc[ai][bj][m][0] * s, v1 = acc[ai][bj][m][1] * s;
                    pg8::u32x4 w; w.x = pg8::cvt_pk_bf16(v0[0], v0[1]); w.y = pg8::cvt_pk_bf16(v0[2], v0[3]); w.z = pg8::cvt_pk_bf16(v1[0], v1[1]); w.w = pg8::cvt_pk_bf16(v1[2], v1[3]);
                    *(pg8::u32x4*)(KVM + (size_t)row * 1024 + col0 + bj * 128) = w;
                }
            }
    }
};
struct EpiProjFused {
    static constexpr bool PERM = true, AFTER_DRAIN = false, MID = true; typedef pg8::f32x4 acc_t;
    const unsigned char* GT; bf16* MBF; int t1, t2;
    typedef _Float16 h8 __attribute__((ext_vector_type(8)));
    __device__ __forceinline__ void mid(f32x4 (&acc)[2][2][4][2], const Unit& u, bool second, int wr, int wc, int fr, int fq) const {
        const unsigned slot = (unsigned)(((wr * 4 + wc) * 64 + fq * 16 + fr) * 16);
        const unsigned gx = (unsigned)(((second ? 16 : 0) + u.pn) * 64 + u.pm) * 131072u + slot, gy = gx + 16u * 64u * 131072u;
        const GAS unsigned char* Gb = (const GAS unsigned char*)GT;
#pragma unroll
        for (int ai = 0; ai < 2; ++ai) {
            h8 X[4][2], Y[4][2];
#pragma unroll
            for (int m = 0; m < 4; ++m)
#pragma unroll
                for (int bj = 0; bj < 2; ++bj) { const unsigned co = (unsigned)((ai * 4 + m) * 2 + bj) * 8192u; X[m][bj] = *(const GAS h8*)(Gb + (gx + co)); Y[m][bj] = *(const GAS h8*)(Gb + (gy + co)); }
#pragma unroll
            for (int m = 0; m < 4; ++m) {
#pragma unroll
                for (int bj = 0; bj < 2; ++bj) {
#pragma unroll
                    for (int j = 0; j < 8; ++j) { const float r = (float)Y[m][bj][j] * __builtin_amdgcn_rcpf((float)X[m][bj][j]); acc[ai][bj][m][j >> 2][j & 3] *= r; }
                    __builtin_amdgcn_sched_barrier(0);
                }
            }
            asm volatile("" ::: "memory");
        }
    }
    __device__ __forceinline__ void operator()(const f32x4 (&acc)[2][2][4][2], const Unit& u, int wr, int wc, int fr, int fq) const {
        const int row0 = u.pm * 256 + wr * 64 + fr, col0 = u.pn * 256 + wc * 32 + 8 * fq;
        h8 Gall[2][4][2];
        { const GAS unsigned char* gb_ = (const GAS unsigned char*)GT + ((unsigned)((32 + u.pn) * 64 + u.pm) * 131072u + (unsigned)(((wr * 4 + wc) * 64 + fq * 16 + fr) * 16));
#pragma unroll
          for (int ai = 0; ai < 2; ++ai)
#pragma unroll
            for (int m = 0; m < 4; ++m)
#pragma unroll
                for (int bj = 0; bj < 2; ++bj) Gall[ai][m][bj] = *(const GAS h8*)(gb_ + (unsigned)((ai * 4 + m) * 2 + bj) * 8192u); }
#pragma unroll
        for (int ai = 0; ai < 2; ++ai)
#pragma unroll
            for (int m = 0; m < 4; ++m) {
                const int row = row0 + ai * 128 + m * 16;
#pragma unroll
                for (int bj = 0; bj < 2; ++bj) {
                    const h8 G = Gall[ai][m][bj];
                    float v[8];
#pragma unroll
                    for (int j = 0; j < 8; ++j) v[j] = acc[ai][bj][m][j >> 2][j & 3] * __builtin_amdgcn_rcpf((float)G[j]);
                    pg8::u32x4 w; w.x = pg8::cvt_pk_bf16(v[0], v[1]); w.y = pg8::cvt_pk_bf16(v[2], v[3]); w.z = pg8::cvt_pk_bf16(v[4], v[5]); w.w = pg8::cvt_pk_bf16(v[6], v[7]);
                    *(pg8::u32x4*)(MBF + (size_t)row * DM + col0 + bj * 128) = w;
                }
            }
    }
};
struct EpiOut {
    static constexpr bool PERM = false, AFTER_DRAIN = false, MID = false; typedef pg8::f32x4 acc_t;
    const float* Xp; float* Xn; bf16* XBn; float* ssx; unsigned* rmx; bool LAST; bool stats; bool FIN; bool TIN; bool TOUT;
    __device__ __forceinline__ void operator()(const f32x4 (&acc)[2][2][4][2], const Unit& u, int wr, int wc, int fr, int fq) const {
        const int row0 = u.pm * 256 + wr * 64 + fr, col0 = u.pn * 256 + wc * 32 + 4 * fq;
        const unsigned tb = (unsigned)(u.pn * 64 + u.pm) * 262144u + (unsigned)(((wr * 4 + wc) * 64 + fq * 16 + fr) * 16), rb = ((unsigned)row0 * (unsigned)DM + (unsigned)col0) * 4u;
        const unsigned ib = TIN ? tb : rb, ob = TOUT ? tb : rb;
        const unsigned is_ai = TIN ? 16u * 8192u : 128u * DM * 4u, is_m = TIN ? 4u * 8192u : 16u * DM * 4u, is_bj = TIN ? 2u * 8192u : 512u, is_n = TIN ? 8192u : 64u;
        const unsigned os_ai = TOUT ? 16u * 8192u : 128u * DM * 4u, os_m = TOUT ? 4u * 8192u : 16u * DM * 4u, os_bj = TOUT ? 2u * 8192u : 512u, os_n = TOUT ? 8192u : 64u;
#pragma unroll
        for (int ai = 0; ai < 2; ++ai) {
            f32x4 xin[4][2][2];
#pragma unroll
            for (int m = 0; m < 4; ++m)
#pragma unroll
                for (int bj = 0; bj < 2; ++bj)
#pragma unroll
                    for (int n = 0; n < 2; ++n) xin[m][bj][n] = *(const GAS f32x4*)((const GAS unsigned char*)Xp + (ib + ai * is_ai + m * is_m + bj * is_bj + n * is_n));
#pragma unroll
            for (int m = 0; m < 4; ++m) {
                const int row = row0 + ai * 128 + m * 16; const size_t off = (size_t)row * DM + col0; float ssl = 0.f, mxl = 0.f;
#pragma unroll
                for (int bj = 0; bj < 2; ++bj) {
                    pg8::u32x2 w[2];
#pragma unroll
                    for (int n = 0; n < 2; ++n) { const f32x4 v = xin[m][bj][n] + acc[ai][bj][m][n]; if (!FIN) *(GAS f32x4*)((GAS unsigned char*)Xn + (ob + ai * os_ai + m * os_m + bj * os_bj + n * os_n)) = v;
                        if (!LAST) { w[n].x = pg8::cvt_pk_bf16(v[0], v[1]); w[n].y = pg8::cvt_pk_bf16(v[2], v[3]); ssl += (v[0] * v[0] + v[1] * v[1]) + (v[2] * v[2] + v[3] * v[3]); mxl = fmaxf(fmaxf(mxl, fmaxf(fabsf(v[0]), fabsf(v[1]))), fmaxf(fabsf(v[2]), fabsf(v[3]))); } }
                    if (!LAST) {
                        auto r0 = __builtin_amdgcn_permlane16_swap(w[0].x, w[1].x, false, false); auto r1 = __builtin_amdgcn_permlane16_swap(w[0].y, w[1].y, false, false);
                        pg8::u32x4 w4; w4.x = r0[0]; w4.y = r1[0]; w4.z = r0[1]; w4.w = r1[1];
                        const int cx = (fq & 1) ? 16 + 4 * (fq - 1) - 4 * fq : 0;
                        *(pg8::u32x4*)(XBn + off + bj * 128 + cx) = w4; }
                }
                if (!LAST && stats) { ssl += __shfl_xor(ssl, 16); ssl += __shfl_xor(ssl, 32); mxl = fmaxf(mxl, __shfl_xor(mxl, 16)); mxl = fmaxf(mxl, __shfl_xor(mxl, 32));
                    if (fq == 0) { atomic_addf(ssx + row, ssl); atomicMax(rmx + row, __float_as_uint(mxl)); } }
            }
            asm volatile("" ::: "memory");
        }
    }
};

__device__ __forceinline__ float dot8(const v4u kv, const LAS float* q) {
    const f32x4 q0 = *(const LAS f32x4*)q, q1 = *(const LAS f32x4*)(q + 4);
    return pg8::bf_lo(kv.x) * q0[0] + pg8::bf_hi(kv.x) * q0[1] + pg8::bf_lo(kv.y) * q0[2] + pg8::bf_hi(kv.y) * q0[3]
         + pg8::bf_lo(kv.z) * q1[0] + pg8::bf_hi(kv.z) * q1[1] + pg8::bf_lo(kv.w) * q1[2] + pg8::bf_hi(kv.w) * q1[3];
}
template <int MODE>
__device__ __forceinline__ void naive_attn_task(Frame& F, const Args& A, int layer, int row, int head, LAS float* wscr) {
    const int lane = F.lane;
    constexpr int DQK = (MODE == 1) ? 192 : 128;
    const bf16 *qp, *kb, *vb, *gatep; bf16* outp; int kpitch, vpitch;
    if (MODE == 0) { qp = F.P + (size_t)row * PP + C_QA + head * 128; kb = F.P + C_KA + (head >> 2) * 128; vb = F.P + C_VA + (head >> 2) * 128; kpitch = PP; vpitch = PP;
        gatep = F.P + (size_t)row * PP + C_ZA + head * 128; outp = F.Y + (size_t)row * YW + head * 128; }
    else if (MODE == 1) { qp = F.QM + (size_t)row * 768 + head * 192; kb = F.KVM + head * 256; vb = F.KVM + head * 256 + 128; kpitch = 1024; vpitch = 1024;
        gatep = F.P + (size_t)row * PP + C_ZB + head * 128; outp = F.Y + (size_t)row * YW + 1024 + head * 128; }
    else { qp = F.P + (size_t)row * PP + C_QC + head * 128; kb = F.P + C_KC + head * 128; vb = F.P + C_VC + head * 128; kpitch = PP; vpitch = PP;
        gatep = F.P + (size_t)row * PP + C_ZC + head * 128; outp = F.Y + (size_t)row * YW + 1536 + head * 128; }
    LAS float* qs = wscr; LAS float* ps = wscr + 192;
    for (int i = lane; i < DQK; i += 64) qs[i] = bf2f(qp[i]);
    LDS_WAIT(); asm volatile("" ::: "memory");
    float o0 = 0.f, o1 = 0.f, mrun = -1e30f, lrun = 0.f, carry = 0.f;
    int klo, khi;
    if (MODE == 0) { klo = row - 127 > 0 ? row - 127 : 0; khi = row; } else if (MODE == 1) { klo = 0; khi = row; } else { klo = 0; khi = row - 1; }
    if (khi >= klo) {
        const int cfirst = klo & ~63, clast = khi & ~63;
        const int nchunk = (clast - cfirst) / 64 + 1;
        for (int ci = 0; ci < nchunk; ++ci) {
            const int c0 = (MODE == 2) ? clast - 64 * ci : cfirst + 64 * ci;
            const int s = c0 + lane; const bool valid = (s >= klo) && (s <= khi);
            const int sl = s > khi ? khi : (s < klo ? klo : s);
            const bf16* kp = kb + (size_t)sl * kpitch;
            float d = 0.f;
#pragma unroll
            for (int c = 0; c < 16; ++c) d += dot8(*(const GAS v4u*)(kp + 8 * c), qs + 8 * c);
            if (MODE == 1) { const bf16* krp = F.KRM + (size_t)sl * 64;
#pragma unroll
                for (int c = 0; c < 8; ++c) d += dot8(*(const GAS v4u*)(krp + 8 * c), qs + 128 + 8 * c); }
            float p;
            if (MODE == 2) {
                const float z = d;
                const float lk = -(fmaxf(z, 0.f) + __builtin_amdgcn_logf(1.0f + __builtin_amdgcn_exp2f(-fabsf(z))));
                float incl = valid ? lk : 0.f;
#pragma unroll
                for (int off = 1; off < 64; off <<= 1) { const float t = __shfl_down(incl, off); if (lane + off < 64) incl += t; }
                float excl = __shfl_down(incl, 1); if (lane == 63) excl = 0.f;
                const float tot = __shfl(incl, 0);
                p = valid ? __builtin_amdgcn_exp2f(z + lk + excl + carry) : 0.f;
                carry += tot;
            } else {
                float sc = d;
                if (MODE == 0) sc += A.rel_bias[(int)T5B[(row - sl) & 127] * 8 + head] * LOG2E;
                sc = valid ? sc : -__builtin_inff();
                const float mn = fmaxf(mrun, wave_max(sc));
                const float alpha = __builtin_amdgcn_exp2f(mrun - mn);
                p = __builtin_amdgcn_exp2f(sc - mn);
                lrun = lrun * alpha + wave_sum(p); o0 *= alpha; o1 *= alpha; mrun = mn;
            }
            ps[lane] = p;
            LDS_WAIT(); asm volatile("" ::: "memory");
            for (int j = 0; j < 64; ++j) {
                int sj = c0 + j; sj = sj > khi ? khi : (sj < klo ? klo : sj);
                const float pj = ps[j];
                const unsigned vv = *(const GAS unsigned*)(vb + (size_t)sj * vpitch + 2 * lane);
                o0 += pj * pg8::bf_lo(vv); o1 += pj * pg8::bf_hi(vv);
            }
            LDS_WAIT(); asm volatile("" ::: "memory");
        }
    }
    if (MODE == 0) { const float sk = A.sinks[layer * 8 + head] * LOG2E; const float mf = fmaxf(mrun, sk); const float a = __builtin_amdgcn_exp2f(mrun - mf);
        const float lf = lrun * a + __builtin_amdgcn_exp2f(sk - mf); const float inv = a / lf; o0 *= inv; o1 *= inv; }
    if (MODE == 1) { const float inv = 1.0f / lrun; o0 *= inv; o1 *= inv; }
    const unsigned gv = *(const GAS unsigned*)(gatep + 2 * lane);
    *(GAS unsigned*)(outp + 2 * lane) = pk2(o0 * pg8::bf_lo(gv), o1 * pg8::bf_hi(gv));
}
__device__ __forceinline__ void naive_attn_phase(Frame& F, const Args& A, int layer) {
    LAS float* wscr = (LAS float*)(F.lds + RING_OFF + F.wave * 2048);
    if (!(ATTN_MFMA_MASK & 2)) for (int t = F.gw; t < S * 4; t += F.NGW) naive_attn_task<1>(F, A, layer, t >> 2, t & 3, wscr);
    if (!(ATTN_MFMA_MASK & 4)) for (int t = F.gw; t < S * 4; t += F.NGW) naive_attn_task<2>(F, A, layer, t >> 2, t & 3, wscr);
    if (!(ATTN_MFMA_MASK & 1)) for (int t = F.gw; t < S * 8; t += F.NGW) naive_attn_task<0>(F, A, layer, t >> 3, t & 7, wscr);
}


namespace att {
typedef short s16x4 __attribute__((ext_vector_type(4)));
typedef float f32x16 __attribute__((ext_vector_type(16)));
constexpr int SHM_T = 16384, OFF_V = 0  , OFF_K = 3 * SHM_T  , OFF_KR = 5 * SHM_T, OFF_WS = 5 * SHM_T + 2 * 8192, OFF_FLAG = OFF_WS + 8 * 256, OFF_LUT = OFF_FLAG + 64, LDS_END = OFF_LUT + 512;
static_assert(LDS_END <= RING_BYTES, "attention LDS");
#define KSWZ(row, colB) ((row) * 256 + ((colB) ^ (((row) & 15) << 4)))
#define KRSWZ(row, chunk) ((row) * 128 + ((((chunk) ^ ((row) >> 1)) & 7) << 4))
__device__ __forceinline__ int v_st(int k, int c) { const int kk = (k & ~0xC) | ((k & 4) << 1) | ((k & 8) >> 1); return ((kk >> 3) * 4 + (c >> 5)) * 512 + ((kk & 7) * 32 + (c & 31)) * 2; }
__device__ __forceinline__ int v_rd_base(int lane) { return ((lane & 3) << 3) | (((lane >> 2) & 3) << 6) | (((lane >> 4) & 1) << 5) | (((lane >> 5) & 1) << 8); }
constexpr int v_rd_off(int d0, int ks, int half) { return d0 * 512 + ks * 4096 + half * 2048; }
__device__ __forceinline__ int crow(int r, int hi) { return (r & 3) + 8 * (r >> 2) + 4 * hi; }
__device__ __forceinline__ unsigned cvtpk(float lo, float hi) { unsigned r; asm volatile("v_cvt_pk_bf16_f32 %0, %1, %2" : "=v"(r) : "v"(lo), "v"(hi)); return r; }
__device__ __forceinline__ void glds16(const void* gsrc, unsigned lds_dst) { unsigned keep;
    asm volatile("s_mov_b32 %0, m0\n\ts_mov_b32 m0, %2\n\ts_nop 0\n\tglobal_load_lds_dwordx4 %1, off\n\ts_mov_b32 m0, %0" : "=&s"(keep) : "v"(gsrc), "s"(lds_dst) : "memory"); }
__device__ __forceinline__ void glds16s(const char* sbase, unsigned voff, unsigned lds_dst) { unsigned keep;
    asm volatile("s_mov_b32 %0, m0\n\ts_mov_b32 m0, %3\n\ts_nop 0\n\tglobal_load_lds_dwordx4 %1, %2\n\ts_mov_b32 m0, %0" : "=&s"(keep) : "v"(voff), "s"(sbase), "s"(lds_dst) : "memory"); }
__device__ __forceinline__ const char* uni_ptr(const void* p) { const unsigned long long v = (unsigned long long)(uintptr_t)p;
    const unsigned lo = __builtin_amdgcn_readfirstlane((unsigned)v), hi_ = __builtin_amdgcn_readfirstlane((unsigned)(v >> 32)); return (const char*)(uintptr_t)(((unsigned long long)hi_ << 32) | lo); }
#define ATT_PK4(P, B_, OUT) do { unsigned a0 = cvtpk(P[B_+0], P[B_+1]), a1 = cvtpk(P[B_+2], P[B_+3]);                          \
        unsigned b0 = cvtpk(P[B_+4], P[B_+5]), b1 = cvtpk(P[B_+6], P[B_+7]);                                             \
        auto r0 = __builtin_amdgcn_permlane32_swap(a0, b0, false, false); auto r1 = __builtin_amdgcn_permlane32_swap(a1, b1, false, false); \
        v4u w_ = {r0[0], r1[0], r0[1], r1[1]}; OUT = __builtin_bit_cast(bf16x8, w_); } while (0)

template <int MODE>
__device__ __forceinline__ void attn_unit(LAS unsigned char* L, const bf16* __restrict__ Qp, int qpitch, const bf16* __restrict__ Kp, const bf16* __restrict__ Vp, int kvpitch,
                                          const bf16* __restrict__ KRp, const bf16* __restrict__ Gp, bf16* __restrict__ Op, int P0, float sink2, const float* __restrict__ biasp,
                                          int jlo_ovr, int jhi_ovr, float* __restrict__ Opart, float* __restrict__ MLp,
                                          gu32* cnt = nullptr, int nparts = 0, const float* Opart0 = nullptr, const float* ML0 = nullptr, volatile LAS unsigned* bflag = nullptr) {
    constexpr int NQ = (MODE == 1) ? 12 : 8;
    constexpr float THR = 8.f, NEG = -__builtin_inff();
    int tid = threadIdx.x; asm volatile("" : "+v"(tid));
    const int wid = __builtin_amdgcn_readfirstlane(tid >> 6), lane = tid & 63, r32 = lane & 31, hi = lane >> 5;
    int j_lo = 0, j_hi = P0 / 64 + 4;
    if (MODE == 0) j_lo = P0 >= 128 ? P0 / 64 - 2 : 0;
    if (MODE == 1) { j_lo = jlo_ovr; j_hi = jhi_ovr; }
    const int NT = j_hi - j_lo;
    const int qlo = P0 + wid * 32, qpos = qlo + r32;
    unsigned ko[2], vo[2];
    const char* const Kb0 = uni_ptr(Kp); const char* const Rb0 = uni_ptr(KRp);
    const unsigned vdiff = (unsigned)__builtin_amdgcn_readfirstlane((int)((const char*)Vp - (const char*)Kp));
#pragma unroll
    for (int i = 0; i < 2; ++i) { const int p = wid * 128 + i * 64 + lane;
        { const int row = p >> 4, phys = p & 15; ko[i] = (unsigned)(row * kvpitch + ((phys ^ (row & 15)) << 3)) * 2u; }
        { const int s = p >> 5, q = p & 31, kk = (s >> 2) * 8 + (q >> 2); const int vr = (kk & ~0xC) | ((kk & 4) << 1) | ((kk & 8) >> 1); vo[i] = (unsigned)(vr * kvpitch + (s & 3) * 32 + (q & 3) * 8) * 2u + vdiff; } }
    const int rp = wid * 64 + lane; const unsigned ro = (unsigned)((rp >> 3) * 64 + (((rp & 7) ^ ((rp >> 4) & 7)) << 3)) * 2u;
    const unsigned ldsK = (unsigned)(uintptr_t)(L + OFF_K) + (unsigned)wid * 2048u, ldsV = (unsigned)(uintptr_t)(L + OFF_V) + (unsigned)wid * 2048u, ldsR = (unsigned)(uintptr_t)(L + OFF_KR) + (unsigned)wid * 1024u;
    const unsigned XK = (unsigned)(r32 * 256 + ((hi ^ (r32 & 15)) << 4)), XR = (unsigned)(r32 * 128 + (((hi ^ (r32 >> 1)) & 7) << 4));
    LAS float* wsf = (LAS float*)(L + OFF_WS + wid * 256); LAS float* li_l = wsf; LAS float* al_l = wsf + 32;
    volatile LAS unsigned* flags = (volatile LAS unsigned*)(L + OFF_FLAG);
    LAS float* blut = (LAS float*)(L + OFF_LUT);
    float blv = 0.f; if (MODE == 0) { if (tid < 128) blv = biasp[tid]; }
    bf16x8 qr[NQ];
#pragma unroll
    for (int d0 = 0; d0 < NQ; ++d0) qr[d0] = *(const GAS bf16x8*)(Qp + (size_t)(wid * 32 + r32) * qpitch + d0 * 16 + hi * 8);
#define ATT_TILE(t) ((MODE == 2) ? (j_hi - 1 - (t)) : (j_lo + (t)))
#define ATT_DMA(jt, bf, vbf) do { const char* kb_ = Kb0 + (size_t)(jt) * 128 * (size_t)kvpitch; \
        glds16s(kb_, ko[0], (unsigned)__builtin_amdgcn_readfirstlane(ldsK + (bf) * SHM_T)); \
        glds16s(kb_, ko[1], (unsigned)__builtin_amdgcn_readfirstlane(ldsK + (bf) * SHM_T + 1024)); \
        glds16s(kb_, vo[0], (unsigned)__builtin_amdgcn_readfirstlane(ldsV + (vbf) * SHM_T)); \
        glds16s(kb_, vo[1], (unsigned)__builtin_amdgcn_readfirstlane(ldsV + (vbf) * SHM_T + 1024)); \
        if (MODE == 1) glds16s(Rb0 + (size_t)(jt) * 8192, ro, (unsigned)__builtin_amdgcn_readfirstlane(ldsR + (bf) * 8192)); } while (0)
    float m_reg = -1e30f, l_reg = 0.f, carry = 0.f;
    f32x16 o[4];
#pragma unroll
    for (int d = 0; d < 4; ++d)
#pragma unroll
        for (int r = 0; r < 16; ++r) o[d][r] = 0.f;
    ATT_DMA(ATT_TILE(0), 0, 0); if (MODE == 0) { if (tid < 128) blut[tid] = blv; } VM_WAIT();
#pragma unroll
    for (int d0 = 0; d0 < NQ; ++d0) asm volatile("" : "+v"(qr[d0]));
    __syncthreads();
    const unsigned vbase = (unsigned)(uintptr_t)(L + OFF_V) + (unsigned)v_rd_base(lane);
    const bool lag = (wid >= 4);
    bool pend = false; int vcur = 0, vprev = 0;
    bf16x8 pa0, pa1, pa2, pa3;
#define ATT_TRRD(dst, off) asm volatile("ds_read_b64_tr_b16 %0, %1 offset:%2" : "=&v"(dst) : "v"(vb0), "i"(off) : "memory")
#define ATT_PV(d0) do { s16x4 l0, l1, l2, l3, h0, h1, h2, h3; constexpr int b_ = v_rd_off(d0, 0, 0); \
        ATT_TRRD(l0, b_); ATT_TRRD(h0, b_ + 2048); ATT_TRRD(l1, b_ + 4096); ATT_TRRD(h1, b_ + 6144); ATT_TRRD(l2, b_ + 8192); ATT_TRRD(h2, b_ + 10240); ATT_TRRD(l3, b_ + 12288); ATT_TRRD(h3, b_ + 14336); \
        asm volatile("s_waitcnt lgkmcnt(0)" ::: "memory"); __builtin_amdgcn_sched_barrier(0); \
        o[d0] = __builtin_amdgcn_mfma_f32_32x32x16_bf16((bf16x8){l0[0], l0[1], l0[2], l0[3], h0[0], h0[1], h0[2], h0[3]}, pa0, o[d0], 0, 0, 0); \
        o[d0] = __builtin_amdgcn_mfma_f32_32x32x16_bf16((bf16x8){l1[0], l1[1], l1[2], l1[3], h1[0], h1[1], h1[2], h1[3]}, pa1, o[d0], 0, 0, 0); \
        o[d0] = __builtin_amdgcn_mfma_f32_32x32x16_bf16((bf16x8){l2[0], l2[1], l2[2], l2[3], h2[0], h2[1], h2[2], h2[3]}, pa2, o[d0], 0, 0, 0); \
        o[d0] = __builtin_amdgcn_mfma_f32_32x32x16_bf16((bf16x8){l3[0], l3[1], l3[2], l3[3], h3[0], h3[1], h3[2], h3[3]}, pa3, o[d0], 0, 0, 0); } while (0)
#define ATT_PV_ALL(vbuf) do { const unsigned vb0 = vbase + (unsigned)((vbuf) * SHM_T); __builtin_amdgcn_s_setprio(1); ATT_PV(0); ATT_PV(1); ATT_PV(2); ATT_PV(3); __builtin_amdgcn_s_setprio(0); } while (0)
    for (int t = 0; t < NT; ++t) {
        const int cur = t & 1, jt = ATT_TILE(t), kb = jt * 64;
        const bool more = (t + 1 < NT);
        vprev = vcur; vcur = t % 3;
        if (more) ATT_DMA(ATT_TILE(t + 1), cur ^ 1, (t + 1) % 3);
        if (lag && pend) { ATT_PV_ALL(vprev); pend = false; }
        bool act;
        if (MODE == 0) act = (kb <= qlo + 31) && (kb + 63 >= qlo - 127);
        else if (MODE == 1) act = (kb <= qlo + 31);
        else act = (kb < qlo + 31) && !__all(carry < -150.f);
        if (act) {
            f32x16 p0, p1;
#pragma unroll
            for (int r = 0; r < 16; ++r) { p0[r] = 0.f; p1[r] = 0.f; }
            {
                unsigned xk = XK, xr = XR; asm volatile("" : "+v"(xk), "+v"(xr));
                const unsigned kbs = (unsigned)(uintptr_t)(L + OFF_K) + (unsigned)cur * SHM_T, rbs = (unsigned)(uintptr_t)(L + OFF_KR) + (unsigned)cur * 8192u;
                bf16x8 f0, f1, f2, f3;
#define ATT_KRD(dst, addr, off) asm volatile("ds_read_b128 %0, %1 offset:%2" : "=&v"(dst) : "v"(addr), "i"(off) : "memory")
#define ATT_KISSUE(s_, A_, B_) do { if ((s_) < 8) { const unsigned a_ = (xk ^ ((unsigned)(s_) << 5)) + kbs; ATT_KRD(A_, a_, 0); ATT_KRD(B_, a_, 8192); } \
                                    else { const unsigned a_ = (xr ^ ((unsigned)((s_) - 8) << 5)) + rbs; ATT_KRD(A_, a_, 0); ATT_KRD(B_, a_, 4096); } } while (0)
                ATT_KISSUE(0, f0, f1); ATT_KISSUE(1, f2, f3);
                __builtin_amdgcn_s_setprio(1);
#pragma unroll
                for (int s = 0; s < NQ; s += 2) {
                    if (s + 1 < NQ) asm volatile("s_waitcnt lgkmcnt(2)" ::: "memory"); else asm volatile("s_waitcnt lgkmcnt(0)" ::: "memory");
                    __builtin_amdgcn_sched_barrier(0);
                    p0 = __builtin_amdgcn_mfma_f32_32x32x16_bf16(f0, qr[s], p0, 0, 0, 0); p1 = __builtin_amdgcn_mfma_f32_32x32x16_bf16(f1, qr[s], p1, 0, 0, 0);
                    __builtin_amdgcn_sched_barrier(0);
                    if (s + 2 < NQ) ATT_KISSUE(s + 2, f0, f1);
                    if (s + 2 < NQ) asm volatile("s_waitcnt lgkmcnt(2)" ::: "memory"); else asm volatile("s_waitcnt lgkmcnt(0)" ::: "memory");
                    __builtin_amdgcn_sched_barrier(0);
                    p0 = __builtin_amdgcn_mfma_f32_32x32x16_bf16(f2, qr[s + 1], p0, 0, 0, 0); p1 = __builtin_amdgcn_mfma_f32_32x32x16_bf16(f3, qr[s + 1], p1, 0, 0, 0);
                    __builtin_amdgcn_sched_barrier(0);
                    if (s + 3 < NQ) ATT_KISSUE(s + 3, f2, f3);
                }
                __builtin_amdgcn_s_setprio(0);
#undef ATT_KISSUE
#undef ATT_KRD
            }
            const int dq = qpos - kb - 4 * hi;
            if (MODE != 2) {
                if (MODE == 0) {
#pragma unroll
                    for (int r = 0; r < 16; ++r) { const int c = (r & 3) + 8 * (r >> 2); const int e0 = dq - c, e1 = dq - c - 32;
                        const float b0 = blut[e0 < 0 ? 0 : (e0 > 127 ? 127 : e0)], b1 = blut[e1 < 0 ? 0 : (e1 > 127 ? 127 : e1)];
                        p0[r] = ((unsigned)e0 < 128u) ? p0[r] + b0 : NEG; p1[r] = ((unsigned)e1 < 128u) ? p1[r] + b1 : NEG; }
                } else {
                    if (kb + 63 > qlo) {
#pragma unroll
                        for (int r = 0; r < 16; ++r) { const int c = (r & 3) + 8 * (r >> 2); if (dq - c < 0) p0[r] = NEG; if (dq - c - 32 < 0) p1[r] = NEG; }
                    }
                }
                float pmax = p0[0];
#pragma unroll
                for (int r = 1; r < 16; ++r) pmax = fmaxf(pmax, p0[r]);
#pragma unroll
                for (int r = 0; r < 16; ++r) pmax = fmaxf(pmax, p1[r]);
                { auto rr = __builtin_amdgcn_permlane32_swap(__float_as_uint(pmax), __float_as_uint(pmax), false, false); pmax = fmaxf(__uint_as_float(rr[0]), __uint_as_float(rr[1])); }
                float mn, alpha;
                if (__all(pmax - m_reg <= THR)) { mn = m_reg; alpha = 1.f; }
                else { mn = fmaxf(m_reg, pmax); alpha = __builtin_amdgcn_exp2f(m_reg - mn); m_reg = mn; }
                float ps = 0.f;
#pragma unroll
                for (int r = 0; r < 16; ++r) { p0[r] = __builtin_amdgcn_exp2f(p0[r] - mn); p1[r] = __builtin_amdgcn_exp2f(p1[r] - mn); ps += p0[r] + p1[r]; }
                { auto rr = __builtin_amdgcn_permlane32_swap(__float_as_uint(ps), __float_as_uint(ps), false, false); ps = __uint_as_float(rr[0]) + __uint_as_float(rr[1]); }
                l_reg = l_reg * alpha + ps;
                if (__any(alpha < 1.f)) {
#pragma unroll
                    for (int r = 0; r < 16; ++r)
#pragma unroll
                        for (int d = 0; d < 4; ++d) o[d][r] *= alpha;
                }
            } else {
                float T[8];
#pragma unroll
                for (int i = 0; i < 8; ++i) {
                    float x[4], zz[4];
#pragma unroll
                    for (int a = 0; a < 4; ++a) { const int r = (i & 3) * 4 + a; const float z = (i < 4) ? p0[r] : p1[r]; const int c = (r & 3) + 8 * (r >> 2) + ((i < 4) ? 0 : 32);
                        const bool past = (dq - c) > 0;
                        const float lk = -(fmaxf(z, 0.f) + __builtin_amdgcn_logf(1.0f + __builtin_amdgcn_exp2f(-fabsf(z))));
                        x[a] = past ? lk : 0.f; zz[a] = past ? (z + lk) : NEG; }
                    const float e2 = x[3], e1 = x[3] + x[2], e0 = e1 + x[1];
                    T[i] = e0 + x[0];
                    if (i < 4) { p0[(i & 3) * 4 + 0] = zz[0] + e0; p0[(i & 3) * 4 + 1] = zz[1] + e1; p0[(i & 3) * 4 + 2] = zz[2] + e2; p0[(i & 3) * 4 + 3] = zz[3]; }
                    else       { p1[(i & 3) * 4 + 0] = zz[0] + e0; p1[(i & 3) * 4 + 1] = zz[1] + e1; p1[(i & 3) * 4 + 2] = zz[2] + e2; p1[(i & 3) * 4 + 3] = zz[3]; }
                }
                float U[8], PT[8];
#pragma unroll
                for (int i = 0; i < 8; ++i) { auto rr = __builtin_amdgcn_permlane32_swap(__float_as_uint(T[i]), __float_as_uint(T[i]), false, false);
                    const float tlo = __uint_as_float(rr[0]), thi = __uint_as_float(rr[1]); U[i] = tlo + thi; PT[i] = hi ? 0.f : thi; }
                float su = carry;
#pragma unroll
                for (int i = 7; i >= 0; --i) {
                    const float A = su + PT[i];
#pragma unroll
                    for (int a = 0; a < 4; ++a) { const int r = (i & 3) * 4 + a; if (i < 4) p0[r] = __builtin_amdgcn_exp2f(p0[r] + A); else p1[r] = __builtin_amdgcn_exp2f(p1[r] + A); }
                    su += U[i];
                }
                carry = su;
            }
            ATT_PK4(p0, 0, pa0); ATT_PK4(p0, 8, pa1); ATT_PK4(p1, 0, pa2); ATT_PK4(p1, 8, pa3);
            if (lag) pend = true; else ATT_PV_ALL(vcur);
        }
        VM_WAIT();
        if (MODE == 2) { if (lane == 0) flags[cur * 8 + wid] = __all(carry < -150.f) ? 1u : 0u; }
        __syncthreads();
        if (MODE == 2) { bool alld = true;
#pragma unroll
            for (int w = 0; w < 8; ++w) alld = alld && (flags[cur * 8 + w] != 0u);
            if (alld) break; }
    }
    if (pend) { ATT_PV_ALL(vcur); }
#undef ATT_PV_ALL
#undef ATT_PV
#undef ATT_TRRD
    const int orow = wid * 32 + r32;
    const GAS unsigned char* const Gub = (const GAS unsigned char*)uni_ptr(Gp); GAS unsigned char* const Oub = (GAS unsigned char*)uni_ptr(Op);
    const unsigned goff = (unsigned)(orow * PP + 8 * hi) * 2u, yoff = (unsigned)(orow * YW + 8 * hi) * 2u;
    auto fin_d0 = [&](const int d0, const f32x16& val, const float inv, const v4u g0, const v4u g1) __attribute__((always_inline)) {
#pragma unroll
        for (int pr = 0; pr < 2; ++pr) { float x[8];
#pragma unroll
            for (int i = 0; i < 4; ++i) { auto rr = __builtin_amdgcn_permlane32_swap(__float_as_uint(val[8 * pr + i] * inv), __float_as_uint(val[8 * pr + 4 + i] * inv), false, false);
                x[i] = __uint_as_float(rr[0]); x[4 + i] = __uint_as_float(rr[1]); }
            const v4u g = pr ? g1 : g0; v4u w;
            w.x = cvtpk(x[0] * pg8::bf_lo(g.x), x[1] * pg8::bf_hi(g.x)); w.y = cvtpk(x[2] * pg8::bf_lo(g.y), x[3] * pg8::bf_hi(g.y));
            w.z = cvtpk(x[4] * pg8::bf_lo(g.z), x[5] * pg8::bf_hi(g.z)); w.w = cvtpk(x[6] * pg8::bf_lo(g.w), x[7] * pg8::bf_hi(g.w));
            *(GAS v4u*)(Oub + (yoff + (unsigned)(d0 * 32 + 16 * pr) * 2u)) = w; }
    };
    auto finish = [&](const float inv) __attribute__((always_inline)) {
        v4u gw[4][2];
#pragma unroll
        for (int d0 = 0; d0 < 4; ++d0)
#pragma unroll
            for (int pr = 0; pr < 2; ++pr) gw[d0][pr] = *(const GAS v4u*)(Gub + (goff + (unsigned)(d0 * 32 + 16 * pr) * 2u));
#pragma unroll
        for (int d0 = 0; d0 < 4; ++d0) fin_d0(d0, o[d0], inv, gw[d0][0], gw[d0][1]);
    };
    const unsigned slot16 = (unsigned)(wid * 64 + lane) * 16u;
    if (MODE == 1) {
        const char* const Pub = uni_ptr(Opart);
#pragma unroll
        for (int d0 = 0; d0 < 4; ++d0)
#pragma unroll
            for (int g = 0; g < 4; ++g) { const f32x4 v = {o[d0][4 * g], o[d0][4 * g + 1], o[d0][4 * g + 2], o[d0][4 * g + 3]};
                asm volatile("global_store_dwordx4 %0, %1, %2 sc1" :: "v"(slot16 + (unsigned)(d0 * 4 + g) * 8192u), "v"(v), "s"(Pub) : "memory"); }
        if (hi == 0) { __hip_atomic_store((GAS unsigned long long*)(MLp + (size_t)orow * 2), ((unsigned long long)__float_as_uint(l_reg) << 32) | __float_as_uint(m_reg), RLX_AGENT); }
        VM_WAIT();
        __syncthreads();
        if (tid == 0) { const unsigned old = __hip_atomic_fetch_add(cnt, 1u, RLX_AGENT); *bflag = (old + 1u == (unsigned)nparts) ? 1u : 0u; }
        __syncthreads();
        const bool lastp = (*bflag != 0u);
        if (lastp) {
            __builtin_amdgcn_fence(__ATOMIC_ACQUIRE, "agent"); VM_WAIT();
            const GAS unsigned char* const P0ub = (const GAS unsigned char*)uni_ptr(Opart0);
            f32x2 mlv[4]; float wp[4]; float mmx = -1e30f, Ls = 0.f;
#pragma unroll
            for (int p = 0; p < 4; ++p) if (p < nparts) mlv[p] = *(const GAS f32x2*)(ML0 + (size_t)p * 512 + orow * 2);
#pragma unroll
            for (int p = 0; p < 4; ++p) if (p < nparts) mmx = fmaxf(mmx, mlv[p].x);
#pragma unroll
            for (int p = 0; p < 4; ++p) { wp[p] = 0.f; if (p < nparts) { wp[p] = __builtin_amdgcn_exp2f(mlv[p].x - mmx); Ls += wp[p] * mlv[p].y; } }
            const float invL = 1.0f / Ls;
#pragma unroll
            for (int d0 = 0; d0 < 4; ++d0) {
                f32x4 pv[4][4];
#pragma unroll
                for (int g = 0; g < 4; ++g)
#pragma unroll
                    for (int p = 0; p < 4; ++p) if (p < nparts) pv[g][p] = *(const GAS f32x4*)(P0ub + (slot16 + (unsigned)p * 131072u + (unsigned)(d0 * 4 + g) * 8192u));
                const v4u g0 = *(const GAS v4u*)(Gub + (goff + (unsigned)(d0 * 32) * 2u)), g1 = *(const GAS v4u*)(Gub + (goff + (unsigned)(d0 * 32 + 16) * 2u));
                f32x16 mv;
#pragma unroll
                for (int g = 0; g < 4; ++g) { f32x4 acc4 = pv[g][0] * wp[0];
#pragma unroll
                    for (int p = 1; p < 4; ++p) if (p < nparts) acc4 += pv[g][p] * wp[p];
                    mv[4 * g] = acc4[0]; mv[4 * g + 1] = acc4[1]; mv[4 * g + 2] = acc4[2]; mv[4 * g + 3] = acc4[3]; }
                fin_d0(d0, mv, invL, g0, g1);
                asm volatile("" ::: "memory"); __builtin_amdgcn_sched_barrier(0);
            }
        }
        __syncthreads();
        return;
    }
    if (MODE == 2) finish(1.0f);
    else { const float mf = fmaxf(m_reg, sink2); const float a = __builtin_amdgcn_exp2f(m_reg - mf); finish(a / (l_reg * a + __builtin_amdgcn_exp2f(sink2 - mf))); }
    __syncthreads();
#undef ATT_TILE
#undef ATT_DMA
}
}

__device__ __forceinline__ void attn_phase(Frame& F, const Args& A, int layer, int rep) {
    volatile LAS unsigned* MISC = (volatile LAS unsigned*)(F.lds + MISC_OFF);
    gu32* qhead = F.ctl + CW_QUEUE + 64 * (2 * layer + rep);
    unsigned nid = 0u;
    if (threadIdx.x == 0) nid = __hip_atomic_fetch_add(qhead, 1u, RLX_AGENT);
    for (;;) {
        if (threadIdx.x == 0) MISC[16] = nid;
        __syncthreads();
        const unsigned id = MISC[16];
        __syncthreads();
        if (id >= 1408u) break;
        if (threadIdx.x == 0) nid = __hip_atomic_fetch_add(qhead, 1u, RLX_AGENT);
        if (id < 640u && !(ATTN_MFMA_MASK & 2)) continue;
        if (id >= 640u && id < 896u && !(ATTN_MFMA_MASK & 4)) continue;
        if (id >= 896u && !(ATTN_MFMA_MASK & 1)) continue;
        if (id < 640u) {
            int h, qb, p;
            if (id < 384u) { const int idx = (int)(id >> 2); h = (int)(id & 3);
                if (idx < 16) { qb = 16 + idx; p = 0; } else if (idx < 48) { const int k = idx - 16; qb = 32 + (k >> 1); p = k & 1; } else { const int k = idx - 48; qb = 48 + k / 3; p = k % 3; } }
            else { const int jj = (int)id - 384, c = 15 - (jj >> 4), r = jj & 15; h = r & 3; const int g = r >> 2; qb = 16 * g + c; p = g; }
            const int P0 = qb * 256, jlo = 64 * p, jhi_full = 4 * (qb + 1), jhi = (64 * (p + 1) < jhi_full) ? 64 * (p + 1) : jhi_full;
            const size_t slot = (size_t)((h * 64 + qb) * 4 + p);
            const size_t slot0 = (size_t)((h * 64 + qb) * 4);
            att::attn_unit<1>(F.lds + RING_OFF, F.QM + (size_t)P0 * 768 + h * 192, 768, F.KVM + h * 256, F.KVM + h * 256 + 128, 1024, F.KRM,
                              F.P + (size_t)P0 * PP + C_ZB + h * 128, F.Y + (size_t)P0 * YW + 1024 + h * 128, P0, 0.f, nullptr, jlo, jhi, F.OPART + slot * 32768, F.ML + slot * 512,
                              F.ctl + CW_MLACNT + 256 * layer + h * 64 + qb, (qb >> 4) + 1, F.OPART + slot0 * 32768, F.ML + slot0 * 512, MISC + 17); }
        else if (id < 896u) { const int i = (int)id - 640, qb = 63 - (i >> 2), h = i & 3, P0 = qb * 256;
            att::attn_unit<2>(F.lds + RING_OFF, F.P + (size_t)P0 * PP + C_QC + h * 128, PP, F.P + C_KC + h * 128, F.P + C_VC + h * 128, PP, nullptr,
                              F.P + (size_t)P0 * PP + C_ZC + h * 128, F.Y + (size_t)P0 * YW + 1536 + h * 128, P0, 0.f, nullptr, 0, 0, nullptr, nullptr); }
        else { const int i = (int)id - 896, qb = i >> 3, h = i & 7, P0 = qb * 256;
            att::attn_unit<0>(F.lds + RING_OFF, F.P + (size_t)P0 * PP + C_QA + h * 128, PP, F.P + C_KA + (h >> 2) * 128, F.P + C_VA + (h >> 2) * 128, PP, nullptr,
                              F.P + (size_t)P0 * PP + C_ZA + h * 128, F.Y + (size_t)P0 * YW + h * 128, P0, A.sinks[layer * 8 + h] * LOG2E, F.BLUT + h * 128, 0, 0, nullptr, nullptr); }
    }
}
__global__ void __launch_bounds__(NWAVES * 64, 2) hybrid_fwd(Args args) {
    extern __shared__ __attribute__((aligned(16))) unsigned char lds[];
    Frame F;
    F.lds = (LAS unsigned char*)lds;
    volatile LAS unsigned* MISC = (volatile LAS unsigned*)(F.lds + MISC_OFF);
    F.G = gridDim.x; F.NGW = F.G * NWAVES;
    set_ptrs(F, args.ws);
    for (int u = threadIdx.x; u < (LDS_BYTES - LDSCTL_OFF) / 4; u += NWAVES * 64) ((LAS unsigned*)(F.lds + LDSCTL_OFF))[u] = 0u;
    __syncthreads();
    XcdBarrier bar; bar.bar = (unsigned*)(F.ctl + CW_BAR); bar.x = 0; bar.st = nullptr;
    if (!MK_PER_PHASE) bar = xcd_barrier_post((unsigned*)(F.ctl + CW_BAR), MISC + 8);
    const int lo = args.ph_lo, hi = args.ph_hi;
#define IN(k) (lo <= (k) && (k) < hi)
#define SEAM(k) do { if (IN(k) && IN((k) + 1)) xcd_barrier(bar); } while (0)

    { if (IN(0)) { set_ptrs(F, args.ws); p0_prologue(F, args); set_ptrs(F, args.ws); prep_rows<0>(F, args.x, F.XB, F.RS, nullptr, nullptr, F.XQ, F.SA); } }
    SEAM(0);
    { if (IN(1)) { set_ptrs(F, args.ws); p0b_gate_quant(F, args); } }
    SEAM(1);
    for (int l = 0; l < DEPTH; ++l) {
        const int pb = 2 + 6 * l;
        { if (IN(pb) && l > 0) { set_ptrs(F, args.ws); prep_q8(F, F.XB, F.SSQ_X + (l - 1) * S, F.ROWMAX + (l - 1) * S, F.RS, F.SA, F.XQ); } }
        if (l > 0) SEAM(pb);
        { if (IN(pb + 1)) { set_ptrs(F, args.ws);
            { pg8::Gemm g{F.XB, F.Win + (size_t)l * NB * DM, S, NB, DM, DM, DM}; pg8::StaticOrder So; So.init(S, NB, F.G, (int)blockIdx.x);
              EpiInProj E{F.P, F.RS, F.KRM, F.ROPEC, F.ROPES, F.SSQ_Q + l * S, F.SSQ_KV + l * S, true};
              pg8::gemm_phase<EpiInProj, pg8::StaticOrder, true, true>(F.lds + RING_OFF, g, So, E); }
            set_ptrs(F, args.ws);
            { pg8::Gemm g{(const bf16*)F.XQ, (const bf16*)(F.WG8 + (size_t)l * NG * DM), S, NG, DM / 2, DM / 2, DM / 2}; pg8::StaticOrder So; So.init(S, NG, F.G, (int)blockIdx.x);
              EpiGateI8 E{F.P, F.RS, F.SA, F.SB + l * NG, F.SSQ_Q + l * S, F.KRM, F.ROPEC, F.ROPES, F.GT};
              pg8::gemm_phase<EpiGateI8, pg8::StaticOrder, true, true>(F.lds + RING_OFF, g, So, E); }
        } }
        SEAM(pb + 1);
        { if (IN(pb + 2)) { set_ptrs(F, args.ws);
            { pg8::Gemm g{F.P + C_CQ, F.Wq + (size_t)l * 768 * 1024, S, 768, 1024, PP, 1024}; pg8::StaticOrder So; So.init(S, 768, F.G, (int)blockIdx.x);
              EpiQUp E{F.QM, F.SSQ_Q + l * S, F.ROPEC, F.ROPES};
              pg8::gemm_phase<EpiQUp, pg8::StaticOrder, true, true>(F.lds + RING_OFF, g, So, E); }
            set_ptrs(F, args.ws);
            { pg8::Gemm g{F.P + C_CKV, F.Wkv + (size_t)l * 1024 * 512, S, 1024, 512, PP, 512}; pg8::StaticOrder So; So.init(S, 1024, F.G, (int)blockIdx.x);
              EpiKvUp E{F.KVM, F.SSQ_KV + l * S};
              pg8::gemm_phase<EpiKvUp, pg8::StaticOrder, true, true>(F.lds + RING_OFF, g, So, E); }
        } }
        SEAM(pb + 2);
        { if (IN(pb + 3)) { set_ptrs(F, args.ws); attn_phase(F, args, l, 0); if (ATTN_MFMA_MASK != 7) { __syncthreads(); naive_attn_phase(F, args, l); } } }
        SEAM(pb + 3);
        { if (IN(pb + 4)) {
            { set_ptrs(F, args.ws); pg8::Gemm g{F.Y, F.Wproj + (size_t)l * DM * YW, S, DM, YW, YW, YW}; pg8::StaticOrder So; So.init(S, DM, F.G, (int)blockIdx.x);
              EpiProjFused E{F.GT, F.MBF, 16, 24}; pg8::gemm_phase<EpiProjFused, pg8::StaticOrder, true, true>(F.lds + RING_OFF, g, So, E); }
        } }
        SEAM(pb + 4);
        { if (IN(pb + 5)) { set_ptrs(F, args.ws);
            pg8::Gemm g{F.MBF, F.Wout + (size_t)l * DM * DM, S, DM, DM, DM, DM}; pg8::StaticOrder So; So.init(S, DM, F.G, (int)blockIdx.x);
            EpiOut E{(l == 0) ? args.x : F.X1, (l == 0) ? F.X1 : args.out, F.XB, F.SSQ_X + l * S, F.ROWMAX + l * S, false, true, l == DEPTH - 1, l > 0, l < DEPTH - 1};
            pg8::gemm_phase<EpiOut, pg8::StaticOrder, true, true>(F.lds + RING_OFF, g, So, E);
        } }
        SEAM(pb + 5);
    }
    if (IN(14)) { set_ptrs(F, args.ws); final_norm(F, F.XB, F.SSQ_X + (DEPTH - 1) * S, args.out, args.final_g); }
#undef IN
#undef SEAM
}

extern "C" void kernel_launch(void* const* d_in, const int* in_sizes, int n_in, void* d_out, int out_size, void* d_ws, size_t ws_size, hipStream_t stream) {
    static int grid = 0;
    if (grid == 0) {
        if (n_in != 14 || in_sizes[0] != S * DM || out_size != S * DM || ws_size < WS_END) { fprintf(stderr, "kernel_launch: unexpected shapes (n_in %d, in0 %d, out %d, ws %zu)\n", n_in, n_in > 0 ? in_sizes[0] : -1, out_size, ws_size); grid = -1; return; }
        int dev = 0, cus = 0, per_cu = 0;
        if (hipGetDevice(&dev) != hipSuccess || hipDeviceGetAttribute(&cus, hipDeviceAttributeMultiprocessorCount, dev) != hipSuccess) { grid = -1; return; }
        if (hipFuncSetAttribute((const void*)hybrid_fwd, hipFuncAttributeMaxDynamicSharedMemorySize, LDS_BYTES) != hipSuccess) { fprintf(stderr, "kernel_launch: hipFuncSetAttribute failed\n"); grid = -1; return; }
        if (hipOccupancyMaxActiveBlocksPerMultiprocessor(&per_cu, (const void*)hybrid_fwd, NWAVES * 64, LDS_BYTES) != hipSuccess || per_cu < 1)
            fprintf(stderr, "kernel_launch: occupancy query reports %d workgroups per CU\n", per_cu);
        (void)hipGetLastError();
        grid = cus;
    }
    if (grid < 0) return;
    if (hipMemsetAsync((char*)d_ws + WS_CTL, 0, CTL_ZERO_BYTES, stream) != hipSuccess) { fprintf(stderr, "kernel_launch: memset failed\n"); return; }
    Args a{};
    a.x = (const float*)d_in[0]; a.norm_g = (const float*)d_in[1]; a.w_in = (const float*)d_in[2]; a.sinks = (const float*)d_in[3]; a.rel_bias = (const float*)d_in[4];
    a.g_q = (const float*)d_in[5]; a.w_q_up = (const float*)d_in[6]; a.g_kv = (const float*)d_in[7]; a.w_kv_up = (const float*)d_in[8];
    a.w_pa = (const float*)d_in[9]; a.w_pb = (const float*)d_in[10]; a.w_pc = (const float*)d_in[11]; a.w_out = (const float*)d_in[12]; a.final_g = (const float*)d_in[13];
    a.out = (float*)d_out; a.ws = (unsigned char*)d_ws;
    constexpr int NPH = 15;
    if (MK_PER_PHASE) {
        for (int p = 0; p < NPH; ++p) { a.ph_lo = p; a.ph_hi = p + 1; hipLaunchKernelGGL(hybrid_fwd, dim3(grid), dim3(NWAVES * 64), LDS_BYTES, stream, a); }
    } else {
        a.ph_lo = 0; a.ph_hi = NPH;
        hipLaunchKernelGGL(hybrid_fwd, dim3(grid), dim3(NWAVES * 64), LDS_BYTES, stream, a);
    }
    const hipError_t le = hipPeekAtLastError();
    if (le != hipSuccess) fprintf(stderr, "kernel_launch: launch failed: %s\n", hipGetErrorName(le));
}
```

```cpp
#include <hip/hip_runtime.h>
#include <cstdio>
#include <cstdint>

#ifndef MK_PER_PHASE
#define MK_PER_PHASE 0
#endif
#ifndef ATTN_MFMA_MASK
#define ATTN_MFMA_MASK 7
#endif

namespace pg8 {
#define PG8_LAS __attribute__((address_space(3)))
typedef unsigned short bf16_t;
typedef short bf16x8 __attribute__((ext_vector_type(8)));
typedef float f32x4 __attribute__((ext_vector_type(4)));
typedef float f32x2 __attribute__((ext_vector_type(2)));
typedef unsigned u32x4 __attribute__((ext_vector_type(4)));
typedef unsigned u32x2 __attribute__((ext_vector_type(2)));
typedef int i32x4 __attribute__((ext_vector_type(4)));
constexpr int BM = 256, BK = 64, HALF = 128, HTB = HALF * BK * 2, STAGE_BYTES = 8 * HTB, NXCD = 8, WGM = 8;

__host__ __device__ __forceinline__ int lds_byte(int r, int c) { const int st = (r >> 4) * 2 + (c >> 5), rr = r & 15, cc = c & 31, ob = rr * 64 + cc * 2; return st * 1024 + (ob ^ (((ob >> 9) & 1) << 5)); }
__host__ __device__ __forceinline__ void stage_rc(int b, int& R, int& C) { const int st = b / 1024, sb = b % 1024, swz = sb ^ (((sb >> 9) & 1) << 5); R = (st >> 1) * 16 + swz / 64; C = (st & 1) * 32 + (swz % 64) / 2; }
__host__ __device__ __forceinline__ int perm32(int rho) { const int n = rho >> 4, i = rho & 15; return 8 * (i >> 2) + 4 * n + (i & 3); }

struct Unit { int pm, pn; };
struct Gemm { const bf16_t* A; const bf16_t* Bt; int M, N, K, lda, ldb; };

struct StaticOrder {
    int nM, nN, nwg, G, c;
    __host__ __device__ void init(int M, int N, int G_, int c_) { nM = M / BM; nN = N / BM; nwg = nM * nN; G = G_; c = c_; }
    __host__ __device__ bool next(int i, Unit& u) const {
        const long L = (long)i * G + c; if (L >= nwg) return false;
        int wgid = (int)L; { const int q = nwg / NXCD, r = nwg % NXCD, xcd = wgid % NXCD, off = wgid / NXCD; wgid = (xcd < r ? xcd * (q + 1) : r * (q + 1) + (xcd - r) * q) + off; }
        const int nig = WGM * nN, gid = wgid / nig, fm = gid * WGM, gsz = (nM - fm) < WGM ? (nM - fm) : WGM;
        u.pm = fm + ((wgid % nig) % gsz); u.pn = (wgid % nig) / gsz; return true;
    }
    __device__ __forceinline__ void a_ready(const Unit&) const {}
    __device__ __forceinline__ void done(const Unit&) const {}
};

__device__ __forceinline__ unsigned cvt_pk_bf16(float lo, float hi) { unsigned r; asm volatile("v_cvt_pk_bf16_f32 %0, %1, %2" : "=v"(r) : "v"(lo), "v"(hi)); return r; }
__device__ __forceinline__ unsigned cvt_pk_f16(float lo, float hi) { typedef _Float16 h2 __attribute__((ext_vector_type(2))); h2 v; v.x = (_Float16)lo; v.y = (_Float16)hi; return __builtin_bit_cast(unsigned, v); }
__device__ __forceinline__ float bf_lo(unsigned w) { return __uint_as_float(w << 16); }
__device__ __forceinline__ float bf_hi(unsigned w) { return __uint_as_float(w & 0xffff0000u); }

__device__ __forceinline__ f32x4 mma16(bf16x8 b, bf16x8 a, f32x4 c) { return __builtin_amdgcn_mfma_f32_16x16x32_bf16(b, a, c, 0, 0, 0); }
__device__ __forceinline__ i32x4 mma16(bf16x8 b, bf16x8 a, i32x4 c) { return __builtin_amdgcn_mfma_i32_16x16x64_i8(__builtin_bit_cast(i32x4, b), __builtin_bit_cast(i32x4, a), c, 0, 0, 0); }
template <class Epi, class Sched, bool ALIGN_EPI = false, bool SP2 = false>
__device__ __forceinline__ void gemm_phase(PG8_LAS unsigned char* lds, const Gemm g, const Sched& S, const Epi& E) {
    int tid = threadIdx.x; asm volatile("" : "+v"(tid));
    const int wid = __builtin_amdgcn_readfirstlane(tid >> 6), lane = tid & 63, wr = wid >> 2, wc = wid & 3, fr = lane & 15, fq = lane >> 4;
    const int K = g.K, nt = K / BK;
    unsigned voffA[2], voffB[2];
#pragma unroll
    for (int i = 0; i < 2; ++i) { int R, C; stage_rc(tid * 16 + i * 8192, R, C); const int Rb = Epi::PERM ? ((R & ~31) + perm32(R & 31)) : R;
        voffA[i] = (unsigned)(R * g.lda + C) * 2u; voffB[i] = (unsigned)(Rb * g.ldb + C) * 2u; }
    const size_t kstep = (size_t)(BK * 2);
    const size_t hstepA = (size_t)HALF * g.lda * 2, hstepB = (size_t)HALF * g.ldb * 2;
    const size_t tstepA = 2 * hstepA, tstepB = 2 * hstepB;
    const unsigned ldsw = (unsigned)wid * 1024u;
    const int aoff = lds_byte(wr * 64 + fr, fq * 8), boff = lds_byte(wc * 32 + fr, fq * 8);
#define PG8_SA(b, h) (((b) * 2 + (h)) * HTB)
#define PG8_SB(b, h) ((4 + (b) * 2 + (h)) * HTB)
#define PG8_STAGE(bufoff, gbase, voff) do { _Pragma("unroll") for (int _i = 0; _i < 2; ++_i) \
        __builtin_amdgcn_global_load_lds((const unsigned*)((const char*)(gbase) + (voff)[_i]), (PG8_LAS unsigned*)(lds + (bufoff) + ldsw + _i * 8192), 16, 0, 0); } while (0)
#define PG8_LDA(dst, b, h) do { _Pragma("unroll") for (int m = 0; m < 4; ++m) _Pragma("unroll") for (int k = 0; k < 2; ++k) dst[m][k] = *(const PG8_LAS bf16x8*)(lds + PG8_SA(b, h) + aoff + m * 2048 + k * 1024); } while (0)
#define PG8_LDB(dst, b, h) do { _Pragma("unroll") for (int n = 0; n < 2; ++n) _Pragma("unroll") for (int k = 0; k < 2; ++k) dst[n][k] = *(const PG8_LAS bf16x8*)(lds + PG8_SB(b, h) + boff + n * 2048 + k * 1024); } while (0)
#define PG8_MMA(ai, bj, At, Bt) do { __builtin_amdgcn_s_setprio(1); _Pragma("unroll") for (int m = 0; m < 4; ++m) _Pragma("unroll") for (int n = 0; n < 2; ++n) _Pragma("unroll") for (int k = 0; k < 2; ++k) \
        acc[ai][bj][m][n] = mma16(Bt[n][k], At[m][k], acc[ai][bj][m][n]); __builtin_amdgcn_s_setprio(0); } while (0)
#define PG8_WAIT_V(n) asm volatile("s_waitcnt vmcnt(" #n ")" ::: "memory")
#define PG8_WAIT_L(n) asm volatile("s_waitcnt lgkmcnt(" #n ")" ::: "memory")
#define PG8_BAR __builtin_amdgcn_s_barrier()
#define PG8_SCHED __builtin_amdgcn_sched_barrier(0)
    Unit cur, nxt; int ui = 0;
    if (!S.next(0, cur)) return;
    typedef typename Epi::acc_t acc_t;
    acc_t acc[2][2][4][2];
#pragma unroll
    for (int a = 0; a < 2; ++a)
#pragma unroll
        for (int b = 0; b < 2; ++b)
#pragma unroll
            for (int m = 0; m < 4; ++m)
#pragma unroll
                for (int n = 0; n < 2; ++n) acc[a][b][m][n] = (acc_t){0, 0, 0, 0};
    bf16x8 At[4][2], B0[2][2], B1[2][2];
    const char* cA = (const char*)g.A + (size_t)cur.pm * tstepA; const char* cB = (const char*)g.Bt + (size_t)cur.pn * tstepB;
    S.a_ready(cur);
    if constexpr (SP2) {
        PG8_STAGE(PG8_SB(0, 0), cB, voffB); PG8_STAGE(PG8_SB(0, 1), cB + hstepB, voffB); PG8_STAGE(PG8_SA(0, 0), cA, voffA); PG8_STAGE(PG8_SA(0, 1), cA + hstepA, voffA);
        if (wr == 1) PG8_BAR;
        PG8_WAIT_V(2); PG8_BAR;
        PG8_STAGE(PG8_SB(1, 0), cB + kstep, voffB); PG8_STAGE(PG8_SA(1, 0), cA + kstep, voffA); PG8_STAGE(PG8_SB(1, 1), cB + hstepB + kstep, voffB);
        PG8_WAIT_V(6); PG8_BAR;
    } else {
        PG8_STAGE(PG8_SB(0, 0), cB, voffB); PG8_STAGE(PG8_SA(0, 0), cA, voffA); PG8_STAGE(PG8_SB(0, 1), cB + hstepB, voffB); PG8_STAGE(PG8_SA(0, 1), cA + hstepA, voffA);
        if (wr == 1) PG8_BAR;
        PG8_WAIT_V(4); PG8_BAR;
        PG8_STAGE(PG8_SB(1, 0), cB + kstep, voffB); PG8_STAGE(PG8_SA(1, 0), cA + kstep, voffA); PG8_STAGE(PG8_SB(1, 1), cB + hstepB + kstep, voffB);
        PG8_WAIT_V(6); PG8_BAR;
    }
    for (;;) {
        const bool has_next = S.next(ui + 1, nxt);
        const char* nA = has_next ? (const char*)g.A + (size_t)nxt.pm * tstepA : cA; const char* nB = has_next ? (const char*)g.Bt + (size_t)nxt.pn * tstepB : cB;
        for (int t = 0; t < nt; t += 2) {
            const bool last = (t == nt - 2);
            const char* a1 = cA + (size_t)(t + 1) * kstep;
            const char* a2 = last ? nA : cA + (size_t)(t + 2) * kstep; const char* b2 = last ? nB : cB + (size_t)(t + 2) * kstep;
            const char* a3 = a2 + kstep; const char* b3 = b2 + kstep;
            if (last && has_next) S.a_ready(nxt);
            if constexpr (Epi::MID) { if (t == E.t1 || t == E.t2) E.mid(acc, cur, t == E.t2, wr, wc, fr, fq); }
            if constexpr (SP2) {
            PG8_LDB(B0, 0, 0); PG8_LDB(B1, 0, 1); PG8_SCHED; PG8_LDA(At, 0, 0); PG8_STAGE(PG8_SA(1, 1), a1 + hstepA, voffA);
            PG8_WAIT_V(8); PG8_WAIT_L(0); PG8_BAR; PG8_MMA(0, 0, At, B0); PG8_MMA(0, 1, At, B1); PG8_BAR; PG8_SCHED;
            PG8_LDA(At, 0, 1); PG8_STAGE(PG8_SB(0, 0), b2, voffB); PG8_STAGE(PG8_SB(0, 1), b2 + hstepB, voffB); PG8_STAGE(PG8_SA(0, 0), a2, voffA);
            PG8_WAIT_V(8); PG8_WAIT_L(0); PG8_BAR; PG8_MMA(1, 0, At, B0); PG8_MMA(1, 1, At, B1); PG8_BAR; PG8_SCHED;
            PG8_LDB(B0, 1, 0); PG8_LDB(B1, 1, 1); PG8_SCHED; PG8_LDA(At, 1, 0); PG8_STAGE(PG8_SA(0, 1), a2 + hstepA, voffA);
            PG8_WAIT_V(8); PG8_WAIT_L(0); PG8_BAR; PG8_MMA(0, 0, At, B0); PG8_MMA(0, 1, At, B1); PG8_BAR; PG8_SCHED;
            PG8_LDA(At, 1, 1); PG8_STAGE(PG8_SB(1, 0), b3, voffB); PG8_STAGE(PG8_SB(1, 1), b3 + hstepB, voffB); PG8_STAGE(PG8_SA(1, 0), a3, voffA);
            PG8_WAIT_V(8); PG8_WAIT_L(0); PG8_BAR; PG8_MMA(1, 0, At, B0); PG8_MMA(1, 1, At, B1); PG8_BAR; PG8_SCHED;
            } else {
            PG8_LDB(B0, 0, 0); PG8_SCHED; PG8_LDA(At, 0, 0); PG8_STAGE(PG8_SA(1, 1), a1 + hstepA, voffA);
            PG8_WAIT_L(8); PG8_BAR; PG8_WAIT_L(0); PG8_MMA(0, 0, At, B0); PG8_BAR; PG8_SCHED;
            PG8_LDB(B1, 0, 1); PG8_STAGE(PG8_SB(0, 0), b2, voffB);
            PG8_BAR; PG8_WAIT_L(0); PG8_MMA(0, 1, At, B1); PG8_BAR;
            PG8_LDA(At, 0, 1); PG8_STAGE(PG8_SA(0, 0), a2, voffA);
            PG8_BAR; PG8_WAIT_L(0); PG8_MMA(1, 0, At, B0); PG8_BAR; PG8_SCHED;
            PG8_STAGE(PG8_SB(0, 1), b2 + hstepB, voffB);
            PG8_WAIT_V(6); PG8_BAR; PG8_MMA(1, 1, At, B1); PG8_BAR;
            PG8_LDB(B0, 1, 0); PG8_SCHED; PG8_LDA(At, 1, 0); PG8_STAGE(PG8_SA(0, 1), a2 + hstepA, voffA);
            PG8_WAIT_L(8); PG8_BAR; PG8_WAIT_L(0); PG8_MMA(0, 0, At, B0); PG8_BAR; PG8_SCHED;
            PG8_LDB(B1, 1, 1); PG8_STAGE(PG8_SB(1, 0), b3, voffB);
            PG8_BAR; PG8_WAIT_L(0); PG8_MMA(0, 1, At, B1); PG8_BAR;
            PG8_LDA(At, 1, 1); PG8_STAGE(PG8_SA(1, 0), a3, voffA);
            PG8_BAR; PG8_WAIT_L(0); PG8_MMA(1, 0, At, B0); PG8_BAR; PG8_SCHED;
            PG8_STAGE(PG8_SB(1, 1), b3 + hstepB, voffB);
            PG8_WAIT_V(6); PG8_BAR; PG8_MMA(1, 1, At, B1); PG8_BAR;
            }
        }
        if constexpr (ALIGN_EPI) { if (wr == 0) PG8_BAR; }
        E(acc, cur, wr, wc, fr, fq); S.done(cur);
        if (!has_next) break;
#pragma unroll
        for (int a = 0; a < 2; ++a)
#pragma unroll
            for (int b = 0; b < 2; ++b)
#pragma unroll
                for (int m = 0; m < 4; ++m)
#pragma unroll
                    for (int n = 0; n < 2; ++n) acc[a][b][m][n] = (acc_t){0, 0, 0, 0};
        cur = nxt; cA = nA; cB = nB; ++ui;
        if constexpr (ALIGN_EPI) { if (wr == 1) PG8_BAR; }
    }
    PG8_WAIT_V(0);
    if constexpr (!ALIGN_EPI) { if (wr == 0) PG8_BAR; }
    PG8_BAR;
#undef PG8_SA
#undef PG8_SB
#undef PG8_STAGE
#undef PG8_LDA
#undef PG8_LDB
#undef PG8_MMA
#undef PG8_WAIT_V
#undef PG8_WAIT_L
#undef PG8_BAR
#undef PG8_SCHED
}
}

constexpr int NWAVES = 8;
constexpr int S = 16384, DM = 4096, DEPTH = 2;
constexpr int PP = 6656;
constexpr int NP = 19200;
constexpr int IN_COLS = 19008;
constexpr int NB = 2816;
constexpr int NG = 16384;
__host__ __device__ constexpr int bf_tile_col(int t) { return t < 1 ? 1280 : t < 5 ? 3584 + 256 * (t - 1) : 5120 + 256 * (t - 5); }
constexpr int C_QA = 0, C_KA = 1024, C_VA = 1280, C_ZA = 1536, C_CQ = 2560, C_CKV = 3584, C_ZB = 4096, C_QC = 4608, C_KC = 5120, C_VC = 5632, C_ZC = 6144,
              C_GA = 6656, C_GB = 10752, C_GC = 14848, C_KR = 18944;
constexpr float EPS = 1e-6f;
constexpr float LOG2E = 1.4426950408889634f;
constexpr float SC128 = 0.08838834764831845f * LOG2E;
constexpr float SC192 = 0.07216878364870322f * LOG2E;
constexpr int YW = 2048;

constexpr size_t MiB = 1u << 20;
constexpr size_t WS_CTL = 0, CTL_ZERO_BYTES = 1 * MiB;
constexpr size_t WS_RS = 1 * MiB;
constexpr size_t WS_RSQ = WS_RS + 65536, WS_RSKV = WS_RSQ + 65536;
constexpr size_t WS_ROPEC = 2 * MiB, WS_ROPES = 4 * MiB;
constexpr size_t WS_WQ = 6 * MiB;
constexpr size_t WS_WKV = 10 * MiB;
constexpr size_t WS_WPROJ = 16 * MiB;
constexpr size_t WS_WOUT = 48 * MiB;
constexpr size_t WS_WIN = 112 * MiB;
constexpr size_t WS_WG8 = 216 * MiB;
constexpr size_t WS_XQ = 344 * MiB;
constexpr size_t WS_SA = WS_RS + 3 * 65536;
constexpr size_t WS_SB = WS_RS + 4 * 65536;
constexpr size_t WS_XB = 416 * MiB;
constexpr size_t WS_P = 544 * MiB;
constexpr size_t WS_GT = 752 * MiB;
constexpr size_t WS_QM = 1144 * MiB;
constexpr size_t WS_KVM = 1168 * MiB;
constexpr size_t WS_KRM = 1200 * MiB;
constexpr size_t WS_Y = 1204 * MiB;
constexpr size_t WS_MBF = 1524 * MiB;
constexpr size_t WS_X1 = 1652 * MiB;
constexpr size_t WS_OPART = 1908 * MiB;
constexpr size_t WS_ML = 2036 * MiB;
constexpr size_t WS_END = 2040 * MiB;
static_assert(WS_WIN + (size_t)2 * NB * DM * 2 <= WS_WG8 && WS_WG8 + (size_t)2 * NG * DM <= WS_XQ && WS_XQ + (size_t)S * DM <= WS_XB && WS_P + (size_t)S * PP * 2 <= WS_GT && WS_GT + (size_t)3 * S * DM * 2 <= WS_QM && WS_SB + 2 * NG * 4 <= WS_ROPEC, "ws map");
constexpr int CW_TMO = 0, CW_CODE = 1;
constexpr int CW_BAR = 4096;
constexpr int CW_MLACNT = 20480;
constexpr int CW_QUEUE = 16384;
constexpr size_t CTL_COLMAX = 640 * 1024;
constexpr size_t CTL_BLUT = 896 * 1024;
constexpr size_t CTL_ROWMAX = 768 * 1024;
constexpr size_t CTL_SSQ_Q = 256 * 1024, CTL_SSQ_KV = 384 * 1024, CTL_SSQ_X = 512 * 1024;

constexpr int RING_OFF = 0, RING_BYTES = 131072;
constexpr int LDSCTL_OFF = RING_BYTES, MISC_OFF = LDSCTL_OFF + 320;
constexpr int LDS_BYTES = 147456;

#define GAS __attribute__((address_space(1)))
#define LAS __attribute__((address_space(3)))
typedef unsigned short bf16;
typedef unsigned v4u __attribute__((ext_vector_type(4)));
typedef unsigned v2u __attribute__((ext_vector_type(2)));
typedef float f32x4 __attribute__((ext_vector_type(4)));
typedef float f32x2 __attribute__((ext_vector_type(2)));
typedef short bf16x8 __attribute__((ext_vector_type(8)));
typedef GAS unsigned gu32;
#define RLX_AGENT __ATOMIC_RELAXED, __HIP_MEMORY_SCOPE_AGENT
#define LDS_WAIT() asm volatile("s_waitcnt lgkmcnt(0)" ::: "memory")
#define VM_WAIT() asm volatile("s_waitcnt vmcnt(0)" ::: "memory")
__device__ __forceinline__ unsigned f2bf(float f) { unsigned u = __builtin_bit_cast(unsigned, f); return (u + 0x7fffu + ((u >> 16) & 1u)) >> 16; }
__device__ __forceinline__ unsigned pk2(float lo, float hi) { return f2bf(lo) | (f2bf(hi) << 16); }
__device__ __forceinline__ float bf2f(unsigned short b) { return __uint_as_float(((unsigned)b) << 16); }

#define XB_TMO      128
#define XB_XCNT(j)  (256  + 64 * (j))
#define XB_XSUB(j)  (1280 + 64 * (j))
#define XB_XGEN(j)  (2304 + 64 * (j))
#define XB_TOP      3328
#define XB_TOPGEN   3392
#define XCD_BAR_WORDS 3456
#define XB_SPIN_CAP (1u << 18)
__device__ __forceinline__ unsigned xb_ld(unsigned* p)              { return __hip_atomic_load(p, __ATOMIC_RELAXED, __HIP_MEMORY_SCOPE_AGENT); }
__device__ __forceinline__ unsigned xb_add(unsigned* p, unsigned v) { return __hip_atomic_fetch_add(p, v, __ATOMIC_RELAXED, __HIP_MEMORY_SCOPE_AGENT); }
__device__ __forceinline__ unsigned xb_xcc_id() { return (unsigned)__builtin_amdgcn_s_getreg((3 << 11) | 20) & 0xFu; }
#define XB_SPIN(cond, bar) do { unsigned _sp = 0; while (cond) { __builtin_amdgcn_s_sleep(1); \
    if ((++_sp & 255u) == 0u) { if (xb_ld(&(bar)[XB_TMO])) break; if (_sp > XB_SPIN_CAP) { atomicAdd(&(bar)[XB_TMO], 1u); break; } } } } while (0)
struct XcdBarrier { unsigned* bar; unsigned x; volatile LAS unsigned* st; };
__device__ __forceinline__ XcdBarrier xcd_barrier_post(unsigned* bar, volatile LAS unsigned* st) {
    XcdBarrier b; b.bar = bar; b.x = xb_xcc_id(); b.st = st;
    if (threadIdx.x == 0) (void)xb_add(&bar[XB_XCNT(b.x)], 1u);
    return b;
}
__device__ __forceinline__ void xcd_barrier_complete(unsigned* bar, unsigned x, unsigned& nloc, unsigned& nx) {
    const unsigned G = gridDim.x * gridDim.y * gridDim.z;
    unsigned sum, cnt, mine, sp = 0u;
    for (;;) {
        sum = 0u; cnt = 0u; mine = 0u;
#pragma unroll
        for (unsigned j = 0; j < 16; ++j) { const unsigned c = xb_ld(&bar[XB_XCNT(j)]); sum += c; cnt += (c > 0u) ? 1u : 0u; mine = (j == x) ? c : mine; }
        if (sum == G) break;
        __builtin_amdgcn_s_sleep(1);
        if ((++sp & 255u) == 0u) { if (xb_ld(&bar[XB_TMO])) break; if (sp > XB_SPIN_CAP) { atomicAdd(&bar[XB_TMO], 1u); break; } }
    }
    nloc = mine > 0u ? mine : 1u; nx = cnt > 0u ? cnt : 1u;
}
__device__ __forceinline__ void xcd_barrier(const XcdBarrier& b) {
    asm volatile("s_waitcnt vmcnt(0)" ::: "memory");
    __syncthreads();
    if (threadIdx.x == 0) {
        unsigned* bar = b.bar;
        __builtin_amdgcn_s_waitcnt(0);
        unsigned nloc = b.st[0], nx = b.st[1];
        if (nloc == 0u) { xcd_barrier_complete(bar, b.x, nloc, nx); b.st[0] = nloc; b.st[1] = nx; }
        const unsigned old = xb_add(&bar[XB_XSUB(b.x)], 1u);
        const unsigned gen = old / nloc;
        if (old + 1u == (gen + 1u) * nloc) {
            __builtin_amdgcn_fence(__ATOMIC_RELEASE, "agent");
            asm volatile("s_waitcnt vmcnt(0)" ::: "memory");
            const unsigned og = xb_add(&bar[XB_TOP], 1u);
            const unsigned tg = og / nx;
            if (og + 1u == (tg + 1u) * nx) xb_add(&bar[XB_TOPGEN], 1u);
            else XB_SPIN(xb_ld(&bar[XB_TOPGEN]) == tg, bar);
            __builtin_amdgcn_fence(__ATOMIC_ACQUIRE, "agent");
            xb_add(&bar[XB_XGEN(b.x)], 1u);
            asm volatile("s_waitcnt vmcnt(0)" ::: "memory");
        } else {
            XB_SPIN(xb_ld(&bar[XB_XGEN(b.x)]) == gen, bar);
            __builtin_amdgcn_fence(__ATOMIC_ACQUIRE, "agent");
            asm volatile("s_waitcnt vmcnt(0)" ::: "memory");
        }
    }
    __syncthreads();
}

struct Args {
    const float* x; const float* norm_g; const float* w_in; const float* sinks; const float* rel_bias; const float* g_q; const float* w_q_up; const float* g_kv; const float* w_kv_up;
    const float* w_pa; const float* w_pb; const float* w_pc; const float* w_out; const float* final_g;
    float* out; unsigned char* ws; int ph_lo, ph_hi;
};
struct Frame {
    LAS unsigned char* lds;
    gu32* ctl;
    int tid, lane, wave, G, gw, NGW;
    bf16 *Win, *Wout, *Wproj, *Wq, *Wkv, *XB, *P, *QM, *KVM, *KRM, *Y, *MBF; unsigned char* GT; signed char *WG8, *XQ; float *SA, *SB; unsigned* COLMAX;
    float *RS, *RSQ, *RSKV, *ROPEC, *ROPES, *X1, *OPART, *ML, *SSQ_Q, *SSQ_KV, *SSQ_X, *BLUT; unsigned* ROWMAX;
};
__device__ __forceinline__ void set_ptrs(Frame& F, unsigned char* ws_) {
    GAS unsigned char* wsg = (GAS unsigned char*)ws_; asm volatile("" : "+s"(wsg)); unsigned char* ws = (unsigned char*)wsg;
    { int t = threadIdx.x; asm volatile("" : "+v"(t)); F.tid = t; F.lane = t & 63; F.wave = __builtin_amdgcn_readfirstlane(t >> 6); F.gw = blockIdx.x * NWAVES + F.wave; }
    F.ctl = (gu32*)(ws + WS_CTL);
    F.Win = (bf16*)(ws + WS_WIN); F.Wout = (bf16*)(ws + WS_WOUT); F.Wproj = (bf16*)(ws + WS_WPROJ); F.Wq = (bf16*)(ws + WS_WQ); F.Wkv = (bf16*)(ws + WS_WKV);
    F.XB = (bf16*)(ws + WS_XB); F.P = (bf16*)(ws + WS_P); F.QM = (bf16*)(ws + WS_QM); F.KVM = (bf16*)(ws + WS_KVM); F.KRM = (bf16*)(ws + WS_KRM); F.Y = (bf16*)(ws + WS_Y); F.MBF = (bf16*)(ws + WS_MBF); F.GT = ws + WS_GT;
    F.RS = (float*)(ws + WS_RS); F.RSQ = (float*)(ws + WS_RSQ); F.RSKV = (float*)(ws + WS_RSKV); F.ROPEC = (float*)(ws + WS_ROPEC); F.ROPES = (float*)(ws + WS_ROPES);
    F.X1 = (float*)(ws + WS_X1); F.OPART = (float*)(ws + WS_OPART); F.ML = (float*)(ws + WS_ML);
    F.WG8 = (signed char*)(ws + WS_WG8); F.XQ = (signed char*)(ws + WS_XQ); F.SA = (float*)(ws + WS_SA); F.SB = (float*)(ws + WS_SB); F.COLMAX = (unsigned*)(ws + WS_CTL + CTL_COLMAX);
    F.SSQ_Q = (float*)(ws + WS_CTL + CTL_SSQ_Q); F.SSQ_KV = (float*)(ws + WS_CTL + CTL_SSQ_KV); F.SSQ_X = (float*)(ws + WS_CTL + CTL_SSQ_X); F.ROWMAX = (unsigned*)(ws + WS_CTL + CTL_ROWMAX); F.BLUT = (float*)(ws + WS_CTL + CTL_BLUT);
}
__device__ __forceinline__ float wave_sum(float v) {
#pragma unroll
    for (int o = 1; o < 64; o <<= 1) v += __shfl_xor(v, o);
    return v;
}
__device__ __forceinline__ float wave_max(float v) {
#pragma unroll
    for (int o = 1; o < 64; o <<= 1) v = fmaxf(v, __shfl_xor(v, o));
    return v;
}

__device__ const unsigned char T5B[128] = {0, 1, 2, 3, 4, 5, 6, 7, 8, 9, 10, 11, 12, 13, 14, 15, 16, 16, 16, 17, 17, 18, 18, 18, 19, 19, 19, 20, 20, 20, 20, 21, 21, 21, 21, 22, 22, 22, 22, 22, 23, 23, 23, 23, 23, 23, 24, 24, 24, 24, 24, 24, 25, 25, 25, 25, 25, 25, 25, 26, 26, 26, 26, 26, 26, 26, 26, 27, 27, 27, 27, 27, 27, 27, 27, 27, 27, 28, 28, 28, 28, 28, 28, 28, 28, 28, 28, 29, 29, 29, 29, 29, 29, 29, 29, 29, 29, 29, 29, 30, 30, 30, 30, 30, 30, 30, 30, 30, 30, 30, 30, 30, 30, 31, 31, 31, 31, 31, 31, 31, 31, 31, 31, 31, 31, 31, 31, 31};

__device__ const float ROPE_INV[32] = {1.000000000e+00f, 7.498942614e-01f, 5.623413324e-01f, 4.216965139e-01f, 3.162277639e-01f, 2.371373773e-01f, 1.778279394e-01f, 1.333521307e-01f, 1.000000015e-01f, 7.498941571e-02f, 5.623413250e-02f, 4.216965288e-02f, 3.162277490e-02f, 2.371373773e-02f, 1.778279431e-02f, 1.333521493e-02f, 9.999999776e-03f, 7.498941850e-03f, 5.623413250e-03f, 4.216964822e-03f, 3.162277630e-03f, 2.371373586e-03f, 1.778279431e-03f, 1.333521446e-03f, 1.000000047e-03f, 7.498942432e-04f, 5.623413017e-04f, 4.216965172e-04f, 3.162277571e-04f, 2.371373703e-04f, 1.778279402e-04f, 1.333521504e-04f};
template <int MAP> __device__ __forceinline__ int src_col(int n) {
    if (MAP == 1) { const int pc = bf_tile_col(n >> 8) + (n & 255); return pc < 4096 ? pc : pc + 64; }
    if (MAP == 3) {
        if (n < 12288) return 6720 + n; if (n < 13312) return n - 12288; if (n < 14336) return 2560 + (n - 13312); if (n < 14592) return 1024 + (n - 14336); if (n < 15104) return 4672 + (n - 14592);
        if (n >= 15360) return 1536 + (n - 15360);
        const int r = n - 15104; return r < 64 ? 4096 + ((r & 1) ? 32 + (r >> 1) : (r >> 1)) : -1; }
    if (MAP == 2) { const int h = n / 192, c = n % 192; if (c < 128) return n; const int j = c - 128; return h * 192 + 128 + ((j & 1) ? 32 + (j >> 1) : (j >> 1)); }
    return n;
}
template <int MAP>
__device__ __forceinline__ void conv_item(const float* W, int Nsrc, const float* g, bf16* WT, int ldd, int dk0, int nblk, LAS float* scr, int item, int lane) {
    const int kb = item / nblk, nb = item % nblk, k0 = 64 * kb, n0 = 32 * nb;
    const int sc = src_col<MAP>(n0 + (lane & 31));
    const GAS float* wp = (const GAS float*)W + (size_t)(k0 + (lane >> 5)) * Nsrc + (sc >= 0 ? sc : 0);
    float v[32];
#pragma unroll
    for (int i = 0; i < 32; ++i) v[i] = __builtin_nontemporal_load(wp + (size_t)(2 * i) * Nsrc);
    const int c = lane & 7;
    f32x4 g0 = {1.f, 1.f, 1.f, 1.f}, g1 = {1.f, 1.f, 1.f, 1.f};
    if (g) { g0 = *(const GAS f32x4*)(g + k0 + 8 * c); g1 = *(const GAS f32x4*)(g + k0 + 8 * c + 4); }
#pragma unroll
    for (int i = 0; i < 32; ++i) scr[(2 * i + (lane >> 5)) * 33 + (lane & 31)] = (sc >= 0) ? v[i] : 0.f;
    LDS_WAIT(); asm volatile("" ::: "memory");
#pragma unroll
    for (int j = 0; j < 4; ++j) { const int n = (lane >> 3) + 8 * j; const LAS float* s = scr + (8 * c) * 33 + n;
        v4u o; o.x = pk2(s[0 * 33] * g0[0], s[1 * 33] * g0[1]); o.y = pk2(s[2 * 33] * g0[2], s[3 * 33] * g0[3]); o.z = pk2(s[4 * 33] * g1[0], s[5 * 33] * g1[1]); o.w = pk2(s[6 * 33] * g1[2], s[7 * 33] * g1[3]);
        *(GAS v4u*)(WT + (size_t)(n0 + n) * ldd + dk0 + k0 + 8 * c) = o; }
    LDS_WAIT(); asm volatile("" ::: "memory");
}
__device__ __forceinline__ void gate_max_item(const float* W, const float* g, unsigned* colmax, int item, int lane) {
    const int kb = item / (NG / 32), nb = item % (NG / 32), k0 = 64 * kb, n0 = 32 * nb;
    const int sc = src_col<3>(n0 + (lane & 31));
    const GAS float* wp = (const GAS float*)W + (size_t)(k0 + (lane >> 5)) * IN_COLS + (sc >= 0 ? sc : 0);
    float v[32];
#pragma unroll
    for (int i = 0; i < 32; ++i) v[i] = __builtin_nontemporal_load(wp + (size_t)(2 * i) * IN_COLS);
    if (sc < 0) {
#pragma unroll
        for (int i = 0; i < 32; ++i) v[i] = 0.f; }
    float m = 0.f;
#pragma unroll
    for (int i = 0; i < 32; ++i) m = fmaxf(m, fabsf(v[i] * g[k0 + 2 * i + (lane >> 5)]));
    m = fmaxf(m, __shfl_xor(m, 32));
    if (lane < 32) atomicMax(colmax + n0 + lane, __float_as_uint(m));
}
__device__ __forceinline__ void gate_quant_item(const float* W, const float* g, const unsigned* colmax, signed char* WQ, float* sb, LAS float* scr, int item, int lane) {
    const int kb = item / (NG / 32), nb = item % (NG / 32), k0 = 64 * kb, n0 = 32 * nb;
    const int sc = src_col<3>(n0 + (lane & 31));
    const GAS float* wp = (const GAS float*)W + (size_t)(k0 + (lane >> 5)) * IN_COLS + (sc >= 0 ? sc : 0);
    float v[32];
#pragma unroll
    for (int i = 0; i < 32; ++i) v[i] = __builtin_nontemporal_load(wp + (size_t)(2 * i) * IN_COLS);
    if (sc < 0) {
#pragma unroll
        for (int i = 0; i < 32; ++i) v[i] = 0.f; }
    const float cm = __uint_as_float(colmax[n0 + (lane & 31)]); const float inv = cm > 0.f ? 127.0f / cm : 0.f;
    if (kb == 0 && lane < 32) sb[n0 + lane] = cm * (1.0f / 127.0f);
#pragma unroll
    for (int i = 0; i < 32; ++i) { const int kk = 2 * i + (lane >> 5); float q = __builtin_rintf(v[i] * g[k0 + kk] * inv); q = fminf(fmaxf(q, -127.f), 127.f); scr[kk * 33 + (lane & 31)] = q; }
    LDS_WAIT(); asm volatile("" ::: "memory");
    const int n = lane >> 1, hf = lane & 1;
    unsigned w[8];
#pragma unroll
    for (int d = 0; d < 8; ++d) { unsigned x = 0;
#pragma unroll
        for (int b = 0; b < 4; ++b) x |= ((unsigned)(int)scr[(32 * hf + 4 * d + b) * 33 + n] & 0xffu) << (8 * b);
        w[d] = x; }
    GAS v4u* dst = (GAS v4u*)(WQ + (size_t)(n0 + n) * DM + k0 + 32 * hf);
    dst[0] = (v4u){w[0], w[1], w[2], w[3]}; dst[1] = (v4u){w[4], w[5], w[6], w[7]};
    LDS_WAIT(); asm volatile("" ::: "memory");
}
__device__ __forceinline__ void sincos_d(double a, float& sn, float& cs) {
    const double q = __builtin_rint(a * 0.63661977236758134308);
    double r = __builtin_fma(-q, 1.57079632679489655800e+00, a); r = __builtin_fma(-q, 6.12323399573676603587e-17, r);
    const double r2 = r * r;
    double ps = r2 * (1.0 / 6227020800.0) - (1.0 / 39916800.0); ps = ps * r2 + (1.0 / 362880.0); ps = ps * r2 - (1.0 / 5040.0); ps = ps * r2 + (1.0 / 120.0); ps = ps * r2 - (1.0 / 6.0); ps = ps * r2 * r + r;
    double pc = r2 * (1.0 / 87178291200.0) - (1.0 / 479001600.0); pc = pc * r2 + (1.0 / 3628800.0); pc = pc * r2 - (1.0 / 40320.0); pc = pc * r2 + (1.0 / 720.0); pc = pc * r2 - (1.0 / 24.0); pc = pc * r2 + 0.5; pc = 1.0 - pc * r2;
    const int qi = ((int)q) & 3;
    const double s_ = (qi == 0) ? ps : (qi == 1) ? pc : (qi == 2) ? -ps : -pc;
    const double c_ = (qi == 0) ? pc : (qi == 1) ? -ps : (qi == 2) ? -pc : ps;
    sn = (float)s_; cs = (float)c_;
}
__device__ __forceinline__ void p0_prologue(Frame& F, const Args& A) {
    LAS float* scr = (LAS float*)(F.lds + RING_OFF + F.wave * 16384);
    constexpr int I_GM = 64 * (NG / 32), I_IN = 64 * (NB / 32), I_Q = 16 * (768 / 32), I_KV = 8 * (1024 / 32), I_PA = 16 * 128, I_PB = 8 * 128, I_PC = 8 * 128, I_O = 64 * 128;
    constexpr int PER_L = I_GM + I_IN + I_Q + I_KV + I_PA + I_PB + I_PC + I_O;
    for (int it = F.gw; it < DEPTH * PER_L; it += F.NGW) {
        const int l = it / PER_L; int r = it % PER_L;
        if (r < I_GM) { gate_max_item(A.w_in + (size_t)l * DM * IN_COLS, A.norm_g + l * DM, F.COLMAX + l * NG, r, F.lane); continue; } r -= I_GM;
        if (r < I_IN) { conv_item<1>(A.w_in + (size_t)l * DM * IN_COLS, IN_COLS, A.norm_g + l * DM, F.Win + (size_t)l * NB * DM, DM, 0, NB / 32, scr, r, F.lane); continue; } r -= I_IN;
        if (r < I_Q) { conv_item<2>(A.w_q_up + (size_t)l * 1024 * 768, 768, A.g_q + l * 1024, F.Wq + (size_t)l * 768 * 1024, 1024, 0, 768 / 32, scr, r, F.lane); continue; } r -= I_Q;
        if (r < I_KV) { conv_item<0>(A.w_kv_up + (size_t)l * 512 * 1024, 1024, A.g_kv + l * 512, F.Wkv + (size_t)l * 1024 * 512, 512, 0, 1024 / 32, scr, r, F.lane); continue; } r -= I_KV;
        if (r < I_PA) { conv_item<0>(A.w_pa + (size_t)l * 1024 * DM, DM, nullptr, F.Wproj + (size_t)l * DM * YW, YW, 0, 128, scr, r, F.lane); continue; } r -= I_PA;
        if (r < I_PB) { conv_item<0>(A.w_pb + (size_t)l * 512 * DM, DM, nullptr, F.Wproj + (size_t)l * DM * YW, YW, 1024, 128, scr, r, F.lane); continue; } r -= I_PB;
        if (r < I_PC) { conv_item<0>(A.w_pc + (size_t)l * 512 * DM, DM, nullptr, F.Wproj + (size_t)l * DM * YW, YW, 1536, 128, scr, r, F.lane); continue; } r -= I_PC;
        conv_item<0>(A.w_out + (size_t)l * DM * DM, DM, nullptr, F.Wout + (size_t)l * DM * DM, DM, 0, 128, scr, r, F.lane);
    }
    if (blockIdx.x == 0) { for (int i = threadIdx.x; i < 8 * 128; i += NWAVES * 64) F.BLUT[i] = A.rel_bias[(int)T5B[i & 127] * 8 + (i >> 7)] * LOG2E; }
    for (int i = F.gw * 64 + F.lane; i < S * 32; i += F.NGW * 64) {
        const int pos = i >> 5, j = i & 31;
        const float inv = ROPE_INV[j];
        const float ang = (float)pos * inv;
        float sn, cs; sincos_d((double)ang, sn, cs);
        F.ROPEC[i] = cs; F.ROPES[i] = sn;
    }
}
__device__ __forceinline__ void p0b_gate_quant(Frame& F, const Args& A) {
    LAS float* scr = (LAS float*)(F.lds + RING_OFF + F.wave * 16384);
    constexpr int I_GM = 64 * (NG / 32);
    for (int it = F.gw; it < DEPTH * I_GM; it += F.NGW) { const int l = it / I_GM, r = it % I_GM;
        gate_quant_item(A.w_in + (size_t)l * DM * IN_COLS, A.norm_g + l * DM, F.COLMAX + l * NG, F.WG8 + (size_t)l * NG * DM, F.SB + l * NG, scr, r, F.lane); }
}
template <int MODE>
__device__ __forceinline__ void prep_rows(Frame& F, const float* X, bf16* XBo, float* RSo, float* OUT, const float* gfin, signed char* XQo = nullptr, float* SAo = nullptr) {
    for (int m = F.gw; m < S; m += F.NGW) {
        const GAS f32x4* xr = (const GAS f32x4*)(X + (size_t)m * DM) + F.lane;
        f32x4 v[16]; float s = 0.f;
#pragma unroll
        for (int j = 0; j < 16; ++j) { v[j] = __builtin_nontemporal_load(xr + 64 * j); s += (v[j].x * v[j].x + v[j].y * v[j].y) + (v[j].z * v[j].z + v[j].w * v[j].w); }
        float mx = 0.f;
        if (MODE == 0) {
#pragma unroll
            for (int j = 0; j < 16; ++j) mx = fmaxf(fmaxf(mx, fmaxf(fabsf(v[j].x), fabsf(v[j].y))), fmaxf(fabsf(v[j].z), fabsf(v[j].w)));
            mx = wave_max(mx); }
        const float ssum = wave_sum(s); const float rs = 1.0f / sqrtf(ssum * (1.0f / DM) + EPS);
        if (MODE == 0) {
            if (F.lane == 0) RSo[m] = ssum;
            GAS v2u* o8 = (GAS v2u*)(XBo + (size_t)m * DM) + F.lane;
#pragma unroll
            for (int j = 0; j < 16; ++j) { v2u w; w.x = pk2(v[j].x, v[j].y); w.y = pk2(v[j].z, v[j].w); o8[64 * j] = w; }
            if (F.lane == 0) SAo[m] = mx * (1.0f / 127.0f);
            const float inv = mx > 0.f ? 127.0f / mx : 0.f;
            GAS unsigned* q4 = (GAS unsigned*)(XQo + (size_t)m * DM) + F.lane;
#pragma unroll
            for (int j = 0; j < 16; ++j) { const int a = (int)__builtin_rintf(v[j].x * inv), b = (int)__builtin_rintf(v[j].y * inv), c = (int)__builtin_rintf(v[j].z * inv), d = (int)__builtin_rintf(v[j].w * inv);
                q4[64 * j] = ((unsigned)a & 0xffu) | (((unsigned)b & 0xffu) << 8) | (((unsigned)c & 0xffu) << 16) | (((unsigned)d & 0xffu) << 24); }
        } else {
            GAS f32x4* o = (GAS f32x4*)(OUT + (size_t)m * DM) + F.lane; const GAS f32x4* gg = (const GAS f32x4*)gfin + F.lane;
#pragma unroll
            for (int j = 0; j < 16; ++j) { const f32x4 gv = gg[64 * j]; o[64 * j] = v[j] * rs * gv; }
        }
    }
}

__device__ __forceinline__ void prep_q8(Frame& F, const bf16* XBi, const float* ssx, const unsigned* rmx, float* RSo, float* SAo, signed char* XQo) {
    for (int m = F.gw; m < S; m += F.NGW) {
        const GAS v4u* xr = (const GAS v4u*)(XBi + (size_t)m * DM) + F.lane;
        v4u v[8];
#pragma unroll
        for (int j = 0; j < 8; ++j) v[j] = xr[64 * j];
        const float mx = __uint_as_float(rmx[m]), inv = mx > 0.f ? 127.0f / mx : 0.f;
        if (F.lane == 0) { RSo[m] = ssx[m]; SAo[m] = mx * (1.0f / 127.0f); }
        GAS v2u* q8 = (GAS v2u*)(XQo + (size_t)m * DM) + F.lane;
#pragma unroll
        for (int j = 0; j < 8; ++j) { unsigned o2[2];
#pragma unroll
            for (int h = 0; h < 2; ++h) { const unsigned w0 = h ? v[j].z : v[j].x, w1 = h ? v[j].w : v[j].y;
                const int a = (int)__builtin_rintf(pg8::bf_lo(w0) * inv), b = (int)__builtin_rintf(pg8::bf_hi(w0) * inv), c = (int)__builtin_rintf(pg8::bf_lo(w1) * inv), d = (int)__builtin_rintf(pg8::bf_hi(w1) * inv);
                o2[h] = ((unsigned)a & 0xffu) | (((unsigned)b & 0xffu) << 8) | (((unsigned)c & 0xffu) << 16) | (((unsigned)d & 0xffu) << 24); }
            v2u w; w.x = o2[0]; w.y = o2[1]; q8[64 * j] = w; }
    }
}

__device__ __forceinline__ void final_norm(Frame& F, const bf16* XBi, const float* ssx, float* OUT, const float* gfin) {
    f32x4 gk[8][2];
    { const GAS f32x4* gg = (const GAS f32x4*)gfin + 2 * F.lane;
#pragma unroll
      for (int j = 0; j < 8; ++j) { gk[j][0] = gg[128 * j]; gk[j][1] = gg[128 * j + 1]; } }
    for (int m = F.gw; m < S; m += F.NGW) {
        const GAS v4u* xr = (const GAS v4u*)(XBi + (size_t)m * DM) + F.lane;
        v4u v[8];
#pragma unroll
        for (int j = 0; j < 8; ++j) v[j] = xr[64 * j];
        const float rs = 1.0f / sqrtf(ssx[m] * (1.0f / DM) + EPS);
        GAS f32x4* o = (GAS f32x4*)(OUT + (size_t)m * DM) + 2 * F.lane;
#pragma unroll
        for (int j = 0; j < 8; ++j) { const f32x4 g0 = gk[j][0], g1 = gk[j][1];
            f32x4 a = {pg8::bf_lo(v[j].x), pg8::bf_hi(v[j].x), pg8::bf_lo(v[j].y), pg8::bf_hi(v[j].y)}, b = {pg8::bf_lo(v[j].z), pg8::bf_hi(v[j].z), pg8::bf_lo(v[j].w), pg8::bf_hi(v[j].w)};
            o[128 * j] = a * rs * g0; o[128 * j + 1] = b * rs * g1; }
    }
}

using pg8::f32x4; using pg8::Unit;
__device__ __forceinline__ float fast_sigmoid(float v) { return __builtin_amdgcn_rcpf(1.0f + __builtin_amdgcn_exp2f(-v * LOG2E)); }
__device__ __forceinline__ void atomic_addf(float* p, float v) { unsafeAtomicAdd(p, v); }
struct EpiInProj {
    static constexpr bool PERM = true, AFTER_DRAIN = false, MID = false; typedef pg8::f32x4 acc_t;
    bf16* P; const float* rs; bf16* KRM; const float* ropeC; const float* ropeS; float* ssq_q; float* ssq_kv; bool stats;
    __device__ __forceinline__ void operator()(const f32x4 (&acc)[2][2][4][2], const Unit& u, int wr, int wc, int fr, int fq) const {
        const int pn = u.pn;
        const int pcb = bf_tile_col(u.pn), po = pcb >> 8;
        const int ty = po < 4 ? 1 : po < 6 ? 0 : po < 10 ? 2 : po < 16 ? 0 : po < 18 ? 2 : po < 20 ? 1 : po < 24 ? 0 : 2;
        const int row0 = u.pm * 256 + wr * 64 + fr, col0 = pcb + wc * 32 + 8 * fq;
        float srow[2][4];
#pragma unroll
        for (int ai = 0; ai < 2; ++ai)
#pragma unroll
            for (int m = 0; m < 4; ++m) srow[ai][m] = rs[row0 + ai * 128 + m * 16];
#pragma unroll
        for (int ai = 0; ai < 2; ++ai)
#pragma unroll
            for (int m = 0; m < 4; ++m) srow[ai][m] = 1.0f / sqrtf(srow[ai][m] * (1.0f / DM) + EPS);
#pragma unroll
        for (int ai = 0; ai < 2; ++ai)
#pragma unroll
            for (int m = 0; m < 4; ++m) {
                const int row = row0 + ai * 128 + m * 16; const float s = srow[ai][m];
                bf16* rowp = P + (size_t)row * PP + col0; float ssl = 0.f;
#pragma unroll
                for (int bj = 0; bj < 2; ++bj) {
                    f32x4 v0 = acc[ai][bj][m][0] * s, v1 = acc[ai][bj][m][1] * s;
                    pg8::u32x4 w;
                    if (ty == 3) {
#pragma unroll
                        for (int j = 0; j < 4; ++j) { v0[j] = fast_sigmoid(v0[j]); v1[j] = fast_sigmoid(v1[j]); }
                        w.x = pg8::cvt_pk_f16(v0[0], v0[1]); w.y = pg8::cvt_pk_f16(v0[2], v0[3]); w.z = pg8::cvt_pk_f16(v1[0], v1[1]); w.w = pg8::cvt_pk_f16(v1[2], v1[3]);
                        *(pg8::u32x4*)(rowp + bj * 128) = w;
                    } else if (ty == 4) {
                        if (bj == 0 && wc < 2) {
                            const int j0 = wc * 16 + 4 * fq;
                            const f32x4 c = *(const f32x4*)(ropeC + (size_t)row * 32 + j0), sn = *(const f32x4*)(ropeS + (size_t)row * 32 + j0);
                            const float a0 = v0[0] * c[0] - v0[1] * sn[0], b0 = v0[1] * c[0] + v0[0] * sn[0];
                            const float a1 = v0[2] * c[1] - v0[3] * sn[1], b1 = v0[3] * c[1] + v0[2] * sn[1];
                            const float a2 = v1[0] * c[2] - v1[1] * sn[2], b2 = v1[1] * c[2] + v1[0] * sn[2];
                            const float a3 = v1[2] * c[3] - v1[3] * sn[3], b3 = v1[3] * c[3] + v1[2] * sn[3];
                            w.x = pg8::cvt_pk_bf16(a0, b0); w.y = pg8::cvt_pk_bf16(a1, b1); w.z = pg8::cvt_pk_bf16(a2, b2); w.w = pg8::cvt_pk_bf16(a3, b3);
                            *(pg8::u32x4*)(KRM + (size_t)row * 64 + wc * 32 + 8 * fq) = w;
                        }
                    } else {
                        if (po >= 10 && po < 16) ssl += (v0[0] * v0[0] + v0[1] * v0[1]) + (v0[2] * v0[2] + v0[3] * v0[3]) + (v1[0] * v1[0] + v1[1] * v1[1]) + (v1[2] * v1[2] + v1[3] * v1[3]);
                        if (ty == 1) { v0 = v0 * SC128; v1 = v1 * SC128; }
                        if (ty == 2) {
#pragma unroll
                            for (int j = 0; j < 4; ++j) { v0[j] = v0[j] * fast_sigmoid(v0[j]); v1[j] = v1[j] * fast_sigmoid(v1[j]); }
                        }
                        w.x = pg8::cvt_pk_bf16(v0[0], v0[1]); w.y = pg8::cvt_pk_bf16(v0[2], v0[3]); w.z = pg8::cvt_pk_bf16(v1[0], v1[1]); w.w = pg8::cvt_pk_bf16(v1[2], v1[3]);
                        *(pg8::u32x4*)(rowp + bj * 128) = w;
                    }
                }
                if (stats && po >= 10 && po < 16) { ssl += __shfl_xor(ssl, 16); ssl += __shfl_xor(ssl, 32); if (fq == 0) atomic_addf((po < 14 ? ssq_q : ssq_kv) + row, ssl); }
            }
    }
};
struct EpiGateI8 {
    static constexpr bool PERM = true, AFTER_DRAIN = false, MID = false; typedef pg8::i32x4 acc_t;
    bf16* P; const float* rs; const float* sa; const float* sb; float* ssq_q; bf16* KRM; const float* ropeC; const float* ropeS; unsigned char* GT;
    __device__ __forceinline__ void operator()(const pg8::i32x4 (&acc)[2][2][4][2], const Unit& u, int wr, int wc, int fr, int fq) const {
        const int t = u.pn;
        const int ty = t < 48 ? 0 : t < 52 ? 1 : t < 56 ? 2 : t < 57 ? 3 : t < 59 ? 1 : t < 60 ? 4 : 5;
        const int row0 = u.pm * 256 + wr * 64 + fr, colw = wc * 32 + 8 * fq, col0 = t * 256 + colw;
        const int pcol = (t < 48 ? C_GA + t * 256 : t < 52 ? C_QA + (t - 48) * 256 : t < 56 ? C_CQ + (t - 52) * 256 : t < 57 ? C_KA : t < 59 ? C_QC + (t - 57) * 256 : t < 60 ? 0 : C_ZA + (t - 60) * 256) + colw;
        const float tsc = ty == 0 ? -LOG2E : ty == 1 ? SC128 : 1.0f;
        f32x4 cs[2][2];
#pragma unroll
        for (int bj = 0; bj < 2; ++bj) { cs[bj][0] = *(const f32x4*)(sb + col0 + bj * 128) * tsc; cs[bj][1] = *(const f32x4*)(sb + col0 + bj * 128 + 4) * tsc; }
        float srow[2][4], arow[2][4];
#pragma unroll
        for (int ai = 0; ai < 2; ++ai)
#pragma unroll
            for (int m = 0; m < 4; ++m) { srow[ai][m] = rs[row0 + ai * 128 + m * 16]; arow[ai][m] = sa[row0 + ai * 128 + m * 16]; }
#pragma unroll
        for (int ai = 0; ai < 2; ++ai)
#pragma unroll
            for (int m = 0; m < 4; ++m) srow[ai][m] = arow[ai][m] / sqrtf(srow[ai][m] * (1.0f / DM) + EPS);
#pragma unroll
        for (int ai = 0; ai < 2; ++ai)
#pragma unroll
            for (int m = 0; m < 4; ++m) {
                const int row = row0 + ai * 128 + m * 16; const float s = srow[ai][m];
                bf16* rowp = P + (size_t)row * PP + pcol; float ssl = 0.f;
#pragma unroll
                for (int bj = 0; bj < 2; ++bj) {
                    float v[8]; pg8::u32x4 w;
#pragma unroll
                    for (int j = 0; j < 8; ++j) v[j] = (float)acc[ai][bj][m][j >> 2][j & 3] * s * cs[bj][j >> 2][j & 3];
                    if (ty == 0) {
#pragma unroll
                        for (int j = 0; j < 8; ++j) v[j] = fminf(1.0f + __builtin_amdgcn_exp2f(v[j]), 65504.0f);
                        w.x = pg8::cvt_pk_f16(v[0], v[1]); w.y = pg8::cvt_pk_f16(v[2], v[3]); w.z = pg8::cvt_pk_f16(v[4], v[5]); w.w = pg8::cvt_pk_f16(v[6], v[7]);
                        *(GAS pg8::u32x4*)((GAS unsigned char*)GT + ((unsigned)(t * 64 + u.pm) * 131072u + (unsigned)((ai * 4 + m) * 2 + bj) * 8192u + (unsigned)(((wr * 4 + wc) * 64 + fq * 16 + fr) * 16))) = w;
                    } else if (ty == 4) {
                        if (bj == 0 && wc < 2) {
                            const int j0 = wc * 16 + 4 * fq;
                            const f32x4 c = *(const f32x4*)(ropeC + (size_t)row * 32 + j0), sn = *(const f32x4*)(ropeS + (size_t)row * 32 + j0);
                            w.x = pg8::cvt_pk_bf16(v[0] * c[0] - v[1] * sn[0], v[1] * c[0] + v[0] * sn[0]); w.y = pg8::cvt_pk_bf16(v[2] * c[1] - v[3] * sn[1], v[3] * c[1] + v[2] * sn[1]);
                            w.z = pg8::cvt_pk_bf16(v[4] * c[2] - v[5] * sn[2], v[5] * c[2] + v[4] * sn[2]); w.w = pg8::cvt_pk_bf16(v[6] * c[3] - v[7] * sn[3], v[7] * c[3] + v[6] * sn[3]);
                            *(pg8::u32x4*)(KRM + (size_t)row * 64 + wc * 32 + 8 * fq) = w;
                        }
                    } else {
                        if (ty == 5) {
#pragma unroll
                            for (int j = 0; j < 8; ++j) v[j] = v[j] * fast_sigmoid(v[j]); }
                        if (ty == 2) ssl += (v[0] * v[0] + v[1] * v[1]) + (v[2] * v[2] + v[3] * v[3]) + (v[4] * v[4] + v[5] * v[5]) + (v[6] * v[6] + v[7] * v[7]);
                        w.x = pg8::cvt_pk_bf16(v[0], v[1]); w.y = pg8::cvt_pk_bf16(v[2], v[3]); w.z = pg8::cvt_pk_bf16(v[4], v[5]); w.w = pg8::cvt_pk_bf16(v[6], v[7]);
                        *(pg8::u32x4*)(rowp + bj * 128) = w;
                    }
                }
                if (ty == 2) { ssl += __shfl_xor(ssl, 16); ssl += __shfl_xor(ssl, 32); if (fq == 0) atomic_addf(ssq_q + row, ssl); }
            }
    }
};
struct EpiQUp {
    static constexpr bool PERM = true, AFTER_DRAIN = false, MID = false; typedef pg8::f32x4 acc_t;
    bf16* QM; const float* rsq; const float* ropeC; const float* ropeS;
    __device__ __forceinline__ void operator()(const f32x4 (&acc)[2][2][4][2], const Unit& u, int wr, int wc, int fr, int fq) const {
        const int row0 = u.pm * 256 + wr * 64 + fr, col0 = u.pn * 256 + wc * 32 + 8 * fq;
        float srow[2][4];
#pragma unroll
        for (int ai = 0; ai < 2; ++ai)
#pragma unroll
            for (int m = 0; m < 4; ++m) srow[ai][m] = rsq[row0 + ai * 128 + m * 16];
        const int cb0 = (u.pn * 256 + wc * 32) % 192, cb1 = (u.pn * 256 + wc * 32 + 128) % 192;
        const int rbj = __builtin_amdgcn_readfirstlane(cb0 >= 128 ? 0 : cb1 >= 128 ? 1 : -1);
        f32x4 ccv[2][4], snv[2][4];
        if (rbj >= 0) { const int j0r = (((rbj ? cb1 : cb0) - 128) >> 1) + 4 * fq;
#pragma unroll
            for (int ai = 0; ai < 2; ++ai)
#pragma unroll
                for (int m = 0; m < 4; ++m) { const size_t ro = (size_t)(row0 + ai * 128 + m * 16) * 32 + j0r; ccv[ai][m] = *(const f32x4*)(ropeC + ro); snv[ai][m] = *(const f32x4*)(ropeS + ro); } }
#pragma unroll
        for (int ai = 0; ai < 2; ++ai)
#pragma unroll
            for (int m = 0; m < 4; ++m) {
                const int row = row0 + ai * 128 + m * 16; const float s = SC192 / sqrtf(srow[ai][m] * (1.0f / 1024.0f) + EPS);
#pragma unroll
                for (int bj = 0; bj < 2; ++bj) {
                    const int col = col0 + bj * 128, c = col % 192;
                    f32x4 v0 = acc[ai][bj][m][0] * s, v1 = acc[ai][bj][m][1] * s;
                    pg8::u32x4 w;
                    if (bj == rbj) {
                        const f32x4 cc = ccv[ai][m], sn = snv[ai][m];
                        const float a0 = v0[0] * cc[0] - v0[1] * sn[0], b0 = v0[1] * cc[0] + v0[0] * sn[0];
                        const float a1 = v0[2] * cc[1] - v0[3] * sn[1], b1 = v0[3] * cc[1] + v0[2] * sn[1];
                        const float a2 = v1[0] * cc[2] - v1[1] * sn[2], b2 = v1[1] * cc[2] + v1[0] * sn[2];
                        const float a3 = v1[2] * cc[3] - v1[3] * sn[3], b3 = v1[3] * cc[3] + v1[2] * sn[3];
                        w.x = pg8::cvt_pk_bf16(a0, b0); w.y = pg8::cvt_pk_bf16(a1, b1); w.z = pg8::cvt_pk_bf16(a2, b2); w.w = pg8::cvt_pk_bf16(a3, b3);
                    } else {
                        w.x = pg8::cvt_pk_bf16(v0[0], v0[1]); w.y = pg8::cvt_pk_bf16(v0[2], v0[3]); w.z = pg8::cvt_pk_bf16(v1[0], v1[1]); w.w = pg8::cvt_pk_bf16(v1[2], v1[3]);
                    }
                    *(pg8::u32x4*)(QM + (size_t)row * 768 + col) = w;
                }
            }
    }
};
struct EpiKvUp {
    static constexpr bool PERM = true, AFTER_DRAIN = false, MID = false; typedef pg8::f32x4 acc_t;
    bf16* KVM; const float* rskv;
    __device__ __forceinline__ void operator()(const f32x4 (&acc)[2][2][4][2], const Unit& u, int wr, int wc, int fr, int fq) const {
        const int row0 = u.pm * 256 + wr * 64 + fr, col0 = u.pn * 256 + wc * 32 + 8 * fq;
        float srow[2][4];
#pragma unroll
        for (int ai = 0; ai < 2; ++ai)
#pragma unroll
            for (int m = 0; m < 4; ++m) srow[ai][m] = rskv[row0 + ai * 128 + m * 16];
#pragma unroll
        for (int ai = 0; ai < 2; ++ai)
#pragma unroll
            for (int m = 0; m < 4; ++m) {
                const int row = row0 + ai * 128 + m * 16; const float s = 1.0f / sqrtf(srow[ai][m] * (1.0f / 512.0f) + EPS);
#pragma unroll
                for (int bj = 0; bj < 2; ++bj) {
                    const f32x4 v0 = acc[ai][bj][m][0] * s, v1 = acc[ai][bj][m][1] * s;
                    pg8::u32x4 w; w.x = pg8::cvt_pk_bf16(v0[0], v0[1]); w.y = pg8::cvt_pk_bf16(v0[2], v0[3]); w.z = pg8::cvt_pk_bf16(v1[0], v1[1]); w.w = pg8::cvt_pk_bf16(v1[2], v1[3]);
                    *(pg8::u32x4*)(KVM + (size_t)row * 1024 + col0 + bj * 128) = w;
                }
            }
    }
};
struct EpiProjFused {
    static constexpr bool PERM = true, AFTER_DRAIN = false, MID = true; typedef pg8::f32x4 acc_t;
    const unsigned char* GT; bf16* MBF; int t1, t2;
    typedef _Float16 h8 __attribute__((ext_vector_type(8)));
    __device__ __forceinline__ void mid(f32x4 (&acc)[2][2][4][2], const Unit& u, bool second, int wr, int wc, int fr, int fq) const {
        const unsigned slot = (unsigned)(((wr * 4 + wc) * 64 + fq * 16 + fr) * 16);
        const unsigned gx = (unsigned)(((second ? 16 : 0) + u.pn) * 64 + u.pm) * 131072u + slot, gy = gx + 16u * 64u * 131072u;
        const GAS unsigned char* Gb = (const GAS unsigned char*)GT;
#pragma unroll
        for (int ai = 0; ai < 2; ++ai) {
            h8 X[4][2], Y[4][2];
#pragma unroll
            for (int m = 0; m < 4; ++m)
#pragma unroll
                for (int bj = 0; bj < 2; ++bj) { const unsigned co = (unsigned)((ai * 4 + m) * 2 + bj) * 8192u; X[m][bj] = *(const GAS h8*)(Gb + (gx + co)); Y[m][bj] = *(const GAS h8*)(Gb + (gy + co)); }
#pragma unroll
            for (int m = 0; m < 4; ++m) {
#pragma unroll
                for (int bj = 0; bj < 2; ++bj) {
#pragma unroll
                    for (int j = 0; j < 8; ++j) { const float r = (float)Y[m][bj][j] * __builtin_amdgcn_rcpf((float)X[m][bj][j]); acc[ai][bj][m][j >> 2][j & 3] *= r; }
                    __builtin_amdgcn_sched_barrier(0);
                }
            }
            asm volatile("" ::: "memory");
        }
    }
    __device__ __forceinline__ void operator()(const f32x4 (&acc)[2][2][4][2], const Unit& u, int wr, int wc, int fr, int fq) const {
        const int row0 = u.pm * 256 + wr * 64 + fr, col0 = u.pn * 256 + wc * 32 + 8 * fq;
        h8 Gall[2][4][2];
        { const GAS unsigned char* gb_ = (const GAS unsigned char*)GT + ((unsigned)((32 + u.pn) * 64 + u.pm) * 131072u + (unsigned)(((wr * 4 + wc) * 64 + fq * 16 + fr) * 16));
#pragma unroll
          for (int ai = 0; ai < 2; ++ai)
#pragma unroll
            for (int m = 0; m < 4; ++m)
#pragma unroll
                for (int bj = 0; bj < 2; ++bj) Gall[ai][m][bj] = *(const GAS h8*)(gb_ + (unsigned)((ai * 4 + m) * 2 + bj) * 8192u); }
#pragma unroll
        for (int ai = 0; ai < 2; ++ai)
#pragma unroll
            for (int m = 0; m < 4; ++m) {
                const int row = row0 + ai * 128 + m * 16;
#pragma unroll
                for (int bj = 0; bj < 2; ++bj) {
                    const h8 G = Gall[ai][m][bj];
                    float v[8];
#pragma unroll
                    for (int j = 0; j < 8; ++j) v[j] = acc[ai][bj][m][j >> 2][j & 3] * __builtin_amdgcn_rcpf((float)G[j]);
                    pg8::u32x4 w; w.x = pg8::cvt_pk_bf16(v[0], v[1]); w.y = pg8::cvt_pk_bf16(v[2], v[3]); w.z = pg8::cvt_pk_bf16(v[4], v[5]); w.w = pg8::cvt_pk_bf16(v[6], v[7]);
                    *(pg8::u32x4*)(MBF + (size_t)row * DM + col0 + bj * 128) = w;
                }
            }
    }
};
struct EpiOut {
    static constexpr bool PERM = false, AFTER_DRAIN = false, MID = false; typedef pg8::f32x4 acc_t;
    const float* Xp; float* Xn; bf16* XBn; float* ssx; unsigned* rmx; bool LAST; bool stats; bool FIN; bool TIN; bool TOUT;
    __device__ __forceinline__ void operator()(const f32x4 (&acc)[2][2][4][2], const Unit& u, int wr, int wc, int fr, int fq) const {
        const int row0 = u.pm * 256 + wr * 64 + fr, col0 = u.pn * 256 + wc * 32 + 4 * fq;
        const unsigned tb = (unsigned)(u.pn * 64 + u.pm) * 262144u + (unsigned)(((wr * 4 + wc) * 64 + fq * 16 + fr) * 16), rb = ((unsigned)row0 * (unsigned)DM + (unsigned)col0) * 4u;
        const unsigned ib = TIN ? tb : rb, ob = TOUT ? tb : rb;
        const unsigned is_ai = TIN ? 16u * 8192u : 128u * DM * 4u, is_m = TIN ? 4u * 8192u : 16u * DM * 4u, is_bj = TIN ? 2u * 8192u : 512u, is_n = TIN ? 8192u : 64u;
        const unsigned os_ai = TOUT ? 16u * 8192u : 128u * DM * 4u, os_m = TOUT ? 4u * 8192u : 16u * DM * 4u, os_bj = TOUT ? 2u * 8192u : 512u, os_n = TOUT ? 8192u : 64u;
#pragma unroll
        for (int ai = 0; ai < 2; ++ai) {
            f32x4 xin[4][2][2];
#pragma unroll
            for (int m = 0; m < 4; ++m)
#pragma unroll
                for (int bj = 0; bj < 2; ++bj)
#pragma unroll
                    for (int n = 0; n < 2; ++n) xin[m][bj][n] = *(const GAS f32x4*)((const GAS unsigned char*)Xp + (ib + ai * is_ai + m * is_m + bj * is_bj + n * is_n));
#pragma unroll
            for (int m = 0; m < 4; ++m) {
                const int row = row0 + ai * 128 + m * 16; const size_t off = (size_t)row * DM + col0; float ssl = 0.f, mxl = 0.f;
#pragma unroll
                for (int bj = 0; bj < 2; ++bj) {
                    pg8::u32x2 w[2];
#pragma unroll
                    for (int n = 0; n < 2; ++n) { const f32x4 v = xin[m][bj][n] + acc[ai][bj][m][n]; if (!FIN) *(GAS f32x4*)((GAS unsigned char*)Xn + (ob + ai * os_ai + m * os_m + bj * os_bj + n * os_n)) = v;
                        if (!LAST) { w[n].x = pg8::cvt_pk_bf16(v[0], v[1]); w[n].y = pg8::cvt_pk_bf16(v[2], v[3]); ssl += (v[0] * v[0] + v[1] * v[1]) + (v[2] * v[2] + v[3] * v[3]); mxl = fmaxf(fmaxf(mxl, fmaxf(fabsf(v[0]), fabsf(v[1]))), fmaxf(fabsf(v[2]), fabsf(v[3]))); } }
                    if (!LAST) {
                        auto r0 = __builtin_amdgcn_permlane16_swap(w[0].x, w[1].x, false, false); auto r1 = __builtin_amdgcn_permlane16_swap(w[0].y, w[1].y, false, false);
                        pg8::u32x4 w4; w4.x = r0[0]; w4.y = r1[0]; w4.z = r0[1]; w4.w = r1[1];
                        const int cx = (fq & 1) ? 16 + 4 * (fq - 1) - 4 * fq : 0;
                        *(pg8::u32x4*)(XBn + off + bj * 128 + cx) = w4; }
                }
                if (!LAST && stats) { ssl += __shfl_xor(ssl, 16); ssl += __shfl_xor(ssl, 32); mxl = fmaxf(mxl, __shfl_xor(mxl, 16)); mxl = fmaxf(mxl, __shfl_xor(mxl, 32));
                    if (fq == 0) { atomic_addf(ssx + row, ssl); atomicMax(rmx + row, __float_as_uint(mxl)); } }
            }
            asm volatile("" ::: "memory");
        }
    }
};

__device__ __forceinline__ float dot8(const v4u kv, const LAS float* q) {
    const f32x4 q0 = *(const LAS f32x4*)q, q1 = *(const LAS f32x4*)(q + 4);
    return pg8::bf_lo(kv.x) * q0[0] + pg8::bf_hi(kv.x) * q0[1] + pg8::bf_lo(kv.y) * q0[2] + pg8::bf_hi(kv.y) * q0[3]
         + pg8::bf_lo(kv.z) * q1[0] + pg8::bf_hi(kv.z) * q1[1] + pg8::bf_lo(kv.w) * q1[2] + pg8::bf_hi(kv.w) * q1[3];
}
template <int MODE>
__device__ __forceinline__ void naive_attn_task(Frame& F, const Args& A, int layer, int row, int head, LAS float* wscr) {
    const int lane = F.lane;
    constexpr int DQK = (MODE == 1) ? 192 : 128;
    const bf16 *qp, *kb, *vb, *gatep; bf16* outp; int kpitch, vpitch;
    if (MODE == 0) { qp = F.P + (size_t)row * PP + C_QA + head * 128; kb = F.P + C_KA + (head >> 2) * 128; vb = F.P + C_VA + (head >> 2) * 128; kpitch = PP; vpitch = PP;
        gatep = F.P + (size_t)row * PP + C_ZA + head * 128; outp = F.Y + (size_t)row * YW + head * 128; }
    else if (MODE == 1) { qp = F.QM + (size_t)row * 768 + head * 192; kb = F.KVM + head * 256; vb = F.KVM + head * 256 + 128; kpitch = 1024; vpitch = 1024;
        gatep = F.P + (size_t)row * PP + C_ZB + head * 128; outp = F.Y + (size_t)row * YW + 1024 + head * 128; }
    else { qp = F.P + (size_t)row * PP + C_QC + head * 128; kb = F.P + C_KC + head * 128; vb = F.P + C_VC + head * 128; kpitch = PP; vpitch = PP;
        gatep = F.P + (size_t)row * PP + C_ZC + head * 128; outp = F.Y + (size_t)row * YW + 1536 + head * 128; }
    LAS float* qs = wscr; LAS float* ps = wscr + 192;
    for (int i = lane; i < DQK; i += 64) qs[i] = bf2f(qp[i]);
    LDS_WAIT(); asm volatile("" ::: "memory");
    float o0 = 0.f, o1 = 0.f, mrun = -1e30f, lrun = 0.f, carry = 0.f;
    int klo, khi;
    if (MODE == 0) { klo = row - 127 > 0 ? row - 127 : 0; khi = row; } else if (MODE == 1) { klo = 0; khi = row; } else { klo = 0; khi = row - 1; }
    if (khi >= klo) {
        const int cfirst = klo & ~63, clast = khi & ~63;
        const int nchunk = (clast - cfirst) / 64 + 1;
        for (int ci = 0; ci < nchunk; ++ci) {
            const int c0 = (MODE == 2) ? clast - 64 * ci : cfirst + 64 * ci;
            const int s = c0 + lane; const bool valid = (s >= klo) && (s <= khi);
            const int sl = s > khi ? khi : (s < klo ? klo : s);
            const bf16* kp = kb + (size_t)sl * kpitch;
            float d = 0.f;
#pragma unroll
            for (int c = 0; c < 16; ++c) d += dot8(*(const GAS v4u*)(kp + 8 * c), qs + 8 * c);
            if (MODE == 1) { const bf16* krp = F.KRM + (size_t)sl * 64;
#pragma unroll
                for (int c = 0; c < 8; ++c) d += dot8(*(const GAS v4u*)(krp + 8 * c), qs + 128 + 8 * c); }
            float p;
            if (MODE == 2) {
                const float z = d;
                const float lk = -(fmaxf(z, 0.f) + __builtin_amdgcn_logf(1.0f + __builtin_amdgcn_exp2f(-fabsf(z))));
                float incl = valid ? lk : 0.f;
#pragma unroll
                for (int off = 1; off < 64; off <<= 1) { const float t = __shfl_down(incl, off); if (lane + off < 64) incl += t; }
                float excl = __shfl_down(incl, 1); if (lane == 63) excl = 0.f;
                const float tot = __shfl(incl, 0);
                p = valid ? __builtin_amdgcn_exp2f(z + lk + excl + carry) : 0.f;
                carry += tot;
            } else {
                float sc = d;
                if (MODE == 0) sc += A.rel_bias[(int)T5B[(row - sl) & 127] * 8 + head] * LOG2E;
                sc = valid ? sc : -__builtin_inff();
                const float mn = fmaxf(mrun, wave_max(sc));
                const float alpha = __builtin_amdgcn_exp2f(mrun - mn);
                p = __builtin_amdgcn_exp2f(sc - mn);
                lrun = lrun * alpha + wave_sum(p); o0 *= alpha; o1 *= alpha; mrun = mn;
            }
            ps[lane] = p;
            LDS_WAIT(); asm volatile("" ::: "memory");
            for (int j = 0; j < 64; ++j) {
                int sj = c0 + j; sj = sj > khi ? khi : (sj < klo ? klo : sj);
                const float pj = ps[j];
                const unsigned vv = *(const GAS unsigned*)(vb + (size_t)sj * vpitch + 2 * lane);
                o0 += pj * pg8::bf_lo(vv); o1 += pj * pg8::bf_hi(vv);
            }
            LDS_WAIT(); asm volatile("" ::: "memory");
        }
    }
    if (MODE == 0) { const float sk = A.sinks[layer * 8 + head] * LOG2E; const float mf = fmaxf(mrun, sk); const float a = __builtin_amdgcn_exp2f(mrun - mf);
        const float lf = lrun * a + __builtin_amdgcn_exp2f(sk - mf); const float inv = a / lf; o0 *= inv; o1 *= inv; }
    if (MODE == 1) { const float inv = 1.0f / lrun; o0 *= inv; o1 *= inv; }
    const unsigned gv = *(const GAS unsigned*)(gatep + 2 * lane);
    *(GAS unsigned*)(outp + 2 * lane) = pk2(o0 * pg8::bf_lo(gv), o1 * pg8::bf_hi(gv));
}
__device__ __forceinline__ void naive_attn_phase(Frame& F, const Args& A, int layer) {
    LAS float* wscr = (LAS float*)(F.lds + RING_OFF + F.wave * 2048);
    if (!(ATTN_MFMA_MASK & 2)) for (int t = F.gw; t < S * 4; t += F.NGW) naive_attn_task<1>(F, A, layer, t >> 2, t & 3, wscr);
    if (!(ATTN_MFMA_MASK & 4)) for (int t = F.gw; t < S * 4; t += F.NGW) naive_attn_task<2>(F, A, layer, t >> 2, t & 3, wscr);
    if (!(ATTN_MFMA_MASK & 1)) for (int t = F.gw; t < S * 8; t += F.NGW) naive_attn_task<0>(F, A, layer, t >> 3, t & 7, wscr);
}


namespace att {
typedef short s16x4 __attribute__((ext_vector_type(4)));
typedef float f32x16 __attribute__((ext_vector_type(16)));
constexpr int SHM_T = 16384, OFF_V = 0  , OFF_K = 3 * SHM_T  , OFF_KR = 5 * SHM_T, OFF_WS = 5 * SHM_T + 2 * 8192, OFF_FLAG = OFF_WS + 8 * 256, OFF_LUT = OFF_FLAG + 64, LDS_END = OFF_LUT + 512;
static_assert(LDS_END <= RING_BYTES, "attention LDS");
#define KSWZ(row, colB) ((row) * 256 + ((colB) ^ (((row) & 15) << 4)))
#define KRSWZ(row, chunk) ((row) * 128 + ((((chunk) ^ ((row) >> 1)) & 7) << 4))
__device__ __forceinline__ int v_st(int k, int c) { const int kk = (k & ~0xC) | ((k & 4) << 1) | ((k & 8) >> 1); return ((kk >> 3) * 4 + (c >> 5)) * 512 + ((kk & 7) * 32 + (c & 31)) * 2; }
__device__ __forceinline__ int v_rd_base(int lane) { return ((lane & 3) << 3) | (((lane >> 2) & 3) << 6) | (((lane >> 4) & 1) << 5) | (((lane >> 5) & 1) << 8); }
constexpr int v_rd_off(int d0, int ks, int half) { return d0 * 512 + ks * 4096 + half * 2048; }
__device__ __forceinline__ int crow(int r, int hi) { return (r & 3) + 8 * (r >> 2) + 4 * hi; }
__device__ __forceinline__ unsigned cvtpk(float lo, float hi) { unsigned r; asm volatile("v_cvt_pk_bf16_f32 %0, %1, %2" : "=v"(r) : "v"(lo), "v"(hi)); return r; }
__device__ __forceinline__ void glds16(const void* gsrc, unsigned lds_dst) { unsigned keep;
    asm volatile("s_mov_b32 %0, m0\n\ts_mov_b32 m0, %2\n\ts_nop 0\n\tglobal_load_lds_dwordx4 %1, off\n\ts_mov_b32 m0, %0" : "=&s"(keep) : "v"(gsrc), "s"(lds_dst) : "memory"); }
__device__ __forceinline__ void glds16s(const char* sbase, unsigned voff, unsigned lds_dst) { unsigned keep;
    asm volatile("s_mov_b32 %0, m0\n\ts_mov_b32 m0, %3\n\ts_nop 0\n\tglobal_load_lds_dwordx4 %1, %2\n\ts_mov_b32 m0, %0" : "=&s"(keep) : "v"(voff), "s"(sbase), "s"(lds_dst) : "memory"); }
__device__ __forceinline__ const char* uni_ptr(const void* p) { const unsigned long long v = (unsigned long long)(uintptr_t)p;
    const unsigned lo = __builtin_amdgcn_readfirstlane((unsigned)v), hi_ = __builtin_amdgcn_readfirstlane((unsigned)(v >> 32)); return (const char*)(uintptr_t)(((unsigned long long)hi_ << 32) | lo); }
#define ATT_PK4(P, B_, OUT) do { unsigned a0 = cvtpk(P[B_+0], P[B_+1]), a1 = cvtpk(P[B_+2], P[B_+3]);                          \
        unsigned b0 = cvtpk(P[B_+4], P[B_+5]), b1 = cvtpk(P[B_+6], P[B_+7]);                                             \
        auto r0 = __builtin_amdgcn_permlane32_swap(a0, b0, false, false); auto r1 = __builtin_amdgcn_permlane32_swap(a1, b1, false, false); \
        v4u w_ = {r0[0], r1[0], r0[1], r1[1]}; OUT = __builtin_bit_cast(bf16x8, w_); } while (0)

template <int MODE>
__device__ __forceinline__ void attn_unit(LAS unsigned char* L, const bf16* __restrict__ Qp, int qpitch, const bf16* __restrict__ Kp, const bf16* __restrict__ Vp, int kvpitch,
                                          const bf16* __restrict__ KRp, const bf16* __restrict__ Gp, bf16* __restrict__ Op, int P0, float sink2, const float* __restrict__ biasp,
                                          int jlo_ovr, int jhi_ovr, float* __restrict__ Opart, float* __restrict__ MLp,
                                          gu32* cnt = nullptr, int nparts = 0, const float* Opart0 = nullptr, const float* ML0 = nullptr, volatile LAS unsigned* bflag = nullptr) {
    constexpr int NQ = (MODE == 1) ? 12 : 8;
    constexpr float THR = 8.f, NEG = -__builtin_inff();
    int tid = threadIdx.x; asm volatile("" : "+v"(tid));
    const int wid = __builtin_amdgcn_readfirstlane(tid >> 6), lane = tid & 63, r32 = lane & 31, hi = lane >> 5;
    int j_lo = 0, j_hi = P0 / 64 + 4;
    if (MODE == 0) j_lo = P0 >= 128 ? P0 / 64 - 2 : 0;
    if (MODE == 1) { j_lo = jlo_ovr; j_hi = jhi_ovr; }
    const int NT = j_hi - j_lo;
    const int qlo = P0 + wid * 32, qpos = qlo + r32;
    unsigned ko[2], vo[2];
    const char* const Kb0 = uni_ptr(Kp); const char* const Rb0 = uni_ptr(KRp);
    const unsigned vdiff = (unsigned)__builtin_amdgcn_readfirstlane((int)((const char*)Vp - (const char*)Kp));
#pragma unroll
    for (int i = 0; i < 2; ++i) { const int p = wid * 128 + i * 64 + lane;
        { const int row = p >> 4, phys = p & 15; ko[i] = (unsigned)(row * kvpitch + ((phys ^ (row & 15)) << 3)) * 2u; }
        { const int s = p >> 5, q = p & 31, kk = (s >> 2) * 8 + (q >> 2); const int vr = (kk & ~0xC) | ((kk & 4) << 1) | ((kk & 8) >> 1); vo[i] = (unsigned)(vr * kvpitch + (s & 3) * 32 + (q & 3) * 8) * 2u + vdiff; } }
    const int rp = wid * 64 + lane; const unsigned ro = (unsigned)((rp >> 3) * 64 + (((rp & 7) ^ ((rp >> 4) & 7)) << 3)) * 2u;
    const unsigned ldsK = (unsigned)(uintptr_t)(L + OFF_K) + (unsigned)wid * 2048u, ldsV = (unsigned)(uintptr_t)(L + OFF_V) + (unsigned)wid * 2048u, ldsR = (unsigned)(uintptr_t)(L + OFF_KR) + (unsigned)wid * 1024u;
    const unsigned XK = (unsigned)(r32 * 256 + ((hi ^ (r32 & 15)) << 4)), XR = (unsigned)(r32 * 128 + (((hi ^ (r32 >> 1)) & 7) << 4));
    LAS float* wsf = (LAS float*)(L + OFF_WS + wid * 256); LAS float* li_l = wsf; LAS float* al_l = wsf + 32;
    volatile LAS unsigned* flags = (volatile LAS unsigned*)(L + OFF_FLAG);
    LAS float* blut = (LAS float*)(L + OFF_LUT);
    float blv = 0.f; if (MODE == 0) { if (tid < 128) blv = biasp[tid]; }
    bf16x8 qr[NQ];
#pragma unroll
    for (int d0 = 0; d0 < NQ; ++d0) qr[d0] = *(const GAS bf16x8*)(Qp + (size_t)(wid * 32 + r32) * qpitch + d0 * 16 + hi * 8);
#define ATT_TILE(t) ((MODE == 2) ? (j_hi - 1 - (t)) : (j_lo + (t)))
#define ATT_DMA(jt, bf, vbf) do { const char* kb_ = Kb0 + (size_t)(jt) * 128 * (size_t)kvpitch; \
        glds16s(kb_, ko[0], (unsigned)__builtin_amdgcn_readfirstlane(ldsK + (bf) * SHM_T)); \
        glds16s(kb_, ko[1], (unsigned)__builtin_amdgcn_readfirstlane(ldsK + (bf) * SHM_T + 1024)); \
        glds16s(kb_, vo[0], (unsigned)__builtin_amdgcn_readfirstlane(ldsV + (vbf) * SHM_T)); \
        glds16s(kb_, vo[1], (unsigned)__builtin_amdgcn_readfirstlane(ldsV + (vbf) * SHM_T + 1024)); \
        if (MODE == 1) glds16s(Rb0 + (size_t)(jt) * 8192, ro, (unsigned)__builtin_amdgcn_readfirstlane(ldsR + (bf) * 8192)); } while (0)
    float m_reg = -1e30f, l_reg = 0.f, carry = 0.f;
    f32x16 o[4];
#pragma unroll
    for (int d = 0; d < 4; ++d)
#pragma unroll
        for (int r = 0; r < 16; ++r) o[d][r] = 0.f;
    ATT_DMA(ATT_TILE(0), 0, 0); if (MODE == 0) { if (tid < 128) blut[tid] = blv; } VM_WAIT();
#pragma unroll
    for (int d0 = 0; d0 < NQ; ++d0) asm volatile("" : "+v"(qr[d0]));
    __syncthreads();
    const unsigned vbase = (unsigned)(uintptr_t)(L + OFF_V) + (unsigned)v_rd_base(lane);
    const bool lag = (wid >= 4);
    bool pend = false; int vcur = 0, vprev = 0;
    bf16x8 pa0, pa1, pa2, pa3;
#define ATT_TRRD(dst, off) asm volatile("ds_read_b64_tr_b16 %0, %1 offset:%2" : "=&v"(dst) : "v"(vb0), "i"(off) : "memory")
#define ATT_PV(d0) do { s16x4 l0, l1, l2, l3, h0, h1, h2, h3; constexpr int b_ = v_rd_off(d0, 0, 0); \
        ATT_TRRD(l0, b_); ATT_TRRD(h0, b_ + 2048); ATT_TRRD(l1, b_ + 4096); ATT_TRRD(h1, b_ + 6144); ATT_TRRD(l2, b_ + 8192); ATT_TRRD(h2, b_ + 10240); ATT_TRRD(l3, b_ + 12288); ATT_TRRD(h3, b_ + 14336); \
        asm volatile("s_waitcnt lgkmcnt(0)" ::: "memory"); __builtin_amdgcn_sched_barrier(0); \
        o[d0] = __builtin_amdgcn_mfma_f32_32x32x16_bf16((bf16x8){l0[0], l0[1], l0[2], l0[3], h0[0], h0[1], h0[2], h0[3]}, pa0, o[d0], 0, 0, 0); \
        o[d0] = __builtin_amdgcn_mfma_f32_32x32x16_bf16((bf16x8){l1[0], l1[1], l1[2], l1[3], h1[0], h1[1], h1[2], h1[3]}, pa1, o[d0], 0, 0, 0); \
        o[d0] = __builtin_amdgcn_mfma_f32_32x32x16_bf16((bf16x8){l2[0], l2[1], l2[2], l2[3], h2[0], h2[1], h2[2], h2[3]}, pa2, o[d0], 0, 0, 0); \
        o[d0] = __builtin_amdgcn_mfma_f32_32x32x16_bf16((bf16x8){l3[0], l3[1], l3[2], l3[3], h3[0], h3[1], h3[2], h3[3]}, pa3, o[d0], 0, 0, 0); } while (0)
#define ATT_PV_ALL(vbuf) do { const unsigned vb0 = vbase + (unsigned)((vbuf) * SHM_T); __builtin_amdgcn_s_setprio(1); ATT_PV(0); ATT_PV(1); ATT_PV(2); ATT_PV(3); __builtin_amdgcn_s_setprio(0); } while (0)
    for (int t = 0; t < NT; ++t) {
        const int cur = t & 1, jt = ATT_TILE(t), kb = jt * 64;
        const bool more = (t + 1 < NT);
        vprev = vcur; vcur = t % 3;
        if (more) ATT_DMA(ATT_TILE(t + 1), cur ^ 1, (t + 1) % 3);
        if (lag && pend) { ATT_PV_ALL(vprev); pend = false; }
        bool act;
        if (MODE == 0) act = (kb <= qlo + 31) && (kb + 63 >= qlo - 127);
        else if (MODE == 1) act = (kb <= qlo + 31);
        else act = (kb < qlo + 31) && !__all(carry < -150.f);
        if (act) {
            f32x16 p0, p1;
#pragma unroll
            for (int r = 0; r < 16; ++r) { p0[r] = 0.f; p1[r] = 0.f; }
            {
                unsigned xk = XK, xr = XR; asm volatile("" : "+v"(xk), "+v"(xr));
                const unsigned kbs = (unsigned)(uintptr_t)(L + OFF_K) + (unsigned)cur * SHM_T, rbs = (unsigned)(uintptr_t)(L + OFF_KR) + (unsigned)cur * 8192u;
                bf16x8 f0, f1, f2, f3;
#define ATT_KRD(dst, addr, off) asm volatile("ds_read_b128 %0, %1 offset:%2" : "=&v"(dst) : "v"(addr), "i"(off) : "memory")
#define ATT_KISSUE(s_, A_, B_) do { if ((s_) < 8) { const unsigned a_ = (xk ^ ((unsigned)(s_) << 5)) + kbs; ATT_KRD(A_, a_, 0); ATT_KRD(B_, a_, 8192); } \
                                    else { const unsigned a_ = (xr ^ ((unsigned)((s_) - 8) << 5)) + rbs; ATT_KRD(A_, a_, 0); ATT_KRD(B_, a_, 4096); } } while (0)
                ATT_KISSUE(0, f0, f1); ATT_KISSUE(1, f2, f3);
                __builtin_amdgcn_s_setprio(1);
#pragma unroll
                for (int s = 0; s < NQ; s += 2) {
                    if (s + 1 < NQ) asm volatile("s_waitcnt lgkmcnt(2)" ::: "memory"); else asm volatile("s_waitcnt lgkmcnt(0)" ::: "memory");
                    __builtin_amdgcn_sched_barrier(0);
                    p0 = __builtin_amdgcn_mfma_f32_32x32x16_bf16(f0, qr[s], p0, 0, 0, 0); p1 = __builtin_amdgcn_mfma_f32_32x32x16_bf16(f1, qr[s], p1, 0, 0, 0);
                    __builtin_amdgcn_sched_barrier(0);
                    if (s + 2 < NQ) ATT_KISSUE(s + 2, f0, f1);
                    if (s + 2 < NQ) asm volatile("s_waitcnt lgkmcnt(2)" ::: "memory"); else asm volatile("s_waitcnt lgkmcnt(0)" ::: "memory");
                    __builtin_amdgcn_sched_barrier(0);
                    p0 = __builtin_amdgcn_mfma_f32_32x32x16_bf16(f2, qr[s + 1], p0, 0, 0, 0); p1 = __builtin_amdgcn_mfma_f32_32x32x16_bf16(f3, qr[s + 1], p1, 0, 0, 0);
                    __builtin_amdgcn_sched_barrier(0);
                    if (s + 3 < NQ) ATT_KISSUE(s + 3, f2, f3);
                }
                __builtin_amdgcn_s_setprio(0);
#undef ATT_KISSUE
#undef ATT_KRD
            }
            const int dq = qpos - kb - 4 * hi;
            if (MODE != 2) {
                if (MODE == 0) {
#pragma unroll
                    for (int r = 0; r < 16; ++r) { const int c = (r & 3) + 8 * (r >> 2); const int e0 = dq - c, e1 = dq - c - 32;
                        const float b0 = blut[e0 < 0 ? 0 : (e0 > 127 ? 127 : e0)], b1 = blut[e1 < 0 ? 0 : (e1 > 127 ? 127 : e1)];
                        p0[r] = ((unsigned)e0 < 128u) ? p0[r] + b0 : NEG; p1[r] = ((unsigned)e1 < 128u) ? p1[r] + b1 : NEG; }
                } else {
                    if (kb + 63 > qlo) {
#pragma unroll
                        for (int r = 0; r < 16; ++r) { const int c = (r & 3) + 8 * (r >> 2); if (dq - c < 0) p0[r] = NEG; if (dq - c - 32 < 0) p1[r] = NEG; }
                    }
                }
                float pmax = p0[0];
#pragma unroll
                for (int r = 1; r < 16; ++r) pmax = fmaxf(pmax, p0[r]);
#pragma unroll
                for (int r = 0; r < 16; ++r) pmax = fmaxf(pmax, p1[r]);
                { auto rr = __builtin_amdgcn_permlane32_swap(__float_as_uint(pmax), __float_as_uint(pmax), false, false); pmax = fmaxf(__uint_as_float(rr[0]), __uint_as_float(rr[1])); }
                float mn, alpha;
                if (__all(pmax - m_reg <= THR)) { mn = m_reg; alpha = 1.f; }
                else { mn = fmaxf(m_reg, pmax); alpha = __builtin_amdgcn_exp2f(m_reg - mn); m_reg = mn; }
                float ps = 0.f;
#pragma unroll
                for (int r = 0; r < 16; ++r) { p0[r] = __builtin_amdgcn_exp2f(p0[r] - mn); p1[r] = __builtin_amdgcn_exp2f(p1[r] - mn); ps += p0[r] + p1[r]; }
                { auto rr = __builtin_amdgcn_permlane32_swap(__float_as_uint(ps), __float_as_uint(ps), false, false); ps = __uint_as_float(rr[0]) + __uint_as_float(rr[1]); }
                l_reg = l_reg * alpha + ps;
                if (__any(alpha < 1.f)) {
#pragma unroll
                    for (int r = 0; r < 16; ++r)
#pragma unroll
                        for (int d = 0; d < 4; ++d) o[d][r] *= alpha;
                }
            } else {
                float T[8];
#pragma unroll
                for (int i = 0; i < 8; ++i) {
                    float x[4], zz[4];
#pragma unroll
                    for (int a = 0; a < 4; ++a) { const int r = (i & 3) * 4 + a; const float z = (i < 4) ? p0[r] : p1[r]; const int c = (r & 3) + 8 * (r >> 2) + ((i < 4) ? 0 : 32);
                        const bool past = (dq - c) > 0;
                        const float lk = -(fmaxf(z, 0.f) + __builtin_amdgcn_logf(1.0f + __builtin_amdgcn_exp2f(-fabsf(z))));
                        x[a] = past ? lk : 0.f; zz[a] = past ? (z + lk) : NEG; }
                    const float e2 = x[3], e1 = x[3] + x[2], e0 = e1 + x[1];
                    T[i] = e0 + x[0];
                    if (i < 4) { p0[(i & 3) * 4 + 0] = zz[0] + e0; p0[(i & 3) * 4 + 1] = zz[1] + e1; p0[(i & 3) * 4 + 2] = zz[2] + e2; p0[(i & 3) * 4 + 3] = zz[3]; }
                    else       { p1[(i & 3) * 4 + 0] = zz[0] + e0; p1[(i & 3) * 4 + 1] = zz[1] + e1; p1[(i & 3) * 4 + 2] = zz[2] + e2; p1[(i & 3) * 4 + 3] = zz[3]; }
                }
                float U[8], PT[8];
#pragma unroll
                for (int i = 0; i < 8; ++i) { auto rr = __builtin_amdgcn_permlane32_swap(__float_as_uint(T[i]), __float_as_uint(T[i]), false, false);
                    const float tlo = __uint_as_float(rr[0]), thi = __uint_as_float(rr[1]); U[i] = tlo + thi; PT[i] = hi ? 0.f : thi; }
                float su = carry;
#pragma unroll
                for (int i = 7; i >= 0; --i) {
                    const float A = su + PT[i];
#pragma unroll
                    for (int a = 0; a < 4; ++a) { const int r = (i & 3) * 4 + a; if (i < 4) p0[r] = __builtin_amdgcn_exp2f(p0[r] + A); else p1[r] = __builtin_amdgcn_exp2f(p1[r] + A); }
                    su += U[i];
                }
                carry = su;
            }
            ATT_PK4(p0, 0, pa0); ATT_PK4(p0, 8, pa1); ATT_PK4(p1, 0, pa2); ATT_PK4(p1, 8, pa3);
            if (lag) pend = true; else ATT_PV_ALL(vcur);
        }
        VM_WAIT();
        if (MODE == 2) { if (lane == 0) flags[cur * 8 + wid] = __all(carry < -150.f) ? 1u : 0u; }
        __syncthreads();
        if (MODE == 2) { bool alld = true;
#pragma unroll
            for (int w = 0; w < 8; ++w) alld = alld && (flags[cur * 8 + w] != 0u);
            if (alld) break; }
    }
    if (pend) { ATT_PV_ALL(vcur); }
#undef ATT_PV_ALL
#undef ATT_PV
#undef ATT_TRRD
    const int orow = wid * 32 + r32;
    const GAS unsigned char* const Gub = (const GAS unsigned char*)uni_ptr(Gp); GAS unsigned char* const Oub = (GAS unsigned char*)uni_ptr(Op);
    const unsigned goff = (unsigned)(orow * PP + 8 * hi) * 2u, yoff = (unsigned)(orow * YW + 8 * hi) * 2u;
    auto fin_d0 = [&](const int d0, const f32x16& val, const float inv, const v4u g0, const v4u g1) __attribute__((always_inline)) {
#pragma unroll
        for (int pr = 0; pr < 2; ++pr) { float x[8];
#pragma unroll
            for (int i = 0; i < 4; ++i) { auto rr = __builtin_amdgcn_permlane32_swap(__float_as_uint(val[8 * pr + i] * inv), __float_as_uint(val[8 * pr + 4 + i] * inv), false, false);
                x[i] = __uint_as_float(rr[0]); x[4 + i] = __uint_as_float(rr[1]); }
            const v4u g = pr ? g1 : g0; v4u w;
            w.x = cvtpk(x[0] * pg8::bf_lo(g.x), x[1] * pg8::bf_hi(g.x)); w.y = cvtpk(x[2] * pg8::bf_lo(g.y), x[3] * pg8::bf_hi(g.y));
            w.z = cvtpk(x[4] * pg8::bf_lo(g.z), x[5] * pg8::bf_hi(g.z)); w.w = cvtpk(x[6] * pg8::bf_lo(g.w), x[7] * pg8::bf_hi(g.w));
            *(GAS v4u*)(Oub + (yoff + (unsigned)(d0 * 32 + 16 * pr) * 2u)) = w; }
    };
    auto finish = [&](const float inv) __attribute__((always_inline)) {
        v4u gw[4][2];
#pragma unroll
        for (int d0 = 0; d0 < 4; ++d0)
#pragma unroll
            for (int pr = 0; pr < 2; ++pr) gw[d0][pr] = *(const GAS v4u*)(Gub + (goff + (unsigned)(d0 * 32 + 16 * pr) * 2u));
#pragma unroll
        for (int d0 = 0; d0 < 4; ++d0) fin_d0(d0, o[d0], inv, gw[d0][0], gw[d0][1]);
    };
    const unsigned slot16 = (unsigned)(wid * 64 + lane) * 16u;
    if (MODE == 1) {
        const char* const Pub = uni_ptr(Opart);
#pragma unroll
        for (int d0 = 0; d0 < 4; ++d0)
#pragma unroll
            for (int g = 0; g < 4; ++g) { const f32x4 v = {o[d0][4 * g], o[d0][4 * g + 1], o[d0][4 * g + 2], o[d0][4 * g + 3]};
                asm volatile("global_store_dwordx4 %0, %1, %2 sc1" :: "v"(slot16 + (unsigned)(d0 * 4 + g) * 8192u), "v"(v), "s"(Pub) : "memory"); }
        if (hi == 0) { __hip_atomic_store((GAS unsigned long long*)(MLp + (size_t)orow * 2), ((unsigned long long)__float_as_uint(l_reg) << 32) | __float_as_uint(m_reg), RLX_AGENT); }
        VM_WAIT();
        __syncthreads();
        if (tid == 0) { const unsigned old = __hip_atomic_fetch_add(cnt, 1u, RLX_AGENT); *bflag = (old + 1u == (unsigned)nparts) ? 1u : 0u; }
        __syncthreads();
        const bool lastp = (*bflag != 0u);
        if (lastp) {
            __builtin_amdgcn_fence(__ATOMIC_ACQUIRE, "agent"); VM_WAIT();
            const GAS unsigned char* const P0ub = (const GAS unsigned char*)uni_ptr(Opart0);
            f32x2 mlv[4]; float wp[4]; float mmx = -1e30f, Ls = 0.f;
#pragma unroll
            for (int p = 0; p < 4; ++p) if (p < nparts) mlv[p] = *(const GAS f32x2*)(ML0 + (size_t)p * 512 + orow * 2);
#pragma unroll
            for (int p = 0; p < 4; ++p) if (p < nparts) mmx = fmaxf(mmx, mlv[p].x);
#pragma unroll
            for (int p = 0; p < 4; ++p) { wp[p] = 0.f; if (p < nparts) { wp[p] = __builtin_amdgcn_exp2f(mlv[p].x - mmx); Ls += wp[p] * mlv[p].y; } }
            const float invL = 1.0f / Ls;
#pragma unroll
            for (int d0 = 0; d0 < 4; ++d0) {
                f32x4 pv[4][4];
#pragma unroll
                for (int g = 0; g < 4; ++g)
#pragma unroll
                    for (int p = 0; p < 4; ++p) if (p < nparts) pv[g][p] = *(const GAS f32x4*)(P0ub + (slot16 + (unsigned)p * 131072u + (unsigned)(d0 * 4 + g) * 8192u));
                const v4u g0 = *(const GAS v4u*)(Gub + (goff + (unsigned)(d0 * 32) * 2u)), g1 = *(const GAS v4u*)(Gub + (goff + (unsigned)(d0 * 32 + 16) * 2u));
                f32x16 mv;
#pragma unroll
                for (int g = 0; g < 4; ++g) { f32x4 acc4 = pv[g][0] * wp[0];
#pragma unroll
                    for (int p = 1; p < 4; ++p) if (p < nparts) acc4 += pv[g][p] * wp[p];
                    mv[4 * g] = acc4[0]; mv[4 * g + 1] = acc4[1]; mv[4 * g + 2] = acc4[2]; mv[4 * g + 3] = acc4[3]; }
                fin_d0(d0, mv, invL, g0, g1);
                asm volatile("" ::: "memory"); __builtin_amdgcn_sched_barrier(0);
            }
        }
        __syncthreads();
        return;
    }
    if (MODE == 2) finish(1.0f);
    else { const float mf = fmaxf(m_reg, sink2); const float a = __builtin_amdgcn_exp2f(m_reg - mf); finish(a / (l_reg * a + __builtin_amdgcn_exp2f(sink2 - mf))); }
    __syncthreads();
#undef ATT_TILE
#undef ATT_DMA
}
}

__device__ __forceinline__ void attn_phase(Frame& F, const Args& A, int layer, int rep) {
    volatile LAS unsigned* MISC = (volatile LAS unsigned*)(F.lds + MISC_OFF);
    gu32* qhead = F.ctl + CW_QUEUE + 64 * (2 * layer + rep);
    unsigned nid = 0u;
    if (threadIdx.x == 0) nid = __hip_atomic_fetch_add(qhead, 1u, RLX_AGENT);
    for (;;) {
        if (threadIdx.x == 0) MISC[16] = nid;
        __syncthreads();
        const unsigned id = MISC[16];
        __syncthreads();
        if (id >= 1408u) break;
        if (threadIdx.x == 0) nid = __hip_atomic_fetch_add(qhead, 1u, RLX_AGENT);
        if (id < 640u && !(ATTN_MFMA_MASK & 2)) continue;
        if (id >= 640u && id < 896u && !(ATTN_MFMA_MASK & 4)) continue;
        if (id >= 896u && !(ATTN_MFMA_MASK & 1)) continue;
        if (id < 640u) {
            int h, qb, p;
            if (id < 384u) { const int idx = (int)(id >> 2); h = (int)(id & 3);
                if (idx < 16) { qb = 16 + idx; p = 0; } else if (idx < 48) { const int k = idx - 16; qb = 32 + (k >> 1); p = k & 1; } else { const int k = idx - 48; qb = 48 + k / 3; p = k % 3; } }
            else { const int jj = (int)id - 384, c = 15 - (jj >> 4), r = jj & 15; h = r & 3; const int g = r >> 2; qb = 16 * g + c; p = g; }
            const int P0 = qb * 256, jlo = 64 * p, jhi_full = 4 * (qb + 1), jhi = (64 * (p + 1) < jhi_full) ? 64 * (p + 1) : jhi_full;
            const size_t slot = (size_t)((h * 64 + qb) * 4 + p);
            const size_t slot0 = (size_t)((h * 64 + qb) * 4);
            att::attn_unit<1>(F.lds + RING_OFF, F.QM + (size_t)P0 * 768 + h * 192, 768, F.KVM + h * 256, F.KVM + h * 256 + 128, 1024, F.KRM,
                              F.P + (size_t)P0 * PP + C_ZB + h * 128, F.Y + (size_t)P0 * YW + 1024 + h * 128, P0, 0.f, nullptr, jlo, jhi, F.OPART + slot * 32768, F.ML + slot * 512,
                              F.ctl + CW_MLACNT + 256 * layer + h * 64 + qb, (qb >> 4) + 1, F.OPART + slot0 * 32768, F.ML + slot0 * 512, MISC + 17); }
        else if (id < 896u) { const int i = (int)id - 640, qb = 63 - (i >> 2), h = i & 3, P0 = qb * 256;
            att::attn_unit<2>(F.lds + RING_OFF, F.P + (size_t)P0 * PP + C_QC + h * 128, PP, F.P + C_KC + h * 128, F.P + C_VC + h * 128, PP, nullptr,
                              F.P + (size_t)P0 * PP + C_ZC + h * 128, F.Y + (size_t)P0 * YW + 1536 + h * 128, P0, 0.f, nullptr, 0, 0, nullptr, nullptr); }
        else { const int i = (int)id - 896, qb = i >> 3, h = i & 7, P0 = qb * 256;
            att::attn_unit<0>(F.lds + RING_OFF, F.P + (size_t)P0 * PP + C_QA + h * 128, PP, F.P + C_KA + (h >> 2) * 128, F.P + C_VA + (h >> 2) * 128, PP, nullptr,
                              F.P + (size_t)P0 * PP + C_ZA + h * 128, F.Y + (size_t)P0 * YW + h * 128, P0, A.sinks[layer * 8 + h] * LOG2E, F.BLUT + h * 128, 0, 0, nullptr, nullptr); }
    }
}
__global__ void __launch_bounds__(NWAVES * 64, 2) hybrid_fwd(Args args) {
    extern __shared__ __attribute__((aligned(16))) unsigned char lds[];
    Frame F;
    F.lds = (LAS unsigned char*)lds;
    volatile LAS unsigned* MISC = (volatile LAS unsigned*)(F.lds + MISC_OFF);
    F.G = gridDim.x; F.NGW = F.G * NWAVES;
    set_ptrs(F, args.ws);
    for (int u = threadIdx.x; u < (LDS_BYTES - LDSCTL_OFF) / 4; u += NWAVES * 64) ((LAS unsigned*)(F.lds + LDSCTL_OFF))[u] = 0u;
    __syncthreads();
    XcdBarrier bar; bar.bar = (unsigned*)(F.ctl + CW_BAR); bar.x = 0; bar.st = nullptr;
    if (!MK_PER_PHASE) bar = xcd_barrier_post((unsigned*)(F.ctl + CW_BAR), MISC + 8);
    const int lo = args.ph_lo, hi = args.ph_hi;
#define IN(k) (lo <= (k) && (k) < hi)
#define SEAM(k) do { if (IN(k) && IN((k) + 1)) xcd_barrier(bar); } while (0)

    { if (IN(0)) { set_ptrs(F, args.ws); p0_prologue(F, args); set_ptrs(F, args.ws); prep_rows<0>(F, args.x, F.XB, F.RS, nullptr, nullptr, F.XQ, F.SA); } }
    SEAM(0);
    { if (IN(1)) { set_ptrs(F, args.ws); p0b_gate_quant(F, args); } }
    SEAM(1);
    for (int l = 0; l < DEPTH; ++l) {
        const int pb = 2 + 6 * l;
        { if (IN(pb) && l > 0) { set_ptrs(F, args.ws); prep_q8(F, F.XB, F.SSQ_X + (l - 1) * S, F.ROWMAX + (l - 1) * S, F.RS, F.SA, F.XQ); } }
        if (l > 0) SEAM(pb);
        { if (IN(pb + 1)) { set_ptrs(F, args.ws);
            { pg8::Gemm g{F.XB, F.Win + (size_t)l * NB * DM, S, NB, DM, DM, DM}; pg8::StaticOrder So; So.init(S, NB, F.G, (int)blockIdx.x);
              EpiInProj E{F.P, F.RS, F.KRM, F.ROPEC, F.ROPES, F.SSQ_Q + l * S, F.SSQ_KV + l * S, true};
              pg8::gemm_phase<EpiInProj, pg8::StaticOrder, true, true>(F.lds + RING_OFF, g, So, E); }
            set_ptrs(F, args.ws);
            { pg8::Gemm g{(const bf16*)F.XQ, (const bf16*)(F.WG8 + (size_t)l * NG * DM), S, NG, DM / 2, DM / 2, DM / 2}; pg8::StaticOrder So; So.init(S, NG, F.G, (int)blockIdx.x);
              EpiGateI8 E{F.P, F.RS, F.SA, F.SB + l * NG, F.SSQ_Q + l * S, F.KRM, F.ROPEC, F.ROPES, F.GT};
              pg8::gemm_phase<EpiGateI8, pg8::StaticOrder, true, true>(F.lds + RING_OFF, g, So, E); }
        } }
        SEAM(pb + 1);
        { if (IN(pb + 2)) { set_ptrs(F, args.ws);
            { pg8::Gemm g{F.P + C_CQ, F.Wq + (size_t)l * 768 * 1024, S, 768, 1024, PP, 1024}; pg8::StaticOrder So; So.init(S, 768, F.G, (int)blockIdx.x);
              EpiQUp E{F.QM, F.SSQ_Q + l * S, F.ROPEC, F.ROPES};
              pg8::gemm_phase<EpiQUp, pg8::StaticOrder, true, true>(F.lds + RING_OFF, g, So, E); }
            set_ptrs(F, args.ws);
            { pg8::Gemm g{F.P + C_CKV, F.Wkv + (size_t)l * 1024 * 512, S, 1024, 512, PP, 512}; pg8::StaticOrder So; So.init(S, 1024, F.G, (int)blockIdx.x);
              EpiKvUp E{F.KVM, F.SSQ_KV + l * S};
              pg8::gemm_phase<EpiKvUp, pg8::StaticOrder, true, true>(F.lds + RING_OFF, g, So, E); }
        } }
        SEAM(pb + 2);
        { if (IN(pb + 3)) { set_ptrs(F, args.ws); attn_phase(F, args, l, 0); if (ATTN_MFMA_MASK != 7) { __syncthreads(); naive_attn_phase(F, args, l); } } }
        SEAM(pb + 3);
        { if (IN(pb + 4)) {
            { set_ptrs(F, args.ws); pg8::Gemm g{F.Y, F.Wproj + (size_t)l * DM * YW, S, DM, YW, YW, YW}; pg8::StaticOrder So; So.init(S, DM, F.G, (int)blockIdx.x);
              EpiProjFused E{F.GT, F.MBF, 16, 24}; pg8::gemm_phase<EpiProjFused, pg8::StaticOrder, true, true>(F.lds + RING_OFF, g, So, E); }
        } }
        SEAM(pb + 4);
        { if (IN(pb + 5)) { set_ptrs(F, args.ws);
            pg8::Gemm g{F.MBF, F.Wout + (size_t)l * DM * DM, S, DM, DM, DM, DM}; pg8::StaticOrder So; So.init(S, DM, F.G, (int)blockIdx.x);
            EpiOut E{(l == 0) ? args.x : F.X1, (l == 0) ? F.X1 : args.out, F.XB, F.SSQ_X + l * S, F.ROWMAX + l * S, false, true, l == DEPTH - 1, l > 0, l < DEPTH - 1};
            pg8::gemm_phase<EpiOut, pg8::StaticOrder, true, true>(F.lds + RING_OFF, g, So, E);
        } }
        SEAM(pb + 5);
    }
    if (IN(14)) { set_ptrs(F, args.ws); final_norm(F, F.XB, F.SSQ_X + (DEPTH - 1) * S, args.out, args.final_g); }
#undef IN
#undef SEAM
}

extern "C" void kernel_launch(void* const* d_in, const int* in_sizes, int n_in, void* d_out, int out_size, void* d_ws, size_t ws_size, hipStream_t stream) {
    static int grid = 0;
    if (grid == 0) {
        if (n_in != 14 || in_sizes[0] != S * DM || out_size != S * DM || ws_size < WS_END) { fprintf(stderr, "kernel_launch: unexpected shapes (n_in %d, in0 %d, out %d, ws %zu)\n", n_in, n_in > 0 ? in_sizes[0] : -1, out_size, ws_size); grid = -1; return; }
        int dev = 0, cus = 0, per_cu = 0;
        if (hipGetDevice(&dev) != hipSuccess || hipDeviceGetAttribute(&cus, hipDeviceAttributeMultiprocessorCount, dev) != hipSuccess) { grid = -1; return; }
        if (hipFuncSetAttribute((const void*)hybrid_fwd, hipFuncAttributeMaxDynamicSharedMemorySize, LDS_BYTES) != hipSuccess) { fprintf(stderr, "kernel_launch: hipFuncSetAttribute failed\n"); grid = -1; return; }
        if (hipOccupancyMaxActiveBlocksPerMultiprocessor(&per_cu, (const void*)hybrid_fwd, NWAVES * 64, LDS_BYTES) != hipSuccess || per_cu < 1)
            fprintf(stderr, "kernel_launch: occupancy query reports %d workgroups per CU\n", per_cu);
        (void)hipGetLastError();
        grid = cus;
    }
    if (grid < 0) return;
    if (hipMemsetAsync((char*)d_ws + WS_CTL, 0, CTL_ZERO_BYTES, stream) != hipSuccess) { fprintf(stderr, "kernel_launch: memset failed\n"); return; }
    Args a{};
    a.x = (const float*)d_in[0]; a.norm_g = (const float*)d_in[1]; a.w_in = (const float*)d_in[2]; a.sinks = (const float*)d_in[3]; a.rel_bias = (const float*)d_in[4];
    a.g_q = (const float*)d_in[5]; a.w_q_up = (const float*)d_in[6]; a.g_kv = (const float*)d_in[7]; a.w_kv_up = (const float*)d_in[8];
    a.w_pa = (const float*)d_in[9]; a.w_pb = (const float*)d_in[10]; a.w_pc = (const float*)d_in[11]; a.w_out = (const float*)d_in[12]; a.final_g = (const float*)d_in[13];
    a.out = (float*)d_out; a.ws = (unsigned char*)d_ws;
    constexpr int NPH = 15;
    if (MK_PER_PHASE) {
        for (int p = 0; p < NPH; ++p) { a.ph_lo = p; a.ph_hi = p + 1; hipLaunchKernelGGL(hybrid_fwd, dim3(grid), dim3(NWAVES * 64), LDS_BYTES, stream, a); }
    } else {
        a.ph_lo = 0; a.ph_hi = NPH;
        hipLaunchKernelGGL(hybrid_fwd, dim3(grid), dim3(NWAVES * 64), LDS_BYTES, stream, a);
    }
    const hipError_t le = hipPeekAtLastError();
    if (le != hipSuccess) fprintf(stderr, "kernel_launch: launch failed: %s\n", hipGetErrorName(le));
}
```

```cpp
#include <hip/hip_runtime.h>
#include <cstdio>
#include <cstdint>

#ifndef MK_PER_PHASE
#define MK_PER_PHASE 0
#endif
#ifndef ATTN_MFMA_MASK
#define ATTN_MFMA_MASK 7
#endif

namespace pg8 {
#define PG8_LAS __attribute__((address_space(3)))
typedef unsigned short bf16_t;
typedef short bf16x8 __attribute__((ext_vector_type(8)));
typedef float f32x4 __attribute__((ext_vector_type(4)));
typedef float f32x2 __attribute__((ext_vector_type(2)));
typedef unsigned u32x4 __attribute__((ext_vector_type(4)));
typedef unsigned u32x2 __attribute__((ext_vector_type(2)));
typedef int i32x4 __attribute__((ext_vector_type(4)));
constexpr int BM = 256, BK = 64, HALF = 128, HTB = HALF * BK * 2, STAGE_BYTES = 8 * HTB, NXCD = 8, WGM = 8;

__host__ __device__ __forceinline__ int lds_byte(int r, int c) { const int st = (r >> 4) * 2 + (c >> 5), rr = r & 15, cc = c & 31, ob = rr * 64 + cc * 2; return st * 1024 + (ob ^ (((ob >> 9) & 1) << 5)); }
__host__ __device__ __forceinline__ void stage_rc(int b, int& R, int& C) { const int st = b / 1024, sb = b % 1024, swz = sb ^ (((sb >> 9) & 1) << 5); R = (st >> 1) * 16 + swz / 64; C = (st & 1) * 32 + (swz % 64) / 2; }
__host__ __device__ __forceinline__ int perm32(int rho) { const int n = rho >> 4, i = rho & 15; return 8 * (i >> 2) + 4 * n + (i & 3); }

struct Unit { int pm, pn; };
struct Gemm { const bf16_t* A; const bf16_t* Bt; int M, N, K, lda, ldb; };

struct StaticOrder {
    int nM, nN, nwg, G, c;
    __host__ __device__ void init(int M, int N, int G_, int c_) { nM = M / BM; nN = N / BM; nwg = nM * nN; G = G_; c = c_; }
    __host__ __device__ bool next(int i, Unit& u) const {
        const long L = (long)i * G + c; if (L >= nwg) return false;
        int wgid = (int)L; { const int q = nwg / NXCD, r = nwg % NXCD, xcd = wgid % NXCD, off = wgid / NXCD; wgid = (xcd < r ? xcd * (q + 1) : r * (q + 1) + (xcd - r) * q) + off; }
        const int nig = WGM * nN, gid = wgid / nig, fm = gid * WGM, gsz = (nM - fm) < WGM ? (nM - fm) : WGM;
        u.pm = fm + ((wgid % nig) % gsz); u.pn = (wgid % nig) / gsz; return true;
    }
    __device__ __forceinline__ void a_ready(const Unit&) const {}
    __device__ __forceinline__ void done(const Unit&) const {}
};

__device__ __forceinline__ unsigned cvt_pk_bf16(float lo, float hi) { unsigned r; asm volatile("v_cvt_pk_bf16_f32 %0, %1, %2" : "=v"(r) : "v"(lo), "v"(hi)); return r; }
__device__ __forceinline__ unsigned cvt_pk_f16(float lo, float hi) { typedef _Float16 h2 __attribute__((ext_vector_type(2))); h2 v; v.x = (_Float16)lo; v.y = (_Float16)hi; return __builtin_bit_cast(unsigned, v); }
__device__ __forceinline__ float bf_lo(unsigned w) { return __uint_as_float(w << 16); }
__device__ __forceinline__ float bf_hi(unsigned w) { return __uint_as_float(w & 0xffff0000u); }

__device__ __forceinline__ f32x4 mma16(bf16x8 b, bf16x8 a, f32x4 c) { return __builtin_amdgcn_mfma_f32_16x16x32_bf16(b, a, c, 0, 0, 0); }
__device__ __forceinline__ i32x4 mma16(bf16x8 b, bf16x8 a, i32x4 c) { return __builtin_amdgcn_mfma_i32_16x16x64_i8(__builtin_bit_cast(i32x4, b), __builtin_bit_cast(i32x4, a), c, 0, 0, 0); }
template <class Epi, class Sched, bool ALIGN_EPI = false, bool SP2 = false>
__device__ __forceinline__ void gemm_phase(PG8_LAS unsigned char* lds, const Gemm g, const Sched& S, const Epi& E) {
    int tid = threadIdx.x; asm volatile("" : "+v"(tid));
    const int wid = __builtin_amdgcn_readfirstlane(tid >> 6), lane = tid & 63, wr = wid >> 2, wc = wid & 3, fr = lane & 15, fq = lane >> 4;
    const int K = g.K, nt = K / BK;
    unsigned voffA[2], voffB[2];
#pragma unroll
    for (int i = 0; i < 2; ++i) { int R, C; stage_rc(tid * 16 + i * 8192, R, C); const int Rb = Epi::PERM ? ((R & ~31) + perm32(R & 31)) : R;
        voffA[i] = (unsigned)(R * g.lda + C) * 2u; voffB[i] = (unsigned)(Rb * g.ldb + C) * 2u; }
    const size_t kstep = (size_t)(BK * 2);
    const size_t hstepA = (size_t)HALF * g.lda * 2, hstepB = (size_t)HALF * g.ldb * 2;
    const size_t tstepA = 2 * hstepA, tstepB = 2 * hstepB;
    const unsigned ldsw = (unsigned)wid * 1024u;
    const int aoff = lds_byte(wr * 64 + fr, fq * 8), boff = lds_byte(wc * 32 + fr, fq * 8);
#define PG8_SA(b, h) (((b) * 2 + (h)) * HTB)
#define PG8_SB(b, h) ((4 + (b) * 2 + (h)) * HTB)
#define PG8_STAGE(bufoff, gbase, voff) do { _Pragma("unroll") for (int _i = 0; _i < 2; ++_i) \
        __builtin_amdgcn_global_load_lds((const unsigned*)((const char*)(gbase) + (voff)[_i]), (PG8_LAS unsigned*)(lds + (bufoff) + ldsw + _i * 8192), 16, 0, 0); } while (0)
#define PG8_LDA(dst, b, h) do { _Pragma("unroll") for (int m = 0; m < 4; ++m) _Pragma("unroll") for (int k = 0; k < 2; ++k) dst[m][k] = *(const PG8_LAS bf16x8*)(lds + PG8_SA(b, h) + aoff + m * 2048 + k * 1024); } while (0)
#define PG8_LDB(dst, b, h) do { _Pragma("unroll") for (int n = 0; n < 2; ++n) _Pragma("unroll") for (int k = 0; k < 2; ++k) dst[n][k] = *(const PG8_LAS bf16x8*)(lds + PG8_SB(b, h) + boff + n * 2048 + k * 1024); } while (0)
#define PG8_MMA(ai, bj, At, Bt) do { __builtin_amdgcn_s_setprio(1); _Pragma("unroll") for (int m = 0; m < 4; ++m) _Pragma("unroll") for (int n = 0; n < 2; ++n) _Pragma("unroll") for (int k = 0; k < 2; ++k) \
        acc[ai][bj][m][n] = mma16(Bt[n][k], At[m][k], acc[ai][bj][m][n]); __builtin_amdgcn_s_setprio(0); } while (0)
#define PG8_WAIT_V(n) asm volatile("s_waitcnt vmcnt(" #n ")" ::: "memory")
#define PG8_WAIT_L(n) asm volatile("s_waitcnt lgkmcnt(" #n ")" ::: "memory")
#define PG8_BAR __builtin_amdgcn_s_barrier()
#define PG8_SCHED __builtin_amdgcn_sched_barrier(0)
    Unit cur, nxt; int ui = 0;
    if (!S.next(0, cur)) return;
    typedef typename Epi::acc_t acc_t;
    acc_t acc[2][2][4][2];
#pragma unroll
    for (int a = 0; a < 2; ++a)
#pragma unroll
        for (int b = 0; b < 2; ++b)
#pragma unroll
            for (int m = 0; m < 4; ++m)
#pragma unroll
                for (int n = 0; n < 2; ++n) acc[a][b][m][n] = (acc_t){0, 0, 0, 0};
    bf16x8 At[4][2], B0[2][2], B1[2][2];
    const char* cA = (const char*)g.A + (size_t)cur.pm * tstepA; const char* cB = (const char*)g.Bt + (size_t)cur.pn * tstepB;
    S.a_ready(cur);
    if constexpr (SP2) {
        PG8_STAGE(PG8_SB(0, 0), cB, voffB); PG8_STAGE(PG8_SB(0, 1), cB + hstepB, voffB); PG8_STAGE(PG8_SA(0, 0), cA, voffA); PG8_STAGE(PG8_SA(0, 1), cA + hstepA, voffA);
        if (wr == 1) PG8_BAR;
        PG8_WAIT_V(2); PG8_BAR;
        PG8_STAGE(PG8_SB(1, 0), cB + kstep, voffB); PG8_STAGE(PG8_SA(1, 0), cA + kstep, voffA); PG8_STAGE(PG8_SB(1, 1), cB + hstepB + kstep, voffB);
        PG8_WAIT_V(6); PG8_BAR;
    } else {
        PG8_STAGE(PG8_SB(0, 0), cB, voffB); PG8_STAGE(PG8_SA(0, 0), cA, voffA); PG8_STAGE(PG8_SB(0, 1), cB + hstepB, voffB); PG8_STAGE(PG8_SA(0, 1), cA + hstepA, voffA);
        if (wr == 1) PG8_BAR;
        PG8_WAIT_V(4); PG8_BAR;
        PG8_STAGE(PG8_SB(1, 0), cB + kstep, voffB); PG8_STAGE(PG8_SA(1, 0), cA + kstep, voffA); PG8_STAGE(PG8_SB(1, 1), cB + hstepB + kstep, voffB);
        PG8_WAIT_V(6); PG8_BAR;
    }
    for (;;) {
        const bool has_next = S.next(ui + 1, nxt);
        const char* nA = has_next ? (const char*)g.A + (size_t)nxt.pm * tstepA : cA; const char* nB = has_next ? (const char*)g.Bt + (size_t)nxt.pn * tstepB : cB;
        for (int t = 0; t < nt; t += 2) {
            const bool last = (t == nt - 2);
            const char* a1 = cA + (size_t)(t + 1) * kstep;
            const char* a2 = last ? nA : cA + (size_t)(t + 2) * kstep; const char* b2 = last ? nB : cB + (size_t)(t + 2) * kstep;
            const char* a3 = a2 + kstep; const char* b3 = b2 + kstep;
            if (last && has_next) S.a_ready(nxt);
            if constexpr (Epi::MID) { if (t == E.t1 || t == E.t2) E.mid(acc, cur, t == E.t2, wr, wc, fr, fq); }
            if constexpr (SP2) {
            PG8_LDB(B0, 0, 0); PG8_LDB(B1, 0, 1); PG8_SCHED; PG8_LDA(At, 0, 0); PG8_STAGE(PG8_SA(1, 1), a1 + hstepA, voffA);
            PG8_WAIT_V(8); PG8_WAIT_L(0); PG8_BAR; PG8_MMA(0, 0, At, B0); PG8_MMA(0, 1, At, B1); PG8_BAR; PG8_SCHED;
            PG8_LDA(At, 0, 1); PG8_STAGE(PG8_SB(0, 0), b2, voffB); PG8_STAGE(PG8_SB(0, 1), b2 + hstepB, voffB); PG8_STAGE(PG8_SA(0, 0), a2, voffA);
            PG8_WAIT_V(8); PG8_WAIT_L(0); PG8_BAR; PG8_MMA(1, 0, At, B0); PG8_MMA(1, 1, At, B1); PG8_BAR; PG8_SCHED;
            PG8_LDB(B0, 1, 0); PG8_LDB(B1, 1, 1); PG8_SCHED; PG8_LDA(At, 1, 0); PG8_STAGE(PG8_SA(0, 1), a2 + hstepA, voffA);
            PG8_WAIT_V(8); PG8_WAIT_L(0); PG8_BAR; PG8_MMA(0, 0, At, B0); PG8_MMA(0, 1, At, B1); PG8_BAR; PG8_SCHED;
            PG8_LDA(At, 1, 1); PG8_STAGE(PG8_SB(1, 0), b3, voffB); PG8_STAGE(PG8_SB(1, 1), b3 + hstepB, voffB); PG8_STAGE(PG8_SA(1, 0), a3, voffA);
            PG8_WAIT_V(8); PG8_WAIT_L(0); PG8_BAR; PG8_MMA(1, 0, At, B0); PG8_MMA(1, 1, At, B1); PG8_BAR; PG8_SCHED;
            } else {
            PG8_LDB(B0, 0, 0); PG8_SCHED; PG8_LDA(At, 0, 0); PG8_STAGE(PG8_SA(1, 1), a1 + hstepA, voffA);
            PG8_WAIT_L(8); PG8_BAR; PG8_WAIT_L(0); PG8_MMA(0, 0, At, B0); PG8_BAR; PG8_SCHED;
            PG8_LDB(B1, 0, 1); PG8_STAGE(PG8_SB(0, 0), b2, voffB);
            PG8_BAR; PG8_WAIT_L(0); PG8_MMA(0, 1, At, B1); PG8_BAR;
            PG8_LDA(At, 0, 1); PG8_STAGE(PG8_SA(0, 0), a2, voffA);
            PG8_BAR; PG8_WAIT_L(0); PG8_MMA(1, 0, At, B0); PG8_BAR; PG8_SCHED;
            PG8_STAGE(PG8_SB(0, 1), b2 + hstepB, voffB);
            PG8_WAIT_V(6); PG8_BAR; PG8_MMA(1, 1, At, B1); PG8_BAR;
            PG8_LDB(B0, 1, 0); PG8_SCHED; PG8_LDA(At, 1, 0); PG8_STAGE(PG8_SA(0, 1), a2 + hstepA, voffA);
            PG8_WAIT_L(8); PG8_BAR; PG8_WAIT_L(0); PG8_MMA(0, 0, At, B0); PG8_BAR; PG8_SCHED;
            PG8_LDB(B1, 1, 1); PG8_STAGE(PG8_SB(1, 0), b3, voffB);
            PG8_BAR; PG8_WAIT_L(0); PG8_MMA(0, 1, At, B1); PG8_BAR;
            PG8_LDA(At, 1, 1); PG8_STAGE(PG8_SA(1, 0), a3, voffA);
            PG8_BAR; PG8_WAIT_L(0); PG8_MMA(1, 0, At, B0); PG8_BAR; PG8_SCHED;
            PG8_STAGE(PG8_SB(1, 1), b3 + hstepB, voffB);
            PG8_WAIT_V(6); PG8_BAR; PG8_MMA(1, 1, At, B1); PG8_BAR;
            }
        }
        if constexpr (ALIGN_EPI) { if (wr == 0) PG8_BAR; }
        E(acc, cur, wr, wc, fr, fq); S.done(cur);
        if (!has_next) break;
#pragma unroll
        for (int a = 0; a < 2; ++a)
#pragma unroll
            for (int b = 0; b < 2; ++b)
#pragma unroll
                for (int m = 0; m < 4; ++m)
#pragma unroll
                    for (int n = 0; n < 2; ++n) acc[a][b][m][n] = (acc_t){0, 0, 0, 0};
        cur = nxt; cA = nA; cB = nB; ++ui;
        if constexpr (ALIGN_EPI) { if (wr == 1) PG8_BAR; }
    }
    PG8_WAIT_V(0);
    if constexpr (!ALIGN_EPI) { if (wr == 0) PG8_BAR; }
    PG8_BAR;
#undef PG8_SA
#undef PG8_SB
#undef PG8_STAGE
#undef PG8_LDA
#undef PG8_LDB
#undef PG8_MMA
#undef PG8_WAIT_V
#undef PG8_WAIT_L
#undef PG8_BAR
#undef PG8_SCHED
}
}

constexpr int NWAVES = 8;
constexpr int S = 16384, DM = 4096, DEPTH = 2;
constexpr int PP = 6656;
constexpr int NP = 19200;
constexpr int IN_COLS = 19008;
constexpr int NB = 2048;
constexpr int NG = 17152;
__host__ __device__ constexpr int bf_tile_col(int t) { return t < 2 ? 4096 + 256 * t : 5120 + 256 * (t - 2); }
constexpr int C_QA = 0, C_KA = 1024, C_VA = 1280, C_ZA = 1536, C_CQ = 2560, C_CKV = 3584, C_ZB = 4096, C_QC = 4608, C_KC = 5120, C_VC = 5632, C_ZC = 6144,
              C_GA = 6656, C_GB = 10752, C_GC = 14848, C_KR = 18944;
constexpr float EPS = 1e-6f;
constexpr float LOG2E = 1.4426950408889634f;
constexpr float SC128 = 0.08838834764831845f * LOG2E;
constexpr float SC192 = 0.07216878364870322f * LOG2E;
constexpr int YW = 2048;

constexpr size_t MiB = 1u << 20;
constexpr size_t WS_CTL = 0, CTL_ZERO_BYTES = 1 * MiB;
constexpr size_t WS_RS = 1 * MiB;
constexpr size_t WS_RSQ = WS_RS + 65536, WS_RSKV = WS_RSQ + 65536;
constexpr size_t WS_ROPEC = 2 * MiB, WS_ROPES = 4 * MiB;
constexpr size_t WS_WQ = 6 * MiB;
constexpr size_t WS_WKV = 10 * MiB;
constexpr size_t WS_WPROJ = 16 * MiB;
constexpr size_t WS_WOUT = 48 * MiB;
constexpr size_t WS_WIN = 112 * MiB;
constexpr size_t WS_WG8 = 210 * MiB;
constexpr size_t WS_XQ = 344 * MiB;
constexpr size_t WS_SA = WS_RS + 3 * 65536;
constexpr size_t WS_SB = WS_RS + 4 * 65536;
constexpr size_t WS_XB = 416 * MiB;
constexpr size_t WS_P = 544 * MiB;
constexpr size_t WS_GT = 752 * MiB;
constexpr size_t WS_QM = 1144 * MiB;
constexpr size_t WS_KVM = 1168 * MiB;
constexpr size_t WS_KRM = 1200 * MiB;
constexpr size_t WS_Y = 1204 * MiB;
constexpr size_t WS_MBF = 1524 * MiB;
constexpr size_t WS_X1 = 1652 * MiB;
constexpr size_t WS_OPART = 1908 * MiB;
constexpr size_t WS_ML = 2036 * MiB;
constexpr size_t WS_END = 2040 * MiB;
static_assert(WS_WIN + (size_t)2 * NB * DM * 2 <= WS_WG8 && WS_WG8 + (size_t)2 * NG * DM <= WS_XQ && WS_XQ + (size_t)S * DM <= WS_XB && WS_P + (size_t)S * PP * 2 <= WS_GT && WS_GT + (size_t)3 * S * DM * 2 <= WS_QM && WS_SB + 2 * NG * 4 <= WS_ROPEC, "ws map");
constexpr int CW_TMO = 0, CW_CODE = 1;
constexpr int CW_BAR = 4096;
constexpr int CW_MLACNT = 20480;
constexpr int CW_QUEUE = 16384;
constexpr size_t CTL_COLMAX = 640 * 1024;
constexpr size_t CTL_BLUT = 904 * 1024;
constexpr size_t CTL_ROWMAX = 776 * 1024;
constexpr size_t CTL_SSQ_Q = 256 * 1024, CTL_SSQ_KV = 384 * 1024, CTL_SSQ_X = 512 * 1024;

constexpr int RING_OFF = 0, RING_BYTES = 131072;
constexpr int LDSCTL_OFF = RING_BYTES, MISC_OFF = LDSCTL_OFF + 320;
constexpr int LDS_BYTES = 147456;

#define GAS __attribute__((address_space(1)))
#define LAS __attribute__((address_space(3)))
typedef unsigned short bf16;
typedef unsigned v4u __attribute__((ext_vector_type(4)));
typedef unsigned v2u __attribute__((ext_vector_type(2)));
typedef float f32x4 __attribute__((ext_vector_type(4)));
typedef float f32x2 __attribute__((ext_vector_type(2)));
typedef short bf16x8 __attribute__((ext_vector_type(8)));
typedef GAS unsigned gu32;
#define RLX_AGENT __ATOMIC_RELAXED, __HIP_MEMORY_SCOPE_AGENT
#define LDS_WAIT() asm volatile("s_waitcnt lgkmcnt(0)" ::: "memory")
#define VM_WAIT() asm volatile("s_waitcnt vmcnt(0)" ::: "memory")
__device__ __forceinline__ unsigned f2bf(float f) { unsigned u = __builtin_bit_cast(unsigned, f); return (u + 0x7fffu + ((u >> 16) & 1u)) >> 16; }
__device__ __forceinline__ unsigned pk2(float lo, float hi) { return f2bf(lo) | (f2bf(hi) << 16); }
__device__ __forceinline__ float bf2f(unsigned short b) { return __uint_as_float(((unsigned)b) << 16); }

#define XB_TMO      128
#define XB_XCNT(j)  (256  + 64 * (j))
#define XB_XSUB(j)  (1280 + 64 * (j))
#define XB_XGEN(j)  (2304 + 64 * (j))
#define XB_TOP      3328
#define XB_TOPGEN   3392
#define XCD_BAR_WORDS 3456
#define XB_SPIN_CAP (1u << 18)
__device__ __forceinline__ unsigned xb_ld(unsigned* p)              { return __hip_atomic_load(p, __ATOMIC_RELAXED, __HIP_MEMORY_SCOPE_AGENT); }
__device__ __forceinline__ unsigned xb_add(unsigned* p, unsigned v) { return __hip_atomic_fetch_add(p, v, __ATOMIC_RELAXED, __HIP_MEMORY_SCOPE_AGENT); }
__device__ __forceinline__ unsigned xb_xcc_id() { return (unsigned)__builtin_amdgcn_s_getreg((3 << 11) | 20) & 0xFu; }
#define XB_SPIN(cond, bar) do { unsigned _sp = 0; while (cond) { __builtin_amdgcn_s_sleep(1); \
    if ((++_sp & 255u) == 0u) { if (xb_ld(&(bar)[XB_TMO])) break; if (_sp > XB_SPIN_CAP) { atomicAdd(&(bar)[XB_TMO], 1u); break; } } } } while (0)
struct XcdBarrier { unsigned* bar; unsigned x; volatile LAS unsigned* st; };
__device__ __forceinline__ XcdBarrier xcd_barrier_post(unsigned* bar, volatile LAS unsigned* st) {
    XcdBarrier b; b.bar = bar; b.x = xb_xcc_id(); b.st = st;
    if (threadIdx.x == 0) (void)xb_add(&bar[XB_XCNT(b.x)], 1u);
    return b;
}
__device__ __forceinline__ void xcd_barrier_complete(unsigned* bar, unsigned x, unsigned& nloc, unsigned& nx) {
    const unsigned G = gridDim.x * gridDim.y * gridDim.z;
    unsigned sum, cnt, mine, sp = 0u;
    for (;;) {
        sum = 0u; cnt = 0u; mine = 0u;
#pragma unroll
        for (unsigned j = 0; j < 16; ++j) { const unsigned c = xb_ld(&bar[XB_XCNT(j)]); sum += c; cnt += (c > 0u) ? 1u : 0u; mine = (j == x) ? c : mine; }
        if (sum == G) break;
        __builtin_amdgcn_s_sleep(1);
        if ((++sp & 255u) == 0u) { if (xb_ld(&bar[XB_TMO])) break; if (sp > XB_SPIN_CAP) { atomicAdd(&bar[XB_TMO], 1u); break; } }
    }
    nloc = mine > 0u ? mine : 1u; nx = cnt > 0u ? cnt : 1u;
}
__device__ __forceinline__ void xcd_barrier(const XcdBarrier& b) {
    asm volatile("s_waitcnt vmcnt(0)" ::: "memory");
    __syncthreads();
    if (threadIdx.x == 0) {
        unsigned* bar = b.bar;
        __builtin_amdgcn_s_waitcnt(0);
        unsigned nloc = b.st[0], nx = b.st[1];
        if (nloc == 0u) { xcd_barrier_complete(bar, b.x, nloc, nx); b.st[0] = nloc; b.st[1] = nx; }
        const unsigned old = xb_add(&bar[XB_XSUB(b.x)], 1u);
        const unsigned gen = old / nloc;
        if (old + 1u == (gen + 1u) * nloc) {
            __builtin_amdgcn_fence(__ATOMIC_RELEASE, "agent");
            asm volatile("s_waitcnt vmcnt(0)" ::: "memory");
            const unsigned og = xb_add(&bar[XB_TOP], 1u);
            const unsigned tg = og / nx;
            if (og + 1u == (tg + 1u) * nx) xb_add(&bar[XB_TOPGEN], 1u);
            else XB_SPIN(xb_ld(&bar[XB_TOPGEN]) == tg, bar);
            __builtin_amdgcn_fence(__ATOMIC_ACQUIRE, "agent");
            xb_add(&bar[XB_XGEN(b.x)], 1u);
            asm volatile("s_waitcnt vmcnt(0)" ::: "memory");
        } else {
            XB_SPIN(xb_ld(&bar[XB_XGEN(b.x)]) == gen, bar);
            __builtin_amdgcn_fence(__ATOMIC_ACQUIRE, "agent");
            asm volatile("s_waitcnt vmcnt(0)" ::: "memory");
        }
    }
    __syncthreads();
}

struct Args {
    const float* x; const float* norm_g; const float* w_in; const float* sinks; const float* rel_bias; const float* g_q; const float* w_q_up; const float* g_kv; const float* w_kv_up;
    const float* w_pa; const float* w_pb; const float* w_pc; const float* w_out; const float* final_g;
    float* out; unsigned char* ws; int ph_lo, ph_hi;
};
struct Frame {
    LAS unsigned char* lds;
    gu32* ctl;
    int tid, lane, wave, G, gw, NGW;
    bf16 *Win, *Wout, *Wproj, *Wq, *Wkv, *XB, *P, *QM, *KVM, *KRM, *Y, *MBF; unsigned char* GT; signed char *WG8, *XQ; float *SA, *SB; unsigned* COLMAX;
    float *RS, *RSQ, *RSKV, *ROPEC, *ROPES, *X1, *OPART, *ML, *SSQ_Q, *SSQ_KV, *SSQ_X, *BLUT; unsigned* ROWMAX;
};
__device__ __forceinline__ void set_ptrs(Frame& F, unsigned char* ws_) {
    GAS unsigned char* wsg = (GAS unsigned char*)ws_; asm volatile("" : "+s"(wsg)); unsigned char* ws = (unsigned char*)wsg;
    { int t = threadIdx.x; asm volatile("" : "+v"(t)); F.tid = t; F.lane = t & 63; F.wave = __builtin_amdgcn_readfirstlane(t >> 6); F.gw = blockIdx.x * NWAVES + F.wave; }
    F.ctl = (gu32*)(ws + WS_CTL);
    F.Win = (bf16*)(ws + WS_WIN); F.Wout = (bf16*)(ws + WS_WOUT); F.Wproj = (bf16*)(ws + WS_WPROJ); F.Wq = (bf16*)(ws + WS_WQ); F.Wkv = (bf16*)(ws + WS_WKV);
    F.XB = (bf16*)(ws + WS_XB); F.P = (bf16*)(ws + WS_P); F.QM = (bf16*)(ws + WS_QM); F.KVM = (bf16*)(ws + WS_KVM); F.KRM = (bf16*)(ws + WS_KRM); F.Y = (bf16*)(ws + WS_Y); F.MBF = (bf16*)(ws + WS_MBF); F.GT = ws + WS_GT;
    F.RS = (float*)(ws + WS_RS); F.RSQ = (float*)(ws + WS_RSQ); F.RSKV = (float*)(ws + WS_RSKV); F.ROPEC = (float*)(ws + WS_ROPEC); F.ROPES = (float*)(ws + WS_ROPES);
    F.X1 = (float*)(ws + WS_X1); F.OPART = (float*)(ws + WS_OPART); F.ML = (float*)(ws + WS_ML);
    F.WG8 = (signed char*)(ws + WS_WG8); F.XQ = (signed char*)(ws + WS_XQ); F.SA = (float*)(ws + WS_SA); F.SB = (float*)(ws + WS_SB); F.COLMAX = (unsigned*)(ws + WS_CTL + CTL_COLMAX);
    F.SSQ_Q = (float*)(ws + WS_CTL + CTL_SSQ_Q); F.SSQ_KV = (float*)(ws + WS_CTL + CTL_SSQ_KV); F.SSQ_X = (float*)(ws + WS_CTL + CTL_SSQ_X); F.ROWMAX = (unsigned*)(ws + WS_CTL + CTL_ROWMAX); F.BLUT = (float*)(ws + WS_CTL + CTL_BLUT);
}
__device__ __forceinline__ float wave_sum(float v) {
#pragma unroll
    for (int o = 1; o < 64; o <<= 1) v += __shfl_xor(v, o);
    return v;
}
__device__ __forceinline__ float wave_max(float v) {
#pragma unroll
    for (int o = 1; o < 64; o <<= 1) v = fmaxf(v, __shfl_xor(v, o));
    return v;
}

__device__ const unsigned char T5B[128] = {0, 1, 2, 3, 4, 5, 6, 7, 8, 9, 10, 11, 12, 13, 14, 15, 16, 16, 16, 17, 17, 18, 18, 18, 19, 19, 19, 20, 20, 20, 20, 21, 21, 21, 21, 22, 22, 22, 22, 22, 23, 23, 23, 23, 23, 23, 24, 24, 24, 24, 24, 24, 25, 25, 25, 25, 25, 25, 25, 26, 26, 26, 26, 26, 26, 26, 26, 27, 27, 27, 27, 27, 27, 27, 27, 27, 27, 28, 28, 28, 28, 28, 28, 28, 28, 28, 28, 29, 29, 29, 29, 29, 29, 29, 29, 29, 29, 29, 29, 30, 30, 30, 30, 30, 30, 30, 30, 30, 30, 30, 30, 30, 30, 31, 31, 31, 31, 31, 31, 31, 31, 31, 31, 31, 31, 31, 31, 31};

__device__ const float ROPE_INV[32] = {1.000000000e+00f, 7.498942614e-01f, 5.623413324e-01f, 4.216965139e-01f, 3.162277639e-01f, 2.371373773e-01f, 1.778279394e-01f, 1.333521307e-01f, 1.000000015e-01f, 7.498941571e-02f, 5.623413250e-02f, 4.216965288e-02f, 3.162277490e-02f, 2.371373773e-02f, 1.778279431e-02f, 1.333521493e-02f, 9.999999776e-03f, 7.498941850e-03f, 5.623413250e-03f, 4.216964822e-03f, 3.162277630e-03f, 2.371373586e-03f, 1.778279431e-03f, 1.333521446e-03f, 1.000000047e-03f, 7.498942432e-04f, 5.623413017e-04f, 4.216965172e-04f, 3.162277571e-04f, 2.371373703e-04f, 1.778279402e-04f, 1.333521504e-04f};
template <int MAP> __device__ __forceinline__ int src_col(int n) {
    if (MAP == 1) { const int pc = bf_tile_col(n >> 8) + (n & 255); return pc < 4096 ? pc : pc + 64; }
    if (MAP == 3) {
        if (n < 12288) return 6720 + n; if (n < 13312) return n - 12288; if (n < 14336) return 2560 + (n - 13312); if (n < 14592) return 1024 + (n - 14336); if (n < 15104) return 4672 + (n - 14592);
        if (n >= 16640) return 3584 + (n - 16640);
        if (n >= 16384) return 1280 + (n - 16384);
        if (n >= 15360) return 1536 + (n - 15360);
        const int r = n - 15104; return r < 64 ? 4096 + ((r & 1) ? 32 + (r >> 1) : (r >> 1)) : -1; }
    if (MAP == 2) { const int h = n / 192, c = n % 192; if (c < 128) return n; const int j = c - 128; return h * 192 + 128 + ((j & 1) ? 32 + (j >> 1) : (j >> 1)); }
    return n;
}
template <int MAP>
__device__ __forceinline__ void conv_item(const float* W, int Nsrc, const float* g, bf16* WT, int ldd, int dk0, int nblk, LAS float* scr, int item, int lane) {
    const int kb = item / nblk, nb = item % nblk, k0 = 64 * kb, n0 = 32 * nb;
    const int sc = src_col<MAP>(n0 + (lane & 31));
    const GAS float* wp = (const GAS float*)W + (size_t)(k0 + (lane >> 5)) * Nsrc + (sc >= 0 ? sc : 0);
    float v[32];
#pragma unroll
    for (int i = 0; i < 32; ++i) v[i] = __builtin_nontemporal_load(wp + (size_t)(2 * i) * Nsrc);
    const int c = lane & 7;
    f32x4 g0 = {1.f, 1.f, 1.f, 1.f}, g1 = {1.f, 1.f, 1.f, 1.f};
    if (g) { g0 = *(const GAS f32x4*)(g + k0 + 8 * c); g1 = *(const GAS f32x4*)(g + k0 + 8 * c + 4); }
#pragma unroll
    for (int i = 0; i < 32; ++i) scr[(2 * i + (lane >> 5)) * 33 + (lane & 31)] = (sc >= 0) ? v[i] : 0.f;
    LDS_WAIT(); asm volatile("" ::: "memory");
#pragma unroll
    for (int j = 0; j < 4; ++j) { const int n = (lane >> 3) + 8 * j; const LAS float* s = scr + (8 * c) * 33 + n;
        v4u o; o.x = pk2(s[0 * 33] * g0[0], s[1 * 33] * g0[1]); o.y = pk2(s[2 * 33] * g0[2], s[3 * 33] * g0[3]); o.z = pk2(s[4 * 33] * g1[0], s[5 * 33] * g1[1]); o.w = pk2(s[6 * 33] * g1[2], s[7 * 33] * g1[3]);
        *(GAS v4u*)(WT + (size_t)(n0 + n) * ldd + dk0 + k0 + 8 * c) = o; }
    LDS_WAIT(); asm volatile("" ::: "memory");
}
__device__ __forceinline__ void gate_max_item(const float* W, const float* g, unsigned* colmax, int item, int lane) {
    const int kb = item / (NG / 32), nb = item % (NG / 32), k0 = 64 * kb, n0 = 32 * nb;
    const int sc = src_col<3>(n0 + (lane & 31));
    const GAS float* wp = (const GAS float*)W + (size_t)(k0 + (lane >> 5)) * IN_COLS + (sc >= 0 ? sc : 0);
    float v[32];
#pragma unroll
    for (int i = 0; i < 32; ++i) v[i] = __builtin_nontemporal_load(wp + (size_t)(2 * i) * IN_COLS);
    if (sc < 0) {
#pragma unroll
        for (int i = 0; i < 32; ++i) v[i] = 0.f; }
    float m = 0.f;
#pragma unroll
    for (int i = 0; i < 32; ++i) m = fmaxf(m, fabsf(v[i] * g[k0 + 2 * i + (lane >> 5)]));
    m = fmaxf(m, __shfl_xor(m, 32));
    if (lane < 32) atomicMax(colmax + n0 + lane, __float_as_uint(m));
}
__device__ __forceinline__ void gate_quant_item(const float* W, const float* g, const unsigned* colmax, signed char* WQ, float* sb, LAS float* scr, int item, int lane) {
    const int kb = item / (NG / 32), nb = item % (NG / 32), k0 = 64 * kb, n0 = 32 * nb;
    const int sc = src_col<3>(n0 + (lane & 31));
    const GAS float* wp = (const GAS float*)W + (size_t)(k0 + (lane >> 5)) * IN_COLS + (sc >= 0 ? sc : 0);
    float v[32];
#pragma unroll
    for (int i = 0; i < 32; ++i) v[i] = __builtin_nontemporal_load(wp + (size_t)(2 * i) * IN_COLS);
    if (sc < 0) {
#pragma unroll
        for (int i = 0; i < 32; ++i) v[i] = 0.f; }
    const float cm = __uint_as_float(colmax[n0 + (lane & 31)]); const float inv = cm > 0.f ? 127.0f / cm : 0.f;
    if (kb == 0 && lane < 32) sb[n0 + lane] = cm * (1.0f / 127.0f);
#pragma unroll
    for (int i = 0; i < 32; ++i) { const int kk = 2 * i + (lane >> 5); float q = __builtin_rintf(v[i] * g[k0 + kk] * inv); q = fminf(fmaxf(q, -127.f), 127.f); scr[kk * 33 + (lane & 31)] = q; }
    LDS_WAIT(); asm volatile("" ::: "memory");
    const int n = lane >> 1, hf = lane & 1;
    unsigned w[8];
#pragma unroll
    for (int d = 0; d < 8; ++d) { unsigned x = 0;
#pragma unroll
        for (int b = 0; b < 4; ++b) x |= ((unsigned)(int)scr[(32 * hf + 4 * d + b) * 33 + n] & 0xffu) << (8 * b);
        w[d] = x; }
    GAS v4u* dst = (GAS v4u*)(WQ + (size_t)(n0 + n) * DM + k0 + 32 * hf);
    dst[0] = (v4u){w[0], w[1], w[2], w[3]}; dst[1] = (v4u){w[4], w[5], w[6], w[7]};
    LDS_WAIT(); asm volatile("" ::: "memory");
}
__device__ __forceinline__ void sincos_d(double a, float& sn, float& cs) {
    const double q = __builtin_rint(a * 0.63661977236758134308);
    double r = __builtin_fma(-q, 1.57079632679489655800e+00, a); r = __builtin_fma(-q, 6.12323399573676603587e-17, r);
    const double r2 = r * r;
    double ps = r2 * (1.0 / 6227020800.0) - (1.0 / 39916800.0); ps = ps * r2 + (1.0 / 362880.0); ps = ps * r2 - (1.0 / 5040.0); ps = ps * r2 + (1.0 / 120.0); ps = ps * r2 - (1.0 / 6.0); ps = ps * r2 * r + r;
    double pc = r2 * (1.0 / 87178291200.0) - (1.0 / 479001600.0); pc = pc * r2 + (1.0 / 3628800.0); pc = pc * r2 - (1.0 / 40320.0); pc = pc * r2 + (1.0 / 720.0); pc = pc * r2 - (1.0 / 24.0); pc = pc * r2 + 0.5; pc = 1.0 - pc * r2;
    const int qi = ((int)q) & 3;
    const double s_ = (qi == 0) ? ps : (qi == 1) ? pc : (qi == 2) ? -ps : -pc;
    const double c_ = (qi == 0) ? pc : (qi == 1) ? -ps : (qi == 2) ? -pc : ps;
    sn = (float)s_; cs = (float)c_;
}
__device__ __forceinline__ void p0_prologue(Frame& F, const Args& A) {
    LAS float* scr = (LAS float*)(F.lds + RING_OFF + F.wave * 16384);
    constexpr int I_GM = 64 * (NG / 32), I_IN = 64 * (NB / 32), I_Q = 16 * (768 / 32), I_KV = 8 * (1024 / 32), I_PA = 16 * 128, I_PB = 8 * 128, I_PC = 8 * 128, I_O = 64 * 128;
    constexpr int PER_L = I_GM + I_IN + I_Q + I_KV + I_PA + I_PB + I_PC + I_O;
    for (int it = F.gw; it < DEPTH * PER_L; it += F.NGW) {
        const int l = it / PER_L; int r = it % PER_L;
        if (r < I_GM) { gate_max_item(A.w_in + (size_t)l * DM * IN_COLS, A.norm_g + l * DM, F.COLMAX + l * NG, r, F.lane); continue; } r -= I_GM;
        if (r < I_IN) { conv_item<1>(A.w_in + (size_t)l * DM * IN_COLS, IN_COLS, A.norm_g + l * DM, F.Win + (size_t)l * NB * DM, DM, 0, NB / 32, scr, r, F.lane); continue; } r -= I_IN;
        if (r < I_Q) { conv_item<2>(A.w_q_up + (size_t)l * 1024 * 768, 768, A.g_q + l * 1024, F.Wq + (size_t)l * 768 * 1024, 1024, 0, 768 / 32, scr, r, F.lane); continue; } r -= I_Q;
        if (r < I_KV) { conv_item<0>(A.w_kv_up + (size_t)l * 512 * 1024, 1024, A.g_kv + l * 512, F.Wkv + (size_t)l * 1024 * 512, 512, 0, 1024 / 32, scr, r, F.lane); continue; } r -= I_KV;
        if (r < I_PA) { conv_item<0>(A.w_pa + (size_t)l * 1024 * DM, DM, nullptr, F.Wproj + (size_t)l * DM * YW, YW, 0, 128, scr, r, F.lane); continue; } r -= I_PA;
        if (r < I_PB) { conv_item<0>(A.w_pb + (size_t)l * 512 * DM, DM, nullptr, F.Wproj + (size_t)l * DM * YW, YW, 1024, 128, scr, r, F.lane); continue; } r -= I_PB;
        if (r < I_PC) { conv_item<0>(A.w_pc + (size_t)l * 512 * DM, DM, nullptr, F.Wproj + (size_t)l * DM * YW, YW, 1536, 128, scr, r, F.lane); continue; } r -= I_PC;
        conv_item<0>(A.w_out + (size_t)l * DM * DM, DM, nullptr, F.Wout + (size_t)l * DM * DM, DM, 0, 128, scr, r, F.lane);
    }
    if (blockIdx.x == 0) { for (int i = threadIdx.x; i < 8 * 128; i += NWAVES * 64) F.BLUT[i] = A.rel_bias[(int)T5B[i & 127] * 8 + (i >> 7)] * LOG2E; }
    for (int i = F.gw * 64 + F.lane; i < S * 32; i += F.NGW * 64) {
        const int pos = i >> 5, j = i & 31;
        const float inv = ROPE_INV[j];
        const float ang = (float)pos * inv;
        float sn, cs; sincos_d((double)ang, sn, cs);
        F.ROPEC[i] = cs; F.ROPES[i] = sn;
    }
}
__device__ __forceinline__ void p0b_gate_quant(Frame& F, const Args& A) {
    LAS float* scr = (LAS float*)(F.lds + RING_OFF + F.wave * 16384);
    constexpr int I_GM = 64 * (NG / 32);
    for (int it = F.gw; it < DEPTH * I_GM; it += F.NGW) { const int l = it / I_GM, r = it % I_GM;
        gate_quant_item(A.w_in + (size_t)l * DM * IN_COLS, A.norm_g + l * DM, F.COLMAX + l * NG, F.WG8 + (size_t)l * NG * DM, F.SB + l * NG, scr, r, F.lane); }
}
template <int MODE>
__device__ __forceinline__ void prep_rows(Frame& F, const float* X, bf16* XBo, float* RSo, float* OUT, const float* gfin, signed char* XQo = nullptr, float* SAo = nullptr) {
    for (int m = F.gw; m < S; m += F.NGW) {
        const GAS f32x4* xr = (const GAS f32x4*)(X + (size_t)m * DM) + F.lane;
        f32x4 v[16]; float s = 0.f;
#pragma unroll
        for (int j = 0; j < 16; ++j) { v[j] = __builtin_nontemporal_load(xr + 64 * j); s += (v[j].x * v[j].x + v[j].y * v[j].y) + (v[j].z * v[j].z + v[j].w * v[j].w); }
        float mx = 0.f;
        if (MODE == 0) {
#pragma unroll
            for (int j = 0; j < 16; ++j) mx = fmaxf(fmaxf(mx, fmaxf(fabsf(v[j].x), fabsf(v[j].y))), fmaxf(fabsf(v[j].z), fabsf(v[j].w)));
            mx = wave_max(mx); }
        const float ssum = wave_sum(s); const float rs = 1.0f / sqrtf(ssum * (1.0f / DM) + EPS);
        if (MODE == 0) {
            if (F.lane == 0) RSo[m] = ssum;
            GAS v2u* o8 = (GAS v2u*)(XBo + (size_t)m * DM) + F.lane;
#pragma unroll
            for (int j = 0; j < 16; ++j) { v2u w; w.x = pk2(v[j].x, v[j].y); w.y = pk2(v[j].z, v[j].w); o8[64 * j] = w; }
            if (F.lane == 0) SAo[m] = mx * (1.0f / 127.0f);
            const float inv = mx > 0.f ? 127.0f / mx : 0.f;
            GAS unsigned* q4 = (GAS unsigned*)(XQo + (size_t)m * DM) + F.lane;
#pragma unroll
            for (int j = 0; j < 16; ++j) { const int a = (int)__builtin_rintf(v[j].x * inv), b = (int)__builtin_rintf(v[j].y * inv), c = (int)__builtin_rintf(v[j].z * inv), d = (int)__builtin_rintf(v[j].w * inv);
                q4[64 * j] = ((unsigned)a & 0xffu) | (((unsigned)b & 0xffu) << 8) | (((unsigned)c & 0xffu) << 16) | (((unsigned)d & 0xffu) << 24); }
        } else {
            GAS f32x4* o = (GAS f32x4*)(OUT + (size_t)m * DM) + F.lane; const GAS f32x4* gg = (const GAS f32x4*)gfin + F.lane;
#pragma unroll
            for (int j = 0; j < 16; ++j) { const f32x4 gv = gg[64 * j]; o[64 * j] = v[j] * rs * gv; }
        }
    }
}

__device__ __forceinline__ void prep_q8(Frame& F, const bf16* XBi, const float* ssx, const unsigned* rmx, float* RSo, float* SAo, signed char* XQo) {
    for (int m = F.gw; m < S; m += F.NGW) {
        const GAS v4u* xr = (const GAS v4u*)(XBi + (size_t)m * DM) + F.lane;
        v4u v[8];
#pragma unroll
        for (int j = 0; j < 8; ++j) v[j] = xr[64 * j];
        const float mx = __uint_as_float(rmx[m]), inv = mx > 0.f ? 127.0f / mx : 0.f;
        if (F.lane == 0) { RSo[m] = ssx[m]; SAo[m] = mx * (1.0f / 127.0f); }
        GAS v2u* q8 = (GAS v2u*)(XQo + (size_t)m * DM) + F.lane;
#pragma unroll
        for (int j = 0; j < 8; ++j) { unsigned o2[2];
#pragma unroll
            for (int h = 0; h < 2; ++h) { const unsigned w0 = h ? v[j].z : v[j].x, w1 = h ? v[j].w : v[j].y;
                const int a = (int)__builtin_rintf(pg8::bf_lo(w0) * inv), b = (int)__builtin_rintf(pg8::bf_hi(w0) * inv), c = (int)__builtin_rintf(pg8::bf_lo(w1) * inv), d = (int)__builtin_rintf(pg8::bf_hi(w1) * inv);
                o2[h] = ((unsigned)a & 0xffu) | (((unsigned)b & 0xffu) << 8) | (((unsigned)c & 0xffu) << 16) | (((unsigned)d & 0xffu) << 24); }
            v2u w; w.x = o2[0]; w.y = o2[1]; q8[64 * j] = w; }
    }
}

__device__ __forceinline__ void final_norm(Frame& F, const bf16* XBi, const float* ssx, float* OUT, const float* gfin) {
    f32x4 gk[8][2];
    { const GAS f32x4* gg = (const GAS f32x4*)gfin + 2 * F.lane;
#pragma unroll
      for (int j = 0; j < 8; ++j) { gk[j][0] = gg[128 * j]; gk[j][1] = gg[128 * j + 1]; } }
    for (int m = F.gw; m < S; m += F.NGW) {
        const GAS v4u* xr = (const GAS v4u*)(XBi + (size_t)m * DM) + F.lane;
        v4u v[8];
#pragma unroll
        for (int j = 0; j < 8; ++j) v[j] = xr[64 * j];
        const float rs = 1.0f / sqrtf(ssx[m] * (1.0f / DM) + EPS);
        GAS f32x4* o = (GAS f32x4*)(OUT + (size_t)m * DM) + 2 * F.lane;
#pragma unroll
        for (int j = 0; j < 8; ++j) { const f32x4 g0 = gk[j][0], g1 = gk[j][1];
            f32x4 a = {pg8::bf_lo(v[j].x), pg8::bf_hi(v[j].x), pg8::bf_lo(v[j].y), pg8::bf_hi(v[j].y)}, b = {pg8::bf_lo(v[j].z), pg8::bf_hi(v[j].z), pg8::bf_lo(v[j].w), pg8::bf_hi(v[j].w)};
            o[128 * j] = a * rs * g0; o[128 * j + 1] = b * rs * g1; }
    }
}

using pg8::f32x4; using pg8::Unit;
__device__ __forceinline__ float fast_sigmoid(float v) { return __builtin_amdgcn_rcpf(1.0f + __builtin_amdgcn_exp2f(-v * LOG2E)); }
__device__ __forceinline__ void atomic_addf(float* p, float v) { unsafeAtomicAdd(p, v); }
struct EpiInProj {
    static constexpr bool PERM = true, AFTER_DRAIN = false, MID = false; typedef pg8::f32x4 acc_t;
    bf16* P; const float* rs; bf16* KRM; const float* ropeC; const float* ropeS; float* ssq_q; float* ssq_kv; bool stats;
    __device__ __forceinline__ void operator()(const f32x4 (&acc)[2][2][4][2], const Unit& u, int wr, int wc, int fr, int fq) const {
        const int pn = u.pn;
        const int pcb = bf_tile_col(u.pn), po = pcb >> 8;
        const int ty = po < 4 ? 1 : po < 6 ? 0 : po < 10 ? 2 : po < 16 ? 0 : po < 18 ? 2 : po < 20 ? 1 : po < 24 ? 0 : 2;
        const int row0 = u.pm * 256 + wr * 64 + fr, col0 = pcb + wc * 32 + 8 * fq;
        float srow[2][4];
#pragma unroll
        for (int ai = 0; ai < 2; ++ai)
#pragma unroll
            for (int m = 0; m < 4; ++m) srow[ai][m] = rs[row0 + ai * 128 + m * 16];
#pragma unroll
        for (int ai = 0; ai < 2; ++ai)
#pragma unroll
            for (int m = 0; m < 4; ++m) srow[ai][m] = 1.0f / sqrtf(srow[ai][m] * (1.0f / DM) + EPS);
#pragma unroll
        for (int ai = 0; ai < 2; ++ai)
#pragma unroll
            for (int m = 0; m < 4; ++m) {
                const int row = row0 + ai * 128 + m * 16; const float s = srow[ai][m];
                bf16* rowp = P + (size_t)row * PP + col0; float ssl = 0.f;
#pragma unroll
                for (int bj = 0; bj < 2; ++bj) {
                    f32x4 v0 = acc[ai][bj][m][0] * s, v1 = acc[ai][bj][m][1] * s;
                    pg8::u32x4 w;
                    if (ty == 3) {
#pragma unroll
                        for (int j = 0; j < 4; ++j) { v0[j] = fast_sigmoid(v0[j]); v1[j] = fast_sigmoid(v1[j]); }
                        w.x = pg8::cvt_pk_f16(v0[0], v0[1]); w.y = pg8::cvt_pk_f16(v0[2], v0[3]); w.z = pg8::cvt_pk_f16(v1[0], v1[1]); w.w = pg8::cvt_pk_f16(v1[2], v1[3]);
                        *(pg8::u32x4*)(rowp + bj * 128) = w;
                    } else if (ty == 4) {
                        if (bj == 0 && wc < 2) {
                            const int j0 = wc * 16 + 4 * fq;
                            const f32x4 c = *(const f32x4*)(ropeC + (size_t)row * 32 + j0), sn = *(const f32x4*)(ropeS + (size_t)row * 32 + j0);
                            const float a0 = v0[0] * c[0] - v0[1] * sn[0], b0 = v0[1] * c[0] + v0[0] * sn[0];
                            const float a1 = v0[2] * c[1] - v0[3] * sn[1], b1 = v0[3] * c[1] + v0[2] * sn[1];
                            const float a2 = v1[0] * c[2] - v1[1] * sn[2], b2 = v1[1] * c[2] + v1[0] * sn[2];
                            const float a3 = v1[2] * c[3] - v1[3] * sn[3], b3 = v1[3] * c[3] + v1[2] * sn[3];
                            w.x = pg8::cvt_pk_bf16(a0, b0); w.y = pg8::cvt_pk_bf16(a1, b1); w.z = pg8::cvt_pk_bf16(a2, b2); w.w = pg8::cvt_pk_bf16(a3, b3);
                            *(pg8::u32x4*)(KRM + (size_t)row * 64 + wc * 32 + 8 * fq) = w;
                        }
                    } else {
                        if (po >= 10 && po < 16) ssl += (v0[0] * v0[0] + v0[1] * v0[1]) + (v0[2] * v0[2] + v0[3] * v0[3]) + (v1[0] * v1[0] + v1[1] * v1[1]) + (v1[2] * v1[2] + v1[3] * v1[3]);
                        if (ty == 1) { v0 = v0 * SC128; v1 = v1 * SC128; }
                        if (ty == 2) {
#pragma unroll
                            for (int j = 0; j < 4; ++j) { v0[j] = v0[j] * fast_sigmoid(v0[j]); v1[j] = v1[j] * fast_sigmoid(v1[j]); }
                        }
                        w.x = pg8::cvt_pk_bf16(v0[0], v0[1]); w.y = pg8::cvt_pk_bf16(v0[2], v0[3]); w.z = pg8::cvt_pk_bf16(v1[0], v1[1]); w.w = pg8::cvt_pk_bf16(v1[2], v1[3]);
                        *(pg8::u32x4*)(rowp + bj * 128) = w;
                    }
                }
                if (stats && po >= 10 && po < 16) { ssl += __shfl_xor(ssl, 16); ssl += __shfl_xor(ssl, 32); if (fq == 0) atomic_addf((po < 14 ? ssq_q : ssq_kv) + row, ssl); }
            }
    }
};
struct EpiGateI8 {
    static constexpr bool PERM = true, AFTER_DRAIN = false, MID = false; typedef pg8::i32x4 acc_t;
    bf16* P; const float* rs; const float* sa; const float* sb; float* ssq_q; bf16* KRM; const float* ropeC; const float* ropeS; unsigned char* GT; float* ssq_kv;
    __device__ __forceinline__ void operator()(const pg8::i32x4 (&acc)[2][2][4][2], const Unit& u, int wr, int wc, int fr, int fq) const {
        const int t = u.pn;
        const int ty = t < 48 ? 0 : t < 52 ? 1 : t < 56 ? 2 : t < 57 ? 3 : t < 59 ? 1 : t < 60 ? 4 : t < 64 ? 5 : t < 65 ? 3 : 6;
        const int row0 = u.pm * 256 + wr * 64 + fr, colw = wc * 32 + 8 * fq, col0 = t * 256 + colw;
        const int pcol = (t < 48 ? C_GA + t * 256 : t < 52 ? C_QA + (t - 48) * 256 : t < 56 ? C_CQ + (t - 52) * 256 : t < 57 ? C_KA : t < 59 ? C_QC + (t - 57) * 256 : t < 60 ? 0 : t < 64 ? C_ZA + (t - 60) * 256 : t < 65 ? C_VA : C_CKV + (t - 65) * 256) + colw;
        const float tsc = ty == 0 ? -LOG2E : ty == 1 ? SC128 : 1.0f;
        f32x4 cs[2][2];
#pragma unroll
        for (int bj = 0; bj < 2; ++bj) { cs[bj][0] = *(const f32x4*)(sb + col0 + bj * 128) * tsc; cs[bj][1] = *(const f32x4*)(sb + col0 + bj * 128 + 4) * tsc; }
        float srow[2][4], arow[2][4];
#pragma unroll
        for (int ai = 0; ai < 2; ++ai)
#pragma unroll
            for (int m = 0; m < 4; ++m) { srow[ai][m] = rs[row0 + ai * 128 + m * 16]; arow[ai][m] = sa[row0 + ai * 128 + m * 16]; }
#pragma unroll
        for (int ai = 0; ai < 2; ++ai)
#pragma unroll
            for (int m = 0; m < 4; ++m) srow[ai][m] = arow[ai][m] / sqrtf(srow[ai][m] * (1.0f / DM) + EPS);
#pragma unroll
        for (int ai = 0; ai < 2; ++ai)
#pragma unroll
            for (int m = 0; m < 4; ++m) {
                const int row = row0 + ai * 128 + m * 16; const float s = srow[ai][m];
                bf16* rowp = P + (size_t)row * PP + pcol; float ssl = 0.f;
#pragma unroll
                for (int bj = 0; bj < 2; ++bj) {
                    float v[8]; pg8::u32x4 w;
#pragma unroll
                    for (int j = 0; j < 8; ++j) v[j] = (float)acc[ai][bj][m][j >> 2][j & 3] * s * cs[bj][j >> 2][j & 3];
                    if (ty == 0) {
#pragma unroll
                        for (int j = 0; j < 8; ++j) v[j] = fminf(1.0f + __builtin_amdgcn_exp2f(v[j]), 65504.0f);
                        w.x = pg8::cvt_pk_f16(v[0], v[1]); w.y = pg8::cvt_pk_f16(v[2], v[3]); w.z = pg8::cvt_pk_f16(v[4], v[5]); w.w = pg8::cvt_pk_f16(v[6], v[7]);
                        *(GAS pg8::u32x4*)((GAS unsigned char*)GT + ((unsigned)(t * 64 + u.pm) * 131072u + (unsigned)((ai * 4 + m) * 2 + bj) * 8192u + (unsigned)(((wr * 4 + wc) * 64 + fq * 16 + fr) * 16))) = w;
                    } else if (ty == 4) {
                        if (bj == 0 && wc < 2) {
                            const int j0 = wc * 16 + 4 * fq;
                            const f32x4 c = *(const f32x4*)(ropeC + (size_t)row * 32 + j0), sn = *(const f32x4*)(ropeS + (size_t)row * 32 + j0);
                            w.x = pg8::cvt_pk_bf16(v[0] * c[0] - v[1] * sn[0], v[1] * c[0] + v[0] * sn[0]); w.y = pg8::cvt_pk_bf16(v[2] * c[1] - v[3] * sn[1], v[3] * c[1] + v[2] * sn[1]);
                            w.z = pg8::cvt_pk_bf16(v[4] * c[2] - v[5] * sn[2], v[5] * c[2] + v[4] * sn[2]); w.w = pg8::cvt_pk_bf16(v[6] * c[3] - v[7] * sn[3], v[7] * c[3] + v[6] * sn[3]);
                            *(pg8::u32x4*)(KRM + (size_t)row * 64 + wc * 32 + 8 * fq) = w;
                        }
                    } else {
                        if (ty == 5) {
#pragma unroll
                            for (int j = 0; j < 8; ++j) v[j] = v[j] * fast_sigmoid(v[j]); }
                        if (ty == 2 || ty == 6) ssl += (v[0] * v[0] + v[1] * v[1]) + (v[2] * v[2] + v[3] * v[3]) + (v[4] * v[4] + v[5] * v[5]) + (v[6] * v[6] + v[7] * v[7]);
                        w.x = pg8::cvt_pk_bf16(v[0], v[1]); w.y = pg8::cvt_pk_bf16(v[2], v[3]); w.z = pg8::cvt_pk_bf16(v[4], v[5]); w.w = pg8::cvt_pk_bf16(v[6], v[7]);
                        *(pg8::u32x4*)(rowp + bj * 128) = w;
                    }
                }
                if (ty == 2 || ty == 6) { ssl += __shfl_xor(ssl, 16); ssl += __shfl_xor(ssl, 32); if (fq == 0) atomic_addf((ty == 2 ? ssq_q : ssq_kv) + row, ssl); }
            }
    }
};
struct EpiQUp {
    static constexpr bool PERM = true, AFTER_DRAIN = false, MID = false; typedef pg8::f32x4 acc_t;
    bf16* QM; const float* rsq; const float* ropeC; const float* ropeS;
    __device__ __forceinline__ void operator()(const f32x4 (&acc)[2][2][4][2], const Unit& u, int wr, int wc, int fr, int fq) const {
        const int row0 = u.pm * 256 + wr * 64 + fr, col0 = u.pn * 256 + wc * 32 + 8 * fq;
        float srow[2][4];
#pragma unroll
        for (int ai = 0; ai < 2; ++ai)
#pragma unroll
            for (int m = 0; m < 4; ++m) srow[ai][m] = rsq[row0 + ai * 128 + m * 16];
        const int cb0 = (u.pn * 256 + wc * 32) % 192, cb1 = (u.pn * 256 + wc * 32 + 128) % 192;
        const int rbj = __builtin_amdgcn_readfirstlane(cb0 >= 128 ? 0 : cb1 >= 128 ? 1 : -1);
        f32x4 ccv[2][4], snv[2][4];
        if (rbj >= 0) { const int j0r = (((rbj ? cb1 : cb0) - 128) >> 1) + 4 * fq;
#pragma unroll
            for (int ai = 0; ai < 2; ++ai)
#pragma unroll
                for (int m = 0; m < 4; ++m) { const size_t ro = (size_t)(row0 + ai * 128 + m * 16) * 32 + j0r; ccv[ai][m] = *(const f32x4*)(ropeC + ro); snv[ai][m] = *(const f32x4*)(ropeS + ro); } }
#pragma unroll
        for (int ai = 0; ai < 2; ++ai)
#pragma unroll
            for (int m = 0; m < 4; ++m) {
                const int row = row0 + ai * 128 + m * 16; const float s = SC192 / sqrtf(srow[ai][m] * (1.0f / 1024.0f) + EPS);
#pragma unroll
                for (int bj = 0; bj < 2; ++bj) {
                    const int col = col0 + bj * 128, c = col % 192;
                    f32x4 v0 = acc[ai][bj][m][0] * s, v1 = acc[ai][bj][m][1] * s;
                    pg8::u32x4 w;
                    if (bj == rbj) {
                        const f32x4 cc = ccv[ai][m], sn = snv[ai][m];
                        const float a0 = v0[0] * cc[0] - v0[1] * sn[0], b0 = v0[1] * cc[0] + v0[0] * sn[0];
                        const float a1 = v0[2] * cc[1] - v0[3] * sn[1], b1 = v0[3] * cc[1] + v0[2] * sn[1];
                        const float a2 = v1[0] * cc[2] - v1[1] * sn[2], b2 = v1[1] * cc[2] + v1[0] * sn[2];
                        const float a3 = v1[2] * cc[3] - v1[3] * sn[3], b3 = v1[3] * cc[3] + v1[2] * sn[3];
                        w.x = pg8::cvt_pk_bf16(a0, b0); w.y = pg8::cvt_pk_bf16(a1, b1); w.z = pg8::cvt_pk_bf16(a2, b2); w.w = pg8::cvt_pk_bf16(a3, b3);
                    } else {
                        w.x = pg8::cvt_pk_bf16(v0[0], v0[1]); w.y = pg8::cvt_pk_bf16(v0[2], v0[3]); w.z = pg8::cvt_pk_bf16(v1[0], v1[1]); w.w = pg8::cvt_pk_bf16(v1[2], v1[3]);
                    }
                    *(pg8::u32x4*)(QM + (size_t)row * 768 + col) = w;
                }
            }
    }
};
struct EpiKvUp {
    static constexpr bool PERM = true, AFTER_DRAIN = false, MID = false; typedef pg8::f32x4 acc_t;
    bf16* KVM; const float* rskv;
    __device__ __forceinline__ void operator()(const f32x4 (&acc)[2][2][4][2], const Unit& u, int wr, int wc, int fr, int fq) const {
        const int row0 = u.pm * 256 + wr * 64 + fr, col0 = u.pn * 256 + wc * 32 + 8 * fq;
        float srow[2][4];
#pragma unroll
        for (int ai = 0; ai < 2; ++ai)
#pragma unroll
            for (int m = 0; m < 4; ++m) srow[ai][m] = rskv[row0 + ai * 128 + m * 16];
#pragma unroll
        for (int ai = 0; ai < 2; ++ai)
#pragma unroll
            for (int m = 0; m < 4; ++m) {
                const int row = row0 + ai * 128 + m * 16; const float s = 1.0f / sqrtf(srow[ai][m] * (1.0f / 512.0f) + EPS);
#pragma unroll
                for (int bj = 0; bj < 2; ++bj) {
                    const f32x4 v0 = acc[ai][bj][m][0] * s, v1 = acc[ai][bj][m][1] * s;
                    pg8::u32x4 w; w.x = pg8::cvt_pk_bf16(v0[0], v0[1]); w.y = pg8::cvt_pk_bf16(v0[2], v0[3]); w.z = pg8::cvt_pk_bf16(v1[0], v1[1]); w.w = pg8::cvt_pk_bf16(v1[2], v1[3]);
                    *(pg8::u32x4*)(KVM + (size_t)row * 1024 + col0 + bj * 128) = w;
                }
            }
    }
};
struct EpiProjFused {
    static constexpr bool PERM = true, AFTER_DRAIN = false, MID = true; typedef pg8::f32x4 acc_t;
    const unsigned char* GT; bf16* MBF; int t1, t2;
    typedef _Float16 h8 __attribute__((ext_vector_type(8)));
    __device__ __forceinline__ void mid(f32x4 (&acc)[2][2][4][2], const Unit& u, bool second, int wr, int wc, int fr, int fq) const {
        const unsigned slot = (unsigned)(((wr * 4 + wc) * 64 + fq * 16 + fr) * 16);
        const unsigned gx = (unsigned)(((second ? 16 : 0) + u.pn) * 64 + u.pm) * 131072u + slot, gy = gx + 16u * 64u * 131072u;
        const GAS unsigned char* Gb = (const GAS unsigned char*)GT;
#pragma unroll
        for (int ai = 0; ai < 2; ++ai) {
            h8 X[4][2], Y[4][2];
#pragma unroll
            for (int m = 0; m < 4; ++m)
#pragma unroll
                for (int bj = 0; bj < 2; ++bj) { const unsigned co = (unsigned)((ai * 4 + m) * 2 + bj) * 8192u; X[m][bj] = *(const GAS h8*)(Gb + (gx + co)); Y[m][bj] = *(const GAS h8*)(Gb + (gy + co)); }
#pragma unroll
            for (int m = 0; m < 4; ++m) {
#pragma unroll
                for (int bj = 0; bj < 2; ++bj) {
#pragma unroll
                    for (int j = 0; j < 8; ++j) { const float r = (float)Y[m][bj][j] * __builtin_amdgcn_rcpf((float)X[m][bj][j]); acc[ai][bj][m][j >> 2][j & 3] *= r; }
                    __builtin_amdgcn_sched_barrier(0);
                }
            }
            asm volatile("" ::: "memory");
        }
    }
    __device__ __forceinline__ void operator()(const f32x4 (&acc)[2][2][4][2], const Unit& u, int wr, int wc, int fr, int fq) const {
        const int row0 = u.pm * 256 + wr * 64 + fr, col0 = u.pn * 256 + wc * 32 + 8 * fq;
        h8 Gall[2][4][2];
        { const GAS unsigned char* gb_ = (const GAS unsigned char*)GT + ((unsigned)((32 + u.pn) * 64 + u.pm) * 131072u + (unsigned)(((wr * 4 + wc) * 64 + fq * 16 + fr) * 16));
#pragma unroll
          for (int ai = 0; ai < 2; ++ai)
#pragma unroll
            for (int m = 0; m < 4; ++m)
#pragma unroll
                for (int bj = 0; bj < 2; ++bj) Gall[ai][m][bj] = *(const GAS h8*)(gb_ + (unsigned)((ai * 4 + m) * 2 + bj) * 8192u); }
#pragma unroll
        for (int ai = 0; ai < 2; ++ai)
#pragma unroll
            for (int m = 0; m < 4; ++m) {
                const int row = row0 + ai * 128 + m * 16;
#pragma unroll
                for (int bj = 0; bj < 2; ++bj) {
                    const h8 G = Gall[ai][m][bj];
                    float v[8];
#pragma unroll
                    for (int j = 0; j < 8; ++j) v[j] = acc[ai][bj][m][j >> 2][j & 3] * __builtin_amdgcn_rcpf((float)G[j]);
                    pg8::u32x4 w; w.x = pg8::cvt_pk_bf16(v[0], v[1]); w.y = pg8::cvt_pk_bf16(v[2], v[3]); w.z = pg8::cvt_pk_bf16(v[4], v[5]); w.w = pg8::cvt_pk_bf16(v[6], v[7]);
                    *(pg8::u32x4*)(MBF + (size_t)row * DM + col0 + bj * 128) = w;
                }
            }
    }
};
struct EpiOut {
    static constexpr bool PERM = false, AFTER_DRAIN = false, MID = false; typedef pg8::f32x4 acc_t;
    const float* Xp; float* Xn; bf16* XBn; float* ssx; unsigned* rmx; bool LAST; bool stats; bool FIN; bool TIN; bool TOUT;
    __device__ __forceinline__ void operator()(const f32x4 (&acc)[2][2][4][2], const Unit& u, int wr, int wc, int fr, int fq) const {
        const int row0 = u.pm * 256 + wr * 64 + fr, col0 = u.pn * 256 + wc * 32 + 4 * fq;
        const unsigned tb = (unsigned)(u.pn * 64 + u.pm) * 262144u + (unsigned)(((wr * 4 + wc) * 64 + fq * 16 + fr) * 16), rb = ((unsigned)row0 * (unsigned)DM + (unsigned)col0) * 4u;
        const unsigned ib = TIN ? tb : rb, ob = TOUT ? tb : rb;
        const unsigned is_ai = TIN ? 16u * 8192u : 128u * DM * 4u, is_m = TIN ? 4u * 8192u : 16u * DM * 4u, is_bj = TIN ? 2u * 8192u : 512u, is_n = TIN ? 8192u : 64u;
        const unsigned os_ai = TOUT ? 16u * 8192u : 128u * DM * 4u, os_m = TOUT ? 4u * 8192u : 16u * DM * 4u, os_bj = TOUT ? 2u * 8192u : 512u, os_n = TOUT ? 8192u : 64u;
#pragma unroll
        for (int ai = 0; ai < 2; ++ai) {
            f32x4 xin[4][2][2];
#pragma unroll
            for (int m = 0; m < 4; ++m)
#pragma unroll
                for (int bj = 0; bj < 2; ++bj)
#pragma unroll
                    for (int n = 0; n < 2; ++n) xin[m][bj][n] = *(const GAS f32x4*)((const GAS unsigned char*)Xp + (ib + ai * is_ai + m * is_m + bj * is_bj + n * is_n));
#pragma unroll
            for (int m = 0; m < 4; ++m) {
                const int row = row0 + ai * 128 + m * 16; const size_t off = (size_t)row * DM + col0; float ssl = 0.f, mxl = 0.f;
#pragma unroll
                for (int bj = 0; bj < 2; ++bj) {
                    pg8::u32x2 w[2];
#pragma unroll
                    for (int n = 0; n < 2; ++n) { const f32x4 v = xin[m][bj][n] + acc[ai][bj][m][n]; if (!FIN) *(GAS f32x4*)((GAS unsigned char*)Xn + (ob + ai * os_ai + m * os_m + bj * os_bj + n * os_n)) = v;
                        if (!LAST) { w[n].x = pg8::cvt_pk_bf16(v[0], v[1]); w[n].y = pg8::cvt_pk_bf16(v[2], v[3]); ssl += (v[0] * v[0] + v[1] * v[1]) + (v[2] * v[2] + v[3] * v[3]); mxl = fmaxf(fmaxf(mxl, fmaxf(fabsf(v[0]), fabsf(v[1]))), fmaxf(fabsf(v[2]), fabsf(v[3]))); } }
                    if (!LAST) {
                        auto r0 = __builtin_amdgcn_permlane16_swap(w[0].x, w[1].x, false, false); auto r1 = __builtin_amdgcn_permlane16_swap(w[0].y, w[1].y, false, false);
                        pg8::u32x4 w4; w4.x = r0[0]; w4.y = r1[0]; w4.z = r0[1]; w4.w = r1[1];
                        const int cx = (fq & 1) ? 16 + 4 * (fq - 1) - 4 * fq : 0;
                        *(pg8::u32x4*)(XBn + off + bj * 128 + cx) = w4; }
                }
                if (!LAST && stats) { ssl += __shfl_xor(ssl, 16); ssl += __shfl_xor(ssl, 32); mxl = fmaxf(mxl, __shfl_xor(mxl, 16)); mxl = fmaxf(mxl, __shfl_xor(mxl, 32));
                    if (fq == 0) { atomic_addf(ssx + row, ssl); atomicMax(rmx + row, __float_as_uint(mxl)); } }
            }
            asm volatile("" ::: "memory");
        }
    }
};

__device__ __forceinline__ float dot8(const v4u kv, const LAS float* q) {
    const f32x4 q0 = *(const LAS f32x4*)q, q1 = *(const LAS f32x4*)(q + 4);
    return pg8::bf_lo(kv.x) * q0[0] + pg8::bf_hi(kv.x) * q0[1] + pg8::bf_lo(kv.y) * q0[2] + pg8::bf_hi(kv.y) * q0[3]
         + pg8::bf_lo(kv.z) * q1[0] + pg8::bf_hi(kv.z) * q1[1] + pg8::bf_lo(kv.w) * q1[2] + pg8::bf_hi(kv.w) * q1[3];
}
template <int MODE>
__device__ __forceinline__ void naive_attn_task(Frame& F, const Args& A, int layer, int row, int head, LAS float* wscr) {
    const int lane = F.lane;
    constexpr int DQK = (MODE == 1) ? 192 : 128;
    const bf16 *qp, *kb, *vb, *gatep; bf16* outp; int kpitch, vpitch;
    if (MODE == 0) { qp = F.P + (size_t)row * PP + C_QA + head * 128; kb = F.P + C_KA + (head >> 2) * 128; vb = F.P + C_VA + (head >> 2) * 128; kpitch = PP; vpitch = PP;
        gatep = F.P + (size_t)row * PP + C_ZA + head * 128; outp = F.Y + (size_t)row * YW + head * 128; }
    else if (MODE == 1) { qp = F.QM + (size_t)row * 768 + head * 192; kb = F.KVM + head * 256; vb = F.KVM + head * 256 + 128; kpitch = 1024; vpitch = 1024;
        gatep = F.P + (size_t)row * PP + C_ZB + head * 128; outp = F.Y + (size_t)row * YW + 1024 + head * 128; }
    else { qp = F.P + (size_t)row * PP + C_QC + head * 128; kb = F.P + C_KC + head * 128; vb = F.P + C_VC + head * 128; kpitch = PP; vpitch = PP;
        gatep = F.P + (size_t)row * PP + C_ZC + head * 128; outp = F.Y + (size_t)row * YW + 1536 + head * 128; }
    LAS float* qs = wscr; LAS float* ps = wscr + 192;
    for (int i = lane; i < DQK; i += 64) qs[i] = bf2f(qp[i]);
    LDS_WAIT(); asm volatile("" ::: "memory");
    float o0 = 0.f, o1 = 0.f, mrun = -1e30f, lrun = 0.f, carry = 0.f;
    int klo, khi;
    if (MODE == 0) { klo = row - 127 > 0 ? row - 127 : 0; khi = row; } else if (MODE == 1) { klo = 0; khi = row; } else { klo = 0; khi = row - 1; }
    if (khi >= klo) {
        const int cfirst = klo & ~63, clast = khi & ~63;
        const int nchunk = (clast - cfirst) / 64 + 1;
        for (int ci = 0; ci < nchunk; ++ci) {
            const int c0 = (MODE == 2) ? clast - 64 * ci : cfirst + 64 * ci;
            const int s = c0 + lane; const bool valid = (s >= klo) && (s <= khi);
            const int sl = s > khi ? khi : (s < klo ? klo : s);
            const bf16* kp = kb + (size_t)sl * kpitch;
            float d = 0.f;
#pragma unroll
            for (int c = 0; c < 16; ++c) d += dot8(*(const GAS v4u*)(kp + 8 * c), qs + 8 * c);
            if (MODE == 1) { const bf16* krp = F.KRM + (size_t)sl * 64;
#pragma unroll
                for (int c = 0; c < 8; ++c) d += dot8(*(const GAS v4u*)(krp + 8 * c), qs + 128 + 8 * c); }
            float p;
            if (MODE == 2) {
                const float z = d;
                const float lk = -(fmaxf(z, 0.f) + __builtin_amdgcn_logf(1.0f + __builtin_amdgcn_exp2f(-fabsf(z))));
                float incl = valid ? lk : 0.f;
#pragma unroll
                for (int off = 1; off < 64; off <<= 1) { const float t = __shfl_down(incl, off); if (lane + off < 64) incl += t; }
                float excl = __shfl_down(incl, 1); if (lane == 63) excl = 0.f;
                const float tot = __shfl(incl, 0);
                p = valid ? __builtin_amdgcn_exp2f(z + lk + excl + carry) : 0.f;
                carry += tot;
            } else {
                float sc = d;
                if (MODE == 0) sc += A.rel_bias[(int)T5B[(row - sl) & 127] * 8 + head] * LOG2E;
                sc = valid ? sc : -__builtin_inff();
                const float mn = fmaxf(mrun, wave_max(sc));
                const float alpha = __builtin_amdgcn_exp2f(mrun - mn);
                p = __builtin_amdgcn_exp2f(sc - mn);
                lrun = lrun * alpha + wave_sum(p); o0 *= alpha; o1 *= alpha; mrun = mn;
            }
            ps[lane] = p;
            LDS_WAIT(); asm volatile("" ::: "memory");
            for (int j = 0; j < 64; ++j) {
                int sj = c0 + j; sj = sj > khi ? khi : (sj < klo ? klo : sj);
                const float pj = ps[j];
                const unsigned vv = *(const GAS unsigned*)(vb + (size_t)sj * vpitch + 2 * lane);
                o0 += pj * pg8::bf_lo(vv); o1 += pj * pg8::bf_hi(vv);
            }
            LDS_WAIT(); asm volatile("" ::: "memory");
        }
    }
    if (MODE == 0) { const float sk = A.sinks[layer * 8 + head] * LOG2E; const float mf = fmaxf(mrun, sk); const float a = __builtin_amdgcn_exp2f(mrun - mf);
        const float lf = lrun * a + __builtin_amdgcn_exp2f(sk - mf); const float inv = a / lf; o0 *= inv; o1 *= inv; }
    if (MODE == 1) { const float inv = 1.0f / lrun; o0 *= inv; o1 *= inv; }
    const unsigned gv = *(const GAS unsigned*)(gatep + 2 * lane);
    *(GAS unsigned*)(outp + 2 * lane) = pk2(o0 * pg8::bf_lo(gv), o1 * pg8::bf_hi(gv));
}
__device__ __forceinline__ void naive_attn_phase(Frame& F, const Args& A, int layer) {
    LAS float* wscr = (LAS float*)(F.lds + RING_OFF + F.wave * 2048);
    if (!(ATTN_MFMA_MASK & 2)) for (int t = F.gw; t < S * 4; t += F.NGW) naive_attn_task<1>(F, A, layer, t >> 2, t & 3, wscr);
    if (!(ATTN_MFMA_MASK & 4)) for (int t = F.gw; t < S * 4; t += F.NGW) naive_attn_task<2>(F, A, layer, t >> 2, t & 3, wscr);
    if (!(ATTN_MFMA_MASK & 1)) for (int t = F.gw; t < S * 8; t += F.NGW) naive_attn_task<0>(F, A, layer, t >> 3, t & 7, wscr);
}


namespace att {
typedef short s16x4 __attribute__((ext_vector_type(4)));
typedef float f32x16 __attribute__((ext_vector_type(16)));
constexpr int SHM_T = 16384, OFF_V = 0  , OFF_K = 3 * SHM_T  , OFF_KR = 5 * SHM_T, OFF_WS = 5 * SHM_T + 2 * 8192, OFF_FLAG = OFF_WS + 8 * 256, OFF_LUT = OFF_FLAG + 64, LDS_END = OFF_LUT + 512;
static_assert(LDS_END <= RING_BYTES, "attention LDS");
#define KSWZ(row, colB) ((row) * 256 + ((colB) ^ (((row) & 15) << 4)))
#define KRSWZ(row, chunk) ((row) * 128 + ((((chunk) ^ ((row) >> 1)) & 7) << 4))
__device__ __forceinline__ int v_st(int k, int c) { const int kk = (k & ~0xC) | ((k & 4) << 1) | ((k & 8) >> 1); return ((kk >> 3) * 4 + (c >> 5)) * 512 + ((kk & 7) * 32 + (c & 31)) * 2; }
__device__ __forceinline__ int v_rd_base(int lane) { return ((lane & 3) << 3) | (((lane >> 2) & 3) << 6) | (((lane >> 4) & 1) << 5) | (((lane >> 5) & 1) << 8); }
constexpr int v_rd_off(int d0, int ks, int half) { return d0 * 512 + ks * 4096 + half * 2048; }
__device__ __forceinline__ int crow(int r, int hi) { return (r & 3) + 8 * (r >> 2) + 4 * hi; }
__device__ __forceinline__ unsigned cvtpk(float lo, float hi) { unsigned r; asm volatile("v_cvt_pk_bf16_f32 %0, %1, %2" : "=v"(r) : "v"(lo), "v"(hi)); return r; }
__device__ __forceinline__ void glds16(const void* gsrc, unsigned lds_dst) { unsigned keep;
    asm volatile("s_mov_b32 %0, m0\n\ts_mov_b32 m0, %2\n\ts_nop 0\n\tglobal_load_lds_dwordx4 %1, off\n\ts_mov_b32 m0, %0" : "=&s"(keep) : "v"(gsrc), "s"(lds_dst) : "memory"); }
__device__ __forceinline__ void glds16s(const char* sbase, unsigned voff, unsigned lds_dst) { unsigned keep;
    asm volatile("s_mov_b32 %0, m0\n\ts_mov_b32 m0, %3\n\ts_nop 0\n\tglobal_load_lds_dwordx4 %1, %2\n\ts_mov_b32 m0, %0" : "=&s"(keep) : "v"(voff), "s"(sbase), "s"(lds_dst) : "memory"); }
__device__ __forceinline__ const char* uni_ptr(const void* p) { const unsigned long long v = (unsigned long long)(uintptr_t)p;
    const unsigned lo = __builtin_amdgcn_readfirstlane((unsigned)v), hi_ = __builtin_amdgcn_readfirstlane((unsigned)(v >> 32)); return (const char*)(uintptr_t)(((unsigned long long)hi_ << 32) | lo); }
#define ATT_PK4(P, B_, OUT) do { unsigned a0 = cvtpk(P[B_+0], P[B_+1]), a1 = cvtpk(P[B_+2], P[B_+3]);                          \
        unsigned b0 = cvtpk(P[B_+4], P[B_+5]), b1 = cvtpk(P[B_+6], P[B_+7]);                                             \
        auto r0 = __builtin_amdgcn_permlane32_swap(a0, b0, false, false); auto r1 = __builtin_amdgcn_permlane32_swap(a1, b1, false, false); \
        v4u w_ = {r0[0], r1[0], r0[1], r1[1]}; OUT = __builtin_bit_cast(bf16x8, w_); } while (0)

template <int MODE>
__device__ __forceinline__ void attn_unit(LAS unsigned char* L, const bf16* __restrict__ Qp, int qpitch, const bf16* __restrict__ Kp, const bf16* __restrict__ Vp, int kvpitch,
                                          const bf16* __restrict__ KRp, const bf16* __restrict__ Gp, bf16* __restrict__ Op, int P0, float sink2, const float* __restrict__ biasp,
                                          int jlo_ovr, int jhi_ovr, float* __restrict__ Opart, float* __restrict__ MLp,
                                          gu32* cnt = nullptr, int nparts = 0, const float* Opart0 = nullptr, const float* ML0 = nullptr, volatile LAS unsigned* bflag = nullptr) {
    constexpr int NQ = (MODE == 1) ? 12 : 8;
    constexpr float THR = 8.f, NEG = -__builtin_inff();
    int tid = threadIdx.x; asm volatile("" : "+v"(tid));
    const int wid = __builtin_amdgcn_readfirstlane(tid >> 6), lane = tid & 63, r32 = lane & 31, hi = lane >> 5;
    int j_lo = 0, j_hi = P0 / 64 + 4;
    if (MODE == 0) j_lo = P0 >= 128 ? P0 / 64 - 2 : 0;
    if (MODE == 1) { j_lo = jlo_ovr; j_hi = jhi_ovr; }
    const int NT = j_hi - j_lo;
    const int qlo = P0 + wid * 32, qpos = qlo + r32;
    unsigned ko[2], vo[2];
    const char* const Kb0 = uni_ptr(Kp); const char* const Rb0 = uni_ptr(KRp);
    const unsigned vdiff = (unsigned)__builtin_amdgcn_readfirstlane((int)((const char*)Vp - (const char*)Kp));
#pragma unroll
    for (int i = 0; i < 2; ++i) { const int p = wid * 128 + i * 64 + lane;
        { const int row = p >> 4, phys = p & 15; ko[i] = (unsigned)(row * kvpitch + ((phys ^ (row & 15)) << 3)) * 2u; }
        { const int s = p >> 5, q = p & 31, kk = (s >> 2) * 8 + (q >> 2); const int vr = (kk & ~0xC) | ((kk & 4) << 1) | ((kk & 8) >> 1); vo[i] = (unsigned)(vr * kvpitch + (s & 3) * 32 + (q & 3) * 8) * 2u + vdiff; } }
    const int rp = wid * 64 + lane; const unsigned ro = (unsigned)((rp >> 3) * 64 + (((rp & 7) ^ ((rp >> 4) & 7)) << 3)) * 2u;
    const unsigned ldsK = (unsigned)(uintptr_t)(L + OFF_K) + (unsigned)wid * 2048u, ldsV = (unsigned)(uintptr_t)(L + OFF_V) + (unsigned)wid * 2048u, ldsR = (unsigned)(uintptr_t)(L + OFF_KR) + (unsigned)wid * 1024u;
    const unsigned XK = (unsigned)(r32 * 256 + ((hi ^ (r32 & 15)) << 4)), XR = (unsigned)(r32 * 128 + (((hi ^ (r32 >> 1)) & 7) << 4));
    LAS float* wsf = (LAS float*)(L + OFF_WS + wid * 256); LAS float* li_l = wsf; LAS float* al_l = wsf + 32;
    volatile LAS unsigned* flags = (volatile LAS unsigned*)(L + OFF_FLAG);
    LAS float* blut = (LAS float*)(L + OFF_LUT);
    float blv = 0.f; if (MODE == 0) { if (tid < 128) blv = biasp[tid]; }
    bf16x8 qr[NQ];
#pragma unroll
    for (int d0 = 0; d0 < NQ; ++d0) qr[d0] = *(const GAS bf16x8*)(Qp + (size_t)(wid * 32 + r32) * qpitch + d0 * 16 + hi * 8);
#define ATT_TILE(t) ((MODE == 2) ? (j_hi - 1 - (t)) : (j_lo + (t)))
#define ATT_DMA(jt, bf, vbf) do { const char* kb_ = Kb0 + (size_t)(jt) * 128 * (size_t)kvpitch; \
        glds16s(kb_, ko[0], (unsigned)__builtin_amdgcn_readfirstlane(ldsK + (bf) * SHM_T)); \
        glds16s(kb_, ko[1], (unsigned)__builtin_amdgcn_readfirstlane(ldsK + (bf) * SHM_T + 1024)); \
        glds16s(kb_, vo[0], (unsigned)__builtin_amdgcn_readfirstlane(ldsV + (vbf) * SHM_T)); \
        glds16s(kb_, vo[1], (unsigned)__builtin_amdgcn_readfirstlane(ldsV + (vbf) * SHM_T + 1024)); \
        if (MODE == 1) glds16s(Rb0 + (size_t)(jt) * 8192, ro, (unsigned)__builtin_amdgcn_readfirstlane(ldsR + (bf) * 8192)); } while (0)
    float m_reg = -1e30f, l_reg = 0.f, carry = 0.f;
    f32x16 o[4];
#pragma unroll
    for (int d = 0; d < 4; ++d)
#pragma unroll
        for (int r = 0; r < 16; ++r) o[d][r] = 0.f;
    ATT_DMA(ATT_TILE(0), 0, 0); if (MODE == 0) { if (tid < 128) blut[tid] = blv; } VM_WAIT();
#pragma unroll
    for (int d0 = 0; d0 < NQ; ++d0) asm volatile("" : "+v"(qr[d0]));
    __syncthreads();
    const unsigned vbase = (unsigned)(uintptr_t)(L + OFF_V) + (unsigned)v_rd_base(lane);
    const bool lag = (wid >= 4);
    bool pend = false; int vcur = 0, vprev = 0;
    bf16x8 pa0, pa1, pa2, pa3;
#define ATT_TRRD(dst, off) asm volatile("ds_read_b64_tr_b16 %0, %1 offset:%2" : "=&v"(dst) : "v"(vb0), "i"(off) : "memory")
#define ATT_PV(d0) do { s16x4 l0, l1, l2, l3, h0, h1, h2, h3; constexpr int b_ = v_rd_off(d0, 0, 0); \
        ATT_TRRD(l0, b_); ATT_TRRD(h0, b_ + 2048); ATT_TRRD(l1, b_ + 4096); ATT_TRRD(h1, b_ + 6144); ATT_TRRD(l2, b_ + 8192); ATT_TRRD(h2, b_ + 10240); ATT_TRRD(l3, b_ + 12288); ATT_TRRD(h3, b_ + 14336); \
        asm volatile("s_waitcnt lgkmcnt(0)" ::: "memory"); __builtin_amdgcn_sched_barrier(0); \
        o[d0] = __builtin_amdgcn_mfma_f32_32x32x16_bf16((bf16x8){l0[0], l0[1], l0[2], l0[3], h0[0], h0[1], h0[2], h0[3]}, pa0, o[d0], 0, 0, 0); \
        o[d0] = __builtin_amdgcn_mfma_f32_32x32x16_bf16((bf16x8){l1[0], l1[1], l1[2], l1[3], h1[0], h1[1], h1[2], h1[3]}, pa1, o[d0], 0, 0, 0); \
        o[d0] = __builtin_amdgcn_mfma_f32_32x32x16_bf16((bf16x8){l2[0], l2[1], l2[2], l2[3], h2[0], h2[1], h2[2], h2[3]}, pa2, o[d0], 0, 0, 0); \
        o[d0] = __builtin_amdgcn_mfma_f32_32x32x16_bf16((bf16x8){l3[0], l3[1], l3[2], l3[3], h3[0], h3[1], h3[2], h3[3]}, pa3, o[d0], 0, 0, 0); } while (0)
#define ATT_PV_ALL(vbuf) do { const unsigned vb0 = vbase + (unsigned)((vbuf) * SHM_T); __builtin_amdgcn_s_setprio(1); ATT_PV(0); ATT_PV(1); ATT_PV(2); ATT_PV(3); __builtin_amdgcn_s_setprio(0); } while (0)
    for (int t = 0; t < NT; ++t) {
        const int cur = t & 1, jt = ATT_TILE(t), kb = jt * 64;
        const bool more = (t + 1 < NT);
        vprev = vcur; vcur = t % 3;
        if (more) ATT_DMA(ATT_TILE(t + 1), cur ^ 1, (t + 1) % 3);
        if (lag && pend) { ATT_PV_ALL(vprev); pend = false; }
        bool act;
        if (MODE == 0) act = (kb <= qlo + 31) && (kb + 63 >= qlo - 127);
        else if (MODE == 1) act = (kb <= qlo + 31);
        else act = (kb < qlo + 31) && !__all(carry < -150.f);
        if (act) {
            f32x16 p0, p1;
#pragma unroll
            for (int r = 0; r < 16; ++r) { p0[r] = 0.f; p1[r] = 0.f; }
            {
                unsigned xk = XK, xr = XR; asm volatile("" : "+v"(xk), "+v"(xr));
                const unsigned kbs = (unsigned)(uintptr_t)(L + OFF_K) + (unsigned)cur * SHM_T, rbs = (unsigned)(uintptr_t)(L + OFF_KR) + (unsigned)cur * 8192u;
                bf16x8 f0, f1, f2, f3;
#define ATT_KRD(dst, addr, off) asm volatile("ds_read_b128 %0, %1 offset:%2" : "=&v"(dst) : "v"(addr), "i"(off) : "memory")
#define ATT_KISSUE(s_, A_, B_) do { if ((s_) < 8) { const unsigned a_ = (xk ^ ((unsigned)(s_) << 5)) + kbs; ATT_KRD(A_, a_, 0); ATT_KRD(B_, a_, 8192); } \
                                    else { const unsigned a_ = (xr ^ ((unsigned)((s_) - 8) << 5)) + rbs; ATT_KRD(A_, a_, 0); ATT_KRD(B_, a_, 4096); } } while (0)
                ATT_KISSUE(0, f0, f1); ATT_KISSUE(1, f2, f3);
                __builtin_amdgcn_s_setprio(1);
#pragma unroll
                for (int s = 0; s < NQ; s += 2) {
                    if (s + 1 < NQ) asm volatile("s_waitcnt lgkmcnt(2)" ::: "memory"); else asm volatile("s_waitcnt lgkmcnt(0)" ::: "memory");
                    __builtin_amdgcn_sched_barrier(0);
                    p0 = __builtin_amdgcn_mfma_f32_32x32x16_bf16(f0, qr[s], p0, 0, 0, 0); p1 = __builtin_amdgcn_mfma_f32_32x32x16_bf16(f1, qr[s], p1, 0, 0, 0);
                    __builtin_amdgcn_sched_barrier(0);
                    if (s + 2 < NQ) ATT_KISSUE(s + 2, f0, f1);
                    if (s + 2 < NQ) asm volatile("s_waitcnt lgkmcnt(2)" ::: "memory"); else asm volatile("s_waitcnt lgkmcnt(0)" ::: "memory");
                    __builtin_amdgcn_sched_barrier(0);
                    p0 = __builtin_amdgcn_mfma_f32_32x32x16_bf16(f2, qr[s + 1], p0, 0, 0, 0); p1 = __builtin_amdgcn_mfma_f32_32x32x16_bf16(f3, qr[s + 1], p1, 0, 0, 0);
                    __builtin_amdgcn_sched_barrier(0);
                    if (s + 3 < NQ) ATT_KISSUE(s + 3, f2, f3);
                }
                __builtin_amdgcn_s_setprio(0);
#undef ATT_KISSUE
#undef ATT_KRD
            }
            const int dq = qpos - kb - 4 * hi;
            if (MODE != 2) {
                if (MODE == 0) {
#pragma unroll
                    for (int r = 0; r < 16; ++r) { const int c = (r & 3) + 8 * (r >> 2); const int e0 = dq - c, e1 = dq - c - 32;
                        const float b0 = blut[e0 < 0 ? 0 : (e0 > 127 ? 127 : e0)], b1 = blut[e1 < 0 ? 0 : (e1 > 127 ? 127 : e1)];
                        p0[r] = ((unsigned)e0 < 128u) ? p0[r] + b0 : NEG; p1[r] = ((unsigned)e1 < 128u) ? p1[r] + b1 : NEG; }
                } else {
                    if (kb + 63 > qlo) {
#pragma unroll
                        for (int r = 0; r < 16; ++r) { const int c = (r & 3) + 8 * (r >> 2); if (dq - c < 0) p0[r] = NEG; if (dq - c - 32 < 0) p1[r] = NEG; }
                    }
                }
                float pmax = p0[0];
#pragma unroll
                for (int r = 1; r < 16; ++r) pmax = fmaxf(pmax, p0[r]);
#pragma unroll
                for (int r = 0; r < 16; ++r) pmax = fmaxf(pmax, p1[r]);
                { auto rr = __builtin_amdgcn_permlane32_swap(__float_as_uint(pmax), __float_as_uint(pmax), false, false); pmax = fmaxf(__uint_as_float(rr[0]), __uint_as_float(rr[1])); }
                float mn, alpha;
                if (__all(pmax - m_reg <= THR)) { mn = m_reg; alpha = 1.f; }
                else { mn = fmaxf(m_reg, pmax); alpha = __builtin_amdgcn_exp2f(m_reg - mn); m_reg = mn; }
                float ps = 0.f;
#pragma unroll
                for (int r = 0; r < 16; ++r) { p0[r] = __builtin_amdgcn_exp2f(p0[r] - mn); p1[r] = __builtin_amdgcn_exp2f(p1[r] - mn); ps += p0[r] + p1[r]; }
                { auto rr = __builtin_amdgcn_permlane32_swap(__float_as_uint(ps), __float_as_uint(ps), false, false); ps = __uint_as_float(rr[0]) + __uint_as_float(rr[1]); }
                l_reg = l_reg * alpha + ps;
                if (__any(alpha < 1.f)) {
#pragma unroll
                    for (int r = 0; r < 16; ++r)
#pragma unroll
                        for (int d = 0; d < 4; ++d) o[d][r] *= alpha;
                }
            } else {
                float T[8];
#pragma unroll
                for (int i = 0; i < 8; ++i) {
                    float x[4], zz[4];
#pragma unroll
                    for (int a = 0; a < 4; ++a) { const int r = (i & 3) * 4 + a; const float z = (i < 4) ? p0[r] : p1[r]; const int c = (r & 3) + 8 * (r >> 2) + ((i < 4) ? 0 : 32);
                        const bool past = (dq - c) > 0;
                        const float lk = -(fmaxf(z, 0.f) + __builtin_amdgcn_logf(1.0f + __builtin_amdgcn_exp2f(-fabsf(z))));
                        x[a] = past ? lk : 0.f; zz[a] = past ? (z + lk) : NEG; }
                    const float e2 = x[3], e1 = x[3] + x[2], e0 = e1 + x[1];
                    T[i] = e0 + x[0];
                    if (i < 4) { p0[(i & 3) * 4 + 0] = zz[0] + e0; p0[(i & 3) * 4 + 1] = zz[1] + e1; p0[(i & 3) * 4 + 2] = zz[2] + e2; p0[(i & 3) * 4 + 3] = zz[3]; }
                    else       { p1[(i & 3) * 4 + 0] = zz[0] + e0; p1[(i & 3) * 4 + 1] = zz[1] + e1; p1[(i & 3) * 4 + 2] = zz[2] + e2; p1[(i & 3) * 4 + 3] = zz[3]; }
                }
                float U[8], PT[8];
#pragma unroll
                for (int i = 0; i < 8; ++i) { auto rr = __builtin_amdgcn_permlane32_swap(__float_as_uint(T[i]), __float_as_uint(T[i]), false, false);
                    const float tlo = __uint_as_float(rr[0]), thi = __uint_as_float(rr[1]); U[i] = tlo + thi; PT[i] = hi ? 0.f : thi; }
                float su = carry;
#pragma unroll
                for (int i = 7; i >= 0; --i) {
                    const float A = su + PT[i];
#pragma unroll
                    for (int a = 0; a < 4; ++a) { const int r = (i & 3) * 4 + a; if (i < 4) p0[r] = __builtin_amdgcn_exp2f(p0[r] + A); else p1[r] = __builtin_amdgcn_exp2f(p1[r] + A); }
                    su += U[i];
                }
                carry = su;
            }
            ATT_PK4(p0, 0, pa0); ATT_PK4(p0, 8, pa1); ATT_PK4(p1, 0, pa2); ATT_PK4(p1, 8, pa3);
            if (lag) pend = true; else ATT_PV_ALL(vcur);
        }
        VM_WAIT();
        if (MODE == 2) { if (lane == 0) flags[cur * 8 + wid] = __all(carry < -150.f) ? 1u : 0u; }
        __syncthreads();
        if (MODE == 2) { bool alld = true;
#pragma unroll
            for (int w = 0; w < 8; ++w) alld = alld && (flags[cur * 8 + w] != 0u);
            if (alld) break; }
    }
    if (pend) { ATT_PV_ALL(vcur); }
#undef ATT_PV_ALL
#undef ATT_PV
#undef ATT_TRRD
    const int orow = wid * 32 + r32;
    const GAS unsigned char* const Gub = (const GAS unsigned char*)uni_ptr(Gp); GAS unsigned char* const Oub = (GAS unsigned char*)uni_ptr(Op);
    const unsigned goff = (unsigned)(orow * PP + 8 * hi) * 2u, yoff = (unsigned)(orow * YW + 8 * hi) * 2u;
    auto fin_d0 = [&](const int d0, const f32x16& val, const float inv, const v4u g0, const v4u g1) __attribute__((always_inline)) {
#pragma unroll
        for (int pr = 0; pr < 2; ++pr) { float x[8];
#pragma unroll
            for (int i = 0; i < 4; ++i) { auto rr = __builtin_amdgcn_permlane32_swap(__float_as_uint(val[8 * pr + i] * inv), __float_as_uint(val[8 * pr + 4 + i] * inv), false, false);
                x[i] = __uint_as_float(rr[0]); x[4 + i] = __uint_as_float(rr[1]); }
            const v4u g = pr ? g1 : g0; v4u w;
            w.x = cvtpk(x[0] * pg8::bf_lo(g.x), x[1] * pg8::bf_hi(g.x)); w.y = cvtpk(x[2] * pg8::bf_lo(g.y), x[3] * pg8::bf_hi(g.y));
            w.z = cvtpk(x[4] * pg8::bf_lo(g.z), x[5] * pg8::bf_hi(g.z)); w.w = cvtpk(x[6] * pg8::bf_lo(g.w), x[7] * pg8::bf_hi(g.w));
            *(GAS v4u*)(Oub + (yoff + (unsigned)(d0 * 32 + 16 * pr) * 2u)) = w; }
    };
    auto finish = [&](const float inv) __attribute__((always_inline)) {
        v4u gw[4][2];
#pragma unroll
        for (int d0 = 0; d0 < 4; ++d0)
#pragma unroll
            for (int pr = 0; pr < 2; ++pr) gw[d0][pr] = *(const GAS v4u*)(Gub + (goff + (unsigned)(d0 * 32 + 16 * pr) * 2u));
#pragma unroll
        for (int d0 = 0; d0 < 4; ++d0) fin_d0(d0, o[d0], inv, gw[d0][0], gw[d0][1]);
    };
    const unsigned slot16 = (unsigned)(wid * 64 + lane) * 16u;
    if (MODE == 1) {
        const char* const Pub = uni_ptr(Opart);
#pragma unroll
        for (int d0 = 0; d0 < 4; ++d0)
#pragma unroll
            for (int g = 0; g < 4; ++g) { const f32x4 v = {o[d0][4 * g], o[d0][4 * g + 1], o[d0][4 * g + 2], o[d0][4 * g + 3]};
                asm volatile("global_store_dwordx4 %0, %1, %2 sc1" :: "v"(slot16 + (unsigned)(d0 * 4 + g) * 8192u), "v"(v), "s"(Pub) : "memory"); }
        if (hi == 0) { __hip_atomic_store((GAS unsigned long long*)(MLp + (size_t)orow * 2), ((unsigned long long)__float_as_uint(l_reg) << 32) | __float_as_uint(m_reg), RLX_AGENT); }
        VM_WAIT();
        __syncthreads();
        if (tid == 0) { const unsigned old = __hip_atomic_fetch_add(cnt, 1u, RLX_AGENT); *bflag = (old + 1u == (unsigned)nparts) ? 1u : 0u; }
        __syncthreads();
        const bool lastp = (*bflag != 0u);
        if (lastp) {
            __builtin_amdgcn_fence(__ATOMIC_ACQUIRE, "agent"); VM_WAIT();
            const GAS unsigned char* const P0ub = (const GAS unsigned char*)uni_ptr(Opart0);
            f32x2 mlv[4]; float wp[4]; float mmx = -1e30f, Ls = 0.f;
#pragma unroll
            for (int p = 0; p < 4; ++p) if (p < nparts) mlv[p] = *(const GAS f32x2*)(ML0 + (size_t)p * 512 + orow * 2);
#pragma unroll
            for (int p = 0; p < 4; ++p) if (p < nparts) mmx = fmaxf(mmx, mlv[p].x);
#pragma unroll
            for (int p = 0; p < 4; ++p) { wp[p] = 0.f; if (p < nparts) { wp[p] = __builtin_amdgcn_exp2f(mlv[p].x - mmx); Ls += wp[p] * mlv[p].y; } }
            const float invL = 1.0f / Ls;
#pragma unroll
            for (int d0 = 0; d0 < 4; ++d0) {
                f32x4 pv[4][4];
#pragma unroll
                for (int g = 0; g < 4; ++g)
#pragma unroll
                    for (int p = 0; p < 4; ++p) if (p < nparts) pv[g][p] = *(const GAS f32x4*)(P0ub + (slot16 + (unsigned)p * 131072u + (unsigned)(d0 * 4 + g) * 8192u));
                const v4u g0 = *(const GAS v4u*)(Gub + (goff + (unsigned)(d0 * 32) * 2u)), g1 = *(const GAS v4u*)(Gub + (goff + (unsigned)(d0 * 32 + 16) * 2u));
                f32x16 mv;
#pragma unroll
                for (int g = 0; g < 4; ++g) { f32x4 acc4 = pv[g][0] * wp[0];
#pragma unroll
                    for (int p = 1; p < 4; ++p) if (p < nparts) acc4 += pv[g][p] * wp[p];
                    mv[4 * g] = acc4[0]; mv[4 * g + 1] = acc4[1]; mv[4 * g + 2] = acc4[2]; mv[4 * g + 3] = acc4[3]; }
                fin_d0(d0, mv, invL, g0, g1);
                asm volatile("" ::: "memory"); __builtin_amdgcn_sched_barrier(0);
            }
        }
        __syncthreads();
        return;
    }
    if (MODE == 2) finish(1.0f);
    else { const float mf = fmaxf(m_reg, sink2); const float a = __builtin_amdgcn_exp2f(m_reg - mf); finish(a / (l_reg * a + __builtin_amdgcn_exp2f(sink2 - mf))); }
    __syncthreads();
#undef ATT_TILE
#undef ATT_DMA
}
}

__device__ __forceinline__ void attn_phase(Frame& F, const Args& A, int layer, int rep) {
    volatile LAS unsigned* MISC = (volatile LAS unsigned*)(F.lds + MISC_OFF);
    gu32* qhead = F.ctl + CW_QUEUE + 64 * (2 * layer + rep);
    unsigned nid = 0u;
    if (threadIdx.x == 0) nid = __hip_atomic_fetch_add(qhead, 1u, RLX_AGENT);
    for (;;) {
        if (threadIdx.x == 0) MISC[16] = nid;
        __syncthreads();
        const unsigned id = MISC[16];
        __syncthreads();
        if (id >= 1408u) break;
        if (threadIdx.x == 0) nid = __hip_atomic_fetch_add(qhead, 1u, RLX_AGENT);
        if (id < 640u && !(ATTN_MFMA_MASK & 2)) continue;
        if (id >= 640u && id < 896u && !(ATTN_MFMA_MASK & 4)) continue;
        if (id >= 896u && !(ATTN_MFMA_MASK & 1)) continue;
        if (id < 640u) {
            int h, qb, p;
            if (id < 384u) { const int idx = (int)(id >> 2); h = (int)(id & 3);
                if (idx < 16) { qb = 16 + idx; p = 0; } else if (idx < 48) { const int k = idx - 16; qb = 32 + (k >> 1); p = k & 1; } else { const int k = idx - 48; qb = 48 + k / 3; p = k % 3; } }
            else { const int jj = (int)id - 384, c = 15 - (jj >> 4), r = jj & 15; h = r & 3; const int g = r >> 2; qb = 16 * g + c; p = g; }
            const int P0 = qb * 256, jlo = 64 * p, jhi_full = 4 * (qb + 1), jhi = (64 * (p + 1) < jhi_full) ? 64 * (p + 1) : jhi_full;
            const size_t slot = (size_t)((h * 64 + qb) * 4 + p);
            const size_t slot0 = (size_t)((h * 64 + qb) * 4);
            att::attn_unit<1>(F.lds + RING_OFF, F.QM + (size_t)P0 * 768 + h * 192, 768, F.KVM + h * 256, F.KVM + h * 256 + 128, 1024, F.KRM,
                              F.P + (size_t)P0 * PP + C_ZB + h * 128, F.Y + (size_t)P0 * YW + 1024 + h * 128, P0, 0.f, nullptr, jlo, jhi, F.OPART + slot * 32768, F.ML + slot * 512,
                              F.ctl + CW_MLACNT + 256 * layer + h * 64 + qb, (qb >> 4) + 1, F.OPART + slot0 * 32768, F.ML + slot0 * 512, MISC + 17); }
        else if (id < 896u) { const int i = (int)id - 640, qb = 63 - (i >> 2), h = i & 3, P0 = qb * 256;
            att::attn_unit<2>(F.lds + RING_OFF, F.P + (size_t)P0 * PP + C_QC + h * 128, PP, F.P + C_KC + h * 128, F.P + C_VC + h * 128, PP, nullptr,
                              F.P + (size_t)P0 * PP + C_ZC + h * 128, F.Y + (size_t)P0 * YW + 1536 + h * 128, P0, 0.f, nullptr, 0, 0, nullptr, nullptr); }
        else { const int i = (int)id - 896, qb = i >> 3, h = i & 7, P0 = qb * 256;
            att::attn_unit<0>(F.lds + RING_OFF, F.P + (size_t)P0 * PP + C_QA + h * 128, PP, F.P + C_KA + (h >> 2) * 128, F.P + C_VA + (h >> 2) * 128, PP, nullptr,
                              F.P + (size_t)P0 * PP + C_ZA + h * 128, F.Y + (size_t)P0 * YW + h * 128, P0, A.sinks[layer * 8 + h] * LOG2E, F.BLUT + h * 128, 0, 0, nullptr, nullptr); }
    }
}
__global__ void __launch_bounds__(NWAVES * 64, 2) hybrid_fwd(Args args) {
    extern __shared__ __attribute__((aligned(16))) unsigned char lds[];
    Frame F;
    F.lds = (LAS unsigned char*)lds;
    volatile LAS unsigned* MISC = (volatile LAS unsigned*)(F.lds + MISC_OFF);
    F.G = gridDim.x; F.NGW = F.G * NWAVES;
    set_ptrs(F, args.ws);
    for (int u = threadIdx.x; u < (LDS_BYTES - LDSCTL_OFF) / 4; u += NWAVES * 64) ((LAS unsigned*)(F.lds + LDSCTL_OFF))[u] = 0u;
    __syncthreads();
    XcdBarrier bar; bar.bar = (unsigned*)(F.ctl + CW_BAR); bar.x = 0; bar.st = nullptr;
    if (!MK_PER_PHASE) bar = xcd_barrier_post((unsigned*)(F.ctl + CW_BAR), MISC + 8);
    const int lo = args.ph_lo, hi = args.ph_hi;
#define IN(k) (lo <= (k) && (k) < hi)
#define SEAM(k) do { if (IN(k) && IN((k) + 1)) xcd_barrier(bar); } while (0)

    { if (IN(0)) { set_ptrs(F, args.ws); p0_prologue(F, args); set_ptrs(F, args.ws); prep_rows<0>(F, args.x, F.XB, F.RS, nullptr, nullptr, F.XQ, F.SA); } }
    SEAM(0);
    { if (IN(1)) { set_ptrs(F, args.ws); p0b_gate_quant(F, args); } }
    SEAM(1);
    for (int l = 0; l < DEPTH; ++l) {
        const int pb = 2 + 6 * l;
        { if (IN(pb) && l > 0) { set_ptrs(F, args.ws); prep_q8(F, F.XB, F.SSQ_X + (l - 1) * S, F.ROWMAX + (l - 1) * S, F.RS, F.SA, F.XQ); } }
        if (l > 0) SEAM(pb);
        { if (IN(pb + 1)) { set_ptrs(F, args.ws);
            { pg8::Gemm g{F.XB, F.Win + (size_t)l * NB * DM, S, NB, DM, DM, DM}; pg8::StaticOrder So; So.init(S, NB, F.G, (int)blockIdx.x);
              EpiInProj E{F.P, F.RS, F.KRM, F.ROPEC, F.ROPES, F.SSQ_Q + l * S, F.SSQ_KV + l * S, true};
              pg8::gemm_phase<EpiInProj, pg8::StaticOrder, true, true>(F.lds + RING_OFF, g, So, E); }
            set_ptrs(F, args.ws);
            { pg8::Gemm g{(const bf16*)F.XQ, (const bf16*)(F.WG8 + (size_t)l * NG * DM), S, NG, DM / 2, DM / 2, DM / 2}; pg8::StaticOrder So; So.init(S, NG, F.G, (int)blockIdx.x);
              EpiGateI8 E{F.P, F.RS, F.SA, F.SB + l * NG, F.SSQ_Q + l * S, F.KRM, F.ROPEC, F.ROPES, F.GT, F.SSQ_KV + l * S};
              pg8::gemm_phase<EpiGateI8, pg8::StaticOrder, true, true>(F.lds + RING_OFF, g, So, E); }
        } }
        SEAM(pb + 1);
        { if (IN(pb + 2)) { set_ptrs(F, args.ws);
            { pg8::Gemm g{F.P + C_CQ, F.Wq + (size_t)l * 768 * 1024, S, 768, 1024, PP, 1024}; pg8::StaticOrder So; So.init(S, 768, F.G, (int)blockIdx.x);
              EpiQUp E{F.QM, F.SSQ_Q + l * S, F.ROPEC, F.ROPES};
              pg8::gemm_phase<EpiQUp, pg8::StaticOrder, true, true>(F.lds + RING_OFF, g, So, E); }
            set_ptrs(F, args.ws);
            { pg8::Gemm g{F.P + C_CKV, F.Wkv + (size_t)l * 1024 * 512, S, 1024, 512, PP, 512}; pg8::StaticOrder So; So.init(S, 1024, F.G, (int)blockIdx.x);
              EpiKvUp E{F.KVM, F.SSQ_KV + l * S};
              pg8::gemm_phase<EpiKvUp, pg8::StaticOrder, true, true>(F.lds + RING_OFF, g, So, E); }
        } }
        SEAM(pb + 2);
        { if (IN(pb + 3)) { set_ptrs(F, args.ws); attn_phase(F, args, l, 0); if (ATTN_MFMA_MASK != 7) { __syncthreads(); naive_attn_phase(F, args, l); } } }
        SEAM(pb + 3);
        { if (IN(pb + 4)) {
            { set_ptrs(F, args.ws); pg8::Gemm g{F.Y, F.Wproj + (size_t)l * DM * YW, S, DM, YW, YW, YW}; pg8::StaticOrder So; So.init(S, DM, F.G, (int)blockIdx.x);
              EpiProjFused E{F.GT, F.MBF, 16, 24}; pg8::gemm_phase<EpiProjFused, pg8::StaticOrder, true, true>(F.lds + RING_OFF, g, So, E); }
        } }
        SEAM(pb + 4);
        { if (IN(pb + 5)) { set_ptrs(F, args.ws);
            pg8::Gemm g{F.MBF, F.Wout + (size_t)l * DM * DM, S, DM, DM, DM, DM}; pg8::StaticOrder So; So.init(S, DM, F.G, (int)blockIdx.x);
            EpiOut E{(l == 0) ? args.x : F.X1, (l == 0) ? F.X1 : args.out, F.XB, F.SSQ_X + l * S, F.ROWMAX + l * S, false, true, l == DEPTH - 1, l > 0, l < DEPTH - 1};
            pg8::gemm_phase<EpiOut, pg8::StaticOrder, true, true>(F.lds + RING_OFF, g, So, E);
        } }
        SEAM(pb + 5);
    }
    if (IN(14)) { set_ptrs(F, args.ws); final_norm(F, F.XB, F.SSQ_X + (DEPTH - 1) * S, args.out, args.final_g); }
#undef IN
#undef SEAM
}

extern "C" void kernel_launch(void* const* d_in, const int* in_sizes, int n_in, void* d_out, int out_size, void* d_ws, size_t ws_size, hipStream_t stream) {
    static int grid = 0;
    if (grid == 0) {
        if (n_in != 14 || in_sizes[0] != S * DM || out_size != S * DM || ws_size < WS_END) { fprintf(stderr, "kernel_launch: unexpected shapes (n_in %d, in0 %d, out %d, ws %zu)\n", n_in, n_in > 0 ? in_sizes[0] : -1, out_size, ws_size); grid = -1; return; }
        int dev = 0, cus = 0, per_cu = 0;
        if (hipGetDevice(&dev) != hipSuccess || hipDeviceGetAttribute(&cus, hipDeviceAttributeMultiprocessorCount, dev) != hipSuccess) { grid = -1; return; }
        if (hipFuncSetAttribute((const void*)hybrid_fwd, hipFuncAttributeMaxDynamicSharedMemorySize, LDS_BYTES) != hipSuccess) { fprintf(stderr, "kernel_launch: hipFuncSetAttribute failed\n"); grid = -1; return; }
        if (hipOccupancyMaxActiveBlocksPerMultiprocessor(&per_cu, (const void*)hybrid_fwd, NWAVES * 64, LDS_BYTES) != hipSuccess || per_cu < 1)
            fprintf(stderr, "kernel_launch: occupancy query reports %d workgroups per CU\n", per_cu);
        (void)hipGetLastError();
        grid = cus;
    }
    if (grid < 0) return;
    if (hipMemsetAsync((char*)d_ws + WS_CTL, 0, CTL_ZERO_BYTES, stream) != hipSuccess) { fprintf(stderr, "kernel_launch: memset failed\n"); return; }
    Args a{};
    a.x = (const float*)d_in[0]; a.norm_g = (const float*)d_in[1]; a.w_in = (const float*)d_in[2]; a.sinks = (const float*)d_in[3]; a.rel_bias = (const float*)d_in[4];
    a.g_q = (const float*)d_in[5]; a.w_q_up = (const float*)d_in[6]; a.g_kv = (const float*)d_in[7]; a.w_kv_up = (const float*)d_in[8];
    a.w_pa = (const float*)d_in[9]; a.w_pb = (const float*)d_in[10]; a.w_pc = (const float*)d_in[11]; a.w_out = (const float*)d_in[12]; a.final_g = (const float*)d_in[13];
    a.out = (float*)d_out; a.ws = (unsigned char*)d_ws;
    constexpr int NPH = 15;
    if (MK_PER_PHASE) {
        for (int p = 0; p < NPH; ++p) { a.ph_lo = p; a.ph_hi = p + 1; hipLaunchKernelGGL(hybrid_fwd, dim3(grid), dim3(NWAVES * 64), LDS_BYTES, stream, a); }
    } else {
        a.ph_lo = 0; a.ph_hi = NPH;
        hipLaunchKernelGGL(hybrid_fwd, dim3(grid), dim3(NWAVES * 64), LDS_BYTES, stream, a);
    }
    const hipError_t le = hipPeekAtLastError();
    if (le != hipSuccess) fprintf(stderr, "kernel_launch: launch failed: %s\n", hipGetErrorName(le));
}
```

```cpp
#include <hip/hip_runtime.h>
#include <cstdio>
#include <cstdint>

#ifndef MK_PER_PHASE
#define MK_PER_PHASE 0
#endif
#ifndef ATTN_MFMA_MASK
#define ATTN_MFMA_MASK 7
#endif

namespace pg8 {
#define PG8_LAS __attribute__((address_space(3)))
typedef unsigned short bf16_t;
typedef short bf16x8 __attribute__((ext_vector_type(8)));
typedef float f32x4 __attribute__((ext_vector_type(4)));
typedef float f32x2 __attribute__((ext_vector_type(2)));
typedef unsigned u32x4 __attribute__((ext_vector_type(4)));
typedef unsigned u32x2 __attribute__((ext_vector_type(2)));
typedef int i32x4 __attribute__((ext_vector_type(4)));
constexpr int BM = 256, BK = 64, HALF = 128, HTB = HALF * BK * 2, STAGE_BYTES = 8 * HTB, NXCD = 8, WGM = 8;

__host__ __device__ __forceinline__ int lds_byte(int r, int c) { const int st = (r >> 4) * 2 + (c >> 5), rr = r & 15, cc = c & 31, ob = rr * 64 + cc * 2; return st * 1024 + (ob ^ (((ob >> 9) & 1) << 5)); }
__host__ __device__ __forceinline__ void stage_rc(int b, int& R, int& C) { const int st = b / 1024, sb = b % 1024, swz = sb ^ (((sb >> 9) & 1) << 5); R = (st >> 1) * 16 + swz / 64; C = (st & 1) * 32 + (swz % 64) / 2; }
__host__ __device__ __forceinline__ int perm32(int rho) { const int n = rho >> 4, i = rho & 15; return 8 * (i >> 2) + 4 * n + (i & 3); }

struct Unit { int pm, pn; };
struct Gemm { const bf16_t* A; const bf16_t* Bt; int M, N, K, lda, ldb; };

struct StaticOrder {
    int nM, nN, nwg, G, c;
    __host__ __device__ void init(int M, int N, int G_, int c_) { nM = M / BM; nN = N / BM; nwg = nM * nN; G = G_; c = c_; }
    __host__ __device__ bool next(int i, Unit& u) const {
        const long L = (long)i * G + c; if (L >= nwg) return false;
        int wgid = (int)L; { const int q = nwg / NXCD, r = nwg % NXCD, xcd = wgid % NXCD, off = wgid / NXCD; wgid = (xcd < r ? xcd * (q + 1) : r * (q + 1) + (xcd - r) * q) + off; }
        const int nig = WGM * nN, gid = wgid / nig, fm = gid * WGM, gsz = (nM - fm) < WGM ? (nM - fm) : WGM;
        u.pm = fm + ((wgid % nig) % gsz); u.pn = (wgid % nig) / gsz; return true;
    }
    __device__ __forceinline__ void a_ready(const Unit&) const {}
    __device__ __forceinline__ void done(const Unit&) const {}
};

__device__ __forceinline__ unsigned cvt_pk_bf16(float lo, float hi) { unsigned r; asm volatile("v_cvt_pk_bf16_f32 %0, %1, %2" : "=v"(r) : "v"(lo), "v"(hi)); return r; }
__device__ __forceinline__ unsigned cvt_pk_f16(float lo, float hi) { typedef _Float16 h2 __attribute__((ext_vector_type(2))); h2 v; v.x = (_Float16)lo; v.y = (_Float16)hi; return __builtin_bit_cast(unsigned, v); }
__device__ __forceinline__ float bf_lo(unsigned w) { return __uint_as_float(w << 16); }
__device__ __forceinline__ float bf_hi(unsigned w) { return __uint_as_float(w & 0xffff0000u); }

__device__ __forceinline__ f32x4 mma16(bf16x8 b, bf16x8 a, f32x4 c) { return __builtin_amdgcn_mfma_f32_16x16x32_bf16(b, a, c, 0, 0, 0); }
__device__ __forceinline__ i32x4 mma16(bf16x8 b, bf16x8 a, i32x4 c) { return __builtin_amdgcn_mfma_i32_16x16x64_i8(__builtin_bit_cast(i32x4, b), __builtin_bit_cast(i32x4, a), c, 0, 0, 0); }
template <class Epi, class Sched, bool ALIGN_EPI = false, bool SP2 = false>
__device__ __forceinline__ void gemm_phase(PG8_LAS unsigned char* lds, const Gemm g, const Sched& S, const Epi& E) {
    int tid = threadIdx.x; asm volatile("" : "+v"(tid));
    const int wid = __builtin_amdgcn_readfirstlane(tid >> 6), lane = tid & 63, wr = wid >> 2, wc = wid & 3, fr = lane & 15, fq = lane >> 4;
    const int K = g.K, nt = K / BK;
    unsigned voffA[2], voffB[2];
#pragma unroll
    for (int i = 0; i < 2; ++i) { int R, C; stage_rc(tid * 16 + i * 8192, R, C); const int Rb = Epi::PERM ? ((R & ~31) + perm32(R & 31)) : R;
        voffA[i] = (unsigned)(R * g.lda + C) * 2u; voffB[i] = (unsigned)(Rb * g.ldb + C) * 2u; }
    const size_t kstep = (size_t)(BK * 2);
    const size_t hstepA = (size_t)HALF * g.lda * 2, hstepB = (size_t)HALF * g.ldb * 2;
    const size_t tstepA = 2 * hstepA, tstepB = 2 * hstepB;
    const unsigned ldsw = (unsigned)wid * 1024u;
    const int aoff = lds_byte(wr * 64 + fr, fq * 8), boff = lds_byte(wc * 32 + fr, fq * 8);
#define PG8_SA(b, h) (((b) * 2 + (h)) * HTB)
#define PG8_SB(b, h) ((4 + (b) * 2 + (h)) * HTB)
#define PG8_STAGE(bufoff, gbase, voff) do { _Pragma("unroll") for (int _i = 0; _i < 2; ++_i) \
        __builtin_amdgcn_global_load_lds((const unsigned*)((const char*)(gbase) + (voff)[_i]), (PG8_LAS unsigned*)(lds + (bufoff) + ldsw + _i * 8192), 16, 0, 0); } while (0)
#define PG8_LDA(dst, b, h) do { _Pragma("unroll") for (int m = 0; m < 4; ++m) _Pragma("unroll") for (int k = 0; k < 2; ++k) dst[m][k] = *(const PG8_LAS bf16x8*)(lds + PG8_SA(b, h) + aoff + m * 2048 + k * 1024); } while (0)
#define PG8_LDB(dst, b, h) do { _Pragma("unroll") for (int n = 0; n < 2; ++n) _Pragma("unroll") for (int k = 0; k < 2; ++k) dst[n][k] = *(const PG8_LAS bf16x8*)(lds + PG8_SB(b, h) + boff + n * 2048 + k * 1024); } while (0)
#define PG8_MMA(ai, bj, At, Bt) do { __builtin_amdgcn_s_setprio(1); _Pragma("unroll") for (int m = 0; m < 4; ++m) _Pragma("unroll") for (int n = 0; n < 2; ++n) _Pragma("unroll") for (int k = 0; k < 2; ++k) \
        acc[ai][bj][m][n] = mma16(Bt[n][k], At[m][k], acc[ai][bj][m][n]); __builtin_amdgcn_s_setprio(0); } while (0)
#define PG8_WAIT_V(n) asm volatile("s_waitcnt vmcnt(" #n ")" ::: "memory")
#define PG8_WAIT_L(n) asm volatile("s_waitcnt lgkmcnt(" #n ")" ::: "memory")
#define PG8_BAR __builtin_amdgcn_s_barrier()
#define PG8_SCHED __builtin_amdgcn_sched_barrier(0)
    Unit cur, nxt; int ui = 0;
    if (!S.next(0, cur)) return;
    typedef typename Epi::acc_t acc_t;
    acc_t acc[2][2][4][2];
#pragma unroll
    for (int a = 0; a < 2; ++a)
#pragma unroll
        for (int b = 0; b < 2; ++b)
#pragma unroll
            for (int m = 0; m < 4; ++m)
#pragma unroll
                for (int n = 0; n < 2; ++n) acc[a][b][m][n] = (acc_t){0, 0, 0, 0};
    bf16x8 At[4][2], B0[2][2], B1[2][2];
    const char* cA = (const char*)g.A + (size_t)cur.pm * tstepA; const char* cB = (const char*)g.Bt + (size_t)cur.pn * tstepB;
    S.a_ready(cur);
    if constexpr (SP2) {
        PG8_STAGE(PG8_SB(0, 0), cB, voffB); PG8_STAGE(PG8_SB(0, 1), cB + hstepB, voffB); PG8_STAGE(PG8_SA(0, 0), cA, voffA); PG8_STAGE(PG8_SA(0, 1), cA + hstepA, voffA);
        if (wr == 1) PG8_BAR;
        PG8_WAIT_V(2); PG8_BAR;
        PG8_STAGE(PG8_SB(1, 0), cB + kstep, voffB); PG8_STAGE(PG8_SA(1, 0), cA + kstep, voffA); PG8_STAGE(PG8_SB(1, 1), cB + hstepB + kstep, voffB);
        PG8_WAIT_V(6); PG8_BAR;
    } else {
        PG8_STAGE(PG8_SB(0, 0), cB, voffB); PG8_STAGE(PG8_SA(0, 0), cA, voffA); PG8_STAGE(PG8_SB(0, 1), cB + hstepB, voffB); PG8_STAGE(PG8_SA(0, 1), cA + hstepA, voffA);
        if (wr == 1) PG8_BAR;
        PG8_WAIT_V(4); PG8_BAR;
        PG8_STAGE(PG8_SB(1, 0), cB + kstep, voffB); PG8_STAGE(PG8_SA(1, 0), cA + kstep, voffA); PG8_STAGE(PG8_SB(1, 1), cB + hstepB + kstep, voffB);
        PG8_WAIT_V(6); PG8_BAR;
    }
    for (;;) {
        const bool has_next = S.next(ui + 1, nxt);
        const char* nA = has_next ? (const char*)g.A + (size_t)nxt.pm * tstepA : cA; const char* nB = has_next ? (const char*)g.Bt + (size_t)nxt.pn * tstepB : cB;
        for (int t = 0; t < nt; t += 2) {
            const bool last = (t == nt - 2);
            const char* a1 = cA + (size_t)(t + 1) * kstep;
            const char* a2 = last ? nA : cA + (size_t)(t + 2) * kstep; const char* b2 = last ? nB : cB + (size_t)(t + 2) * kstep;
            const char* a3 = a2 + kstep; const char* b3 = b2 + kstep;
            if (last && has_next) S.a_ready(nxt);
            if constexpr (Epi::MID) { if (t == E.t1 || t == E.t2) E.mid(acc, cur, t == E.t2, wr, wc, fr, fq); }
            if constexpr (SP2) {
            PG8_LDB(B0, 0, 0); PG8_LDB(B1, 0, 1); PG8_SCHED; PG8_LDA(At, 0, 0); PG8_STAGE(PG8_SA(1, 1), a1 + hstepA, voffA);
            PG8_WAIT_V(8); PG8_WAIT_L(0); PG8_BAR; PG8_MMA(0, 0, At, B0); PG8_MMA(0, 1, At, B1); PG8_BAR; PG8_SCHED;
            PG8_LDA(At, 0, 1); PG8_STAGE(PG8_SB(0, 0), b2, voffB); PG8_STAGE(PG8_SB(0, 1), b2 + hstepB, voffB); PG8_STAGE(PG8_SA(0, 0), a2, voffA);
            PG8_WAIT_V(8); PG8_WAIT_L(0); PG8_BAR; PG8_MMA(1, 0, At, B0); PG8_MMA(1, 1, At, B1); PG8_BAR; PG8_SCHED;
            PG8_LDB(B0, 1, 0); PG8_LDB(B1, 1, 1); PG8_SCHED; PG8_LDA(At, 1, 0); PG8_STAGE(PG8_SA(0, 1), a2 + hstepA, voffA);
            PG8_WAIT_V(8); PG8_WAIT_L(0); PG8_BAR; PG8_MMA(0, 0, At, B0); PG8_MMA(0, 1, At, B1); PG8_BAR; PG8_SCHED;
            PG8_LDA(At, 1, 1); PG8_STAGE(PG8_SB(1, 0), b3, voffB); PG8_STAGE(PG8_SB(1, 1), b3 + hstepB, voffB); PG8_STAGE(PG8_SA(1, 0), a3, voffA);
            PG8_WAIT_V(8); PG8_WAIT_L(0); PG8_BAR; PG8_MMA(1, 0, At, B0); PG8_MMA(1, 1, At, B1); PG8_BAR; PG8_SCHED;
            } else {
            PG8_LDB(B0, 0, 0); PG8_SCHED; PG8_LDA(At, 0, 0); PG8_STAGE(PG8_SA(1, 1), a1 + hstepA, voffA);
            PG8_WAIT_L(8); PG8_BAR; PG8_WAIT_L(0); PG8_MMA(0, 0, At, B0); PG8_BAR; PG8_SCHED;
            PG8_LDB(B1, 0, 1); PG8_STAGE(PG8_SB(0, 0), b2, voffB);
            PG8_BAR; PG8_WAIT_L(0); PG8_MMA(0, 1, At, B1); PG8_BAR;
            PG8_LDA(At, 0, 1); PG8_STAGE(PG8_SA(0, 0), a2, voffA);
            PG8_BAR; PG8_WAIT_L(0); PG8_MMA(1, 0, At, B0); PG8_BAR; PG8_SCHED;
            PG8_STAGE(PG8_SB(0, 1), b2 + hstepB, voffB);
            PG8_WAIT_V(6); PG8_BAR; PG8_MMA(1, 1, At, B1); PG8_BAR;
            PG8_LDB(B0, 1, 0); PG8_SCHED; PG8_LDA(At, 1, 0); PG8_STAGE(PG8_SA(0, 1), a2 + hstepA, voffA);
            PG8_WAIT_L(8); PG8_BAR; PG8_WAIT_L(0); PG8_MMA(0, 0, At, B0); PG8_BAR; PG8_SCHED;
            PG8_LDB(B1, 1, 1); PG8_STAGE(PG8_SB(1, 0), b3, voffB);
            PG8_BAR; PG8_WAIT_L(0); PG8_MMA(0, 1, At, B1); PG8_BAR;
            PG8_LDA(At, 1, 1); PG8_STAGE(PG8_SA(1, 0), a3, voffA);
            PG8_BAR; PG8_WAIT_L(0); PG8_MMA(1, 0, At, B0); PG8_BAR; PG8_SCHED;
            PG8_STAGE(PG8_SB(1, 1), b3 + hstepB, voffB);
            PG8_WAIT_V(6); PG8_BAR; PG8_MMA(1, 1, At, B1); PG8_BAR;
            }
        }
        if constexpr (ALIGN_EPI) { if (wr == 0) PG8_BAR; }
        E(acc, cur, wr, wc, fr, fq); S.done(cur);
        if (!has_next) break;
#pragma unroll
        for (int a = 0; a < 2; ++a)
#pragma unroll
            for (int b = 0; b < 2; ++b)
#pragma unroll
                for (int m = 0; m < 4; ++m)
#pragma unroll
                    for (int n = 0; n < 2; ++n) acc[a][b][m][n] = (acc_t){0, 0, 0, 0};
        cur = nxt; cA = nA; cB = nB; ++ui;
        if constexpr (ALIGN_EPI) { if (wr == 1) PG8_BAR; }
    }
    PG8_WAIT_V(0);
    if constexpr (!ALIGN_EPI) { if (wr == 0) PG8_BAR; }
    PG8_BAR;
#undef PG8_SA
#undef PG8_SB
#undef PG8_STAGE
#undef PG8_LDA
#undef PG8_LDB
#undef PG8_MMA
#undef PG8_WAIT_V
#undef PG8_WAIT_L
#undef PG8_BAR
#undef PG8_SCHED
}
}

constexpr int NWAVES = 8;
constexpr int S = 16384, DM = 4096, DEPTH = 2;
constexpr int PP = 6656;
constexpr int NP = 19200;
constexpr int IN_COLS = 19008;
constexpr int NB = 2048;
constexpr int NG = 17152;
__host__ __device__ constexpr int bf_tile_col(int t) { return t < 2 ? 4096 + 256 * t : 5120 + 256 * (t - 2); }
constexpr int C_QA = 0, C_KA = 1024, C_VA = 1280, C_ZA = 1536, C_CQ = 2560, C_CKV = 3584, C_ZB = 4096, C_QC = 4608, C_KC = 5120, C_VC = 5632, C_ZC = 6144,
              C_GA = 6656, C_GB = 10752, C_GC = 14848, C_KR = 18944;
constexpr float EPS = 1e-6f;
constexpr float LOG2E = 1.4426950408889634f;
constexpr float SC128 = 0.08838834764831845f * LOG2E;
constexpr float SC192 = 0.07216878364870322f * LOG2E;
constexpr int YW = 2048;

constexpr size_t MiB = 1u << 20;
constexpr size_t WS_CTL = 0, CTL_ZERO_BYTES = 1 * MiB;
constexpr size_t WS_RS = 1 * MiB;
constexpr size_t WS_RSQ = WS_RS + 65536, WS_RSKV = WS_RSQ + 65536;
constexpr size_t WS_ROPEC = 2 * MiB, WS_ROPES = 4 * MiB;
constexpr size_t WS_WQ = 6 * MiB;
constexpr size_t WS_WKV = 10 * MiB;
constexpr size_t WS_WPROJ = 16 * MiB;
constexpr size_t WS_WOUT = 48 * MiB;
constexpr size_t WS_WIN = 112 * MiB;
constexpr size_t WS_WG8 = 210 * MiB;
constexpr size_t WS_XQ = 344 * MiB;
constexpr size_t WS_SA = WS_RS + 3 * 65536;
constexpr size_t WS_SB = WS_RS + 4 * 65536;
constexpr size_t WS_XB = 416 * MiB;
constexpr size_t WS_P = 544 * MiB;
constexpr size_t WS_GT = 752 * MiB;
constexpr size_t WS_QM = 1144 * MiB;
constexpr size_t WS_KVM = 1168 * MiB;
constexpr size_t WS_KRM = 1200 * MiB;
constexpr size_t WS_Y = 1204 * MiB;
constexpr size_t WS_MBF = 1524 * MiB;
constexpr size_t WS_X1 = 1652 * MiB;
constexpr size_t WS_OPART = 1908 * MiB;
constexpr size_t WS_ML = 2036 * MiB;
constexpr size_t WS_END = 2040 * MiB;
static_assert(WS_WIN + (size_t)2 * NB * DM * 2 <= WS_WG8 && WS_WG8 + (size_t)2 * NG * DM <= WS_XQ && WS_XQ + (size_t)S * DM <= WS_XB && WS_P + (size_t)S * PP * 2 <= WS_GT && WS_GT + (size_t)3 * S * DM * 2 <= WS_QM && WS_SB + 2 * NG * 4 <= WS_ROPEC, "ws map");
constexpr int CW_TMO = 0, CW_CODE = 1;
constexpr int CW_BAR = 4096;
constexpr int CW_MLACNT = 20480;
constexpr int CW_QUEUE = 16384;
constexpr size_t CTL_COLMAX = 640 * 1024;
constexpr size_t CTL_BLUT = 904 * 1024;
constexpr size_t CTL_ROWMAX = 776 * 1024;
constexpr size_t CTL_SSQ_Q = 256 * 1024, CTL_SSQ_KV = 384 * 1024, CTL_SSQ_X = 512 * 1024;

constexpr int RING_OFF = 0, RING_BYTES = 131072;
constexpr int LDSCTL_OFF = RING_BYTES, MISC_OFF = LDSCTL_OFF + 320;
constexpr int LDS_BYTES = 147456;

#define GAS __attribute__((address_space(1)))
#define LAS __attribute__((address_space(3)))
typedef unsigned short bf16;
typedef unsigned v4u __attribute__((ext_vector_type(4)));
typedef unsigned v2u __attribute__((ext_vector_type(2)));
typedef float f32x4 __attribute__((ext_vector_type(4)));
typedef float f32x2 __attribute__((ext_vector_type(2)));
typedef short bf16x8 __attribute__((ext_vector_type(8)));
typedef GAS unsigned gu32;
#define RLX_AGENT __ATOMIC_RELAXED, __HIP_MEMORY_SCOPE_AGENT
#define LDS_WAIT() asm volatile("s_waitcnt lgkmcnt(0)" ::: "memory")
#define VM_WAIT() asm volatile("s_waitcnt vmcnt(0)" ::: "memory")
__device__ __forceinline__ unsigned f2bf(float f) { unsigned u = __builtin_bit_cast(unsigned, f); return (u + 0x7fffu + ((u >> 16) & 1u)) >> 16; }
__device__ __forceinline__ unsigned pk2(float lo, float hi) { return f2bf(lo) | (f2bf(hi) << 16); }
__device__ __forceinline__ float bf2f(unsigned short b) { return __uint_as_float(((unsigned)b) << 16); }

#define XB_TMO      128
#define XB_XCNT(j)  (256  + 64 * (j))
#define XB_XSUB(j)  (1280 + 64 * (j))
#define XB_XGEN(j)  (2304 + 64 * (j))
#define XB_TOP      3328
#define XB_TOPGEN   3392
#define XCD_BAR_WORDS 3456
#define XB_SPIN_CAP (1u << 18)
__device__ __forceinline__ unsigned xb_ld(unsigned* p)              { return __hip_atomic_load(p, __ATOMIC_RELAXED, __HIP_MEMORY_SCOPE_AGENT); }
__device__ __forceinline__ unsigned xb_add(unsigned* p, unsigned v) { return __hip_atomic_fetch_add(p, v, __ATOMIC_RELAXED, __HIP_MEMORY_SCOPE_AGENT); }
__device__ __forceinline__ unsigned xb_xcc_id() { return (unsigned)__builtin_amdgcn_s_getreg((3 << 11) | 20) & 0xFu; }
#define XB_SPIN(cond, bar) do { unsigned _sp = 0; while (cond) { __builtin_amdgcn_s_sleep(1); \
    if ((++_sp & 255u) == 0u) { if (xb_ld(&(bar)[XB_TMO])) break; if (_sp > XB_SPIN_CAP) { atomicAdd(&(bar)[XB_TMO], 1u); break; } } } } while (0)
struct XcdBarrier { unsigned* bar; unsigned x; volatile LAS unsigned* st; };
__device__ __forceinline__ XcdBarrier xcd_barrier_post(unsigned* bar, volatile LAS unsigned* st) {
    XcdBarrier b; b.bar = bar; b.x = xb_xcc_id(); b.st = st;
    if (threadIdx.x == 0) (void)xb_add(&bar[XB_XCNT(b.x)], 1u);
    return b;
}
__device__ __forceinline__ void xcd_barrier_complete(unsigned* bar, unsigned x, unsigned& nloc, unsigned& nx) {
    const unsigned G = gridDim.x * gridDim.y * gridDim.z;
    unsigned sum, cnt, mine, sp = 0u;
    for (;;) {
        sum = 0u; cnt = 0u; mine = 0u;
#pragma unroll
        for (unsigned j = 0; j < 16; ++j) { const unsigned c = xb_ld(&bar[XB_XCNT(j)]); sum += c; cnt += (c > 0u) ? 1u : 0u; mine = (j == x) ? c : mine; }
        if (sum == G) break;
        __builtin_amdgcn_s_sleep(1);
        if ((++sp & 255u) == 0u) { if (xb_ld(&bar[XB_TMO])) break; if (sp > XB_SPIN_CAP) { atomicAdd(&bar[XB_TMO], 1u); break; } }
    }
    nloc = mine > 0u ? mine : 1u; nx = cnt > 0u ? cnt : 1u;
}
__device__ __forceinline__ void xcd_barrier(const XcdBarrier& b) {
    asm volatile("s_waitcnt vmcnt(0)" ::: "memory");
    __syncthreads();
    if (threadIdx.x == 0) {
        unsigned* bar = b.bar;
        __builtin_amdgcn_s_waitcnt(0);
        unsigned nloc = b.st[0], nx = b.st[1];
        if (nloc == 0u) { xcd_barrier_complete(bar, b.x, nloc, nx); b.st[0] = nloc; b.st[1] = nx; }
        const unsigned old = xb_add(&bar[XB_XSUB(b.x)], 1u);
        const unsigned gen = old / nloc;
        if (old + 1u == (gen + 1u) * nloc) {
            __builtin_amdgcn_fence(__ATOMIC_RELEASE, "agent");
            asm volatile("s_waitcnt vmcnt(0)" ::: "memory");
            const unsigned og = xb_add(&bar[XB_TOP], 1u);
            const unsigned tg = og / nx;
            if (og + 1u == (tg + 1u) * nx) xb_add(&bar[XB_TOPGEN], 1u);
            else XB_SPIN(xb_ld(&bar[XB_TOPGEN]) == tg, bar);
            __builtin_amdgcn_fence(__ATOMIC_ACQUIRE, "agent");
            xb_add(&bar[XB_XGEN(b.x)], 1u);
            asm volatile("s_waitcnt vmcnt(0)" ::: "memory");
        } else {
            XB_SPIN(xb_ld(&bar[XB_XGEN(b.x)]) == gen, bar);
            __builtin_amdgcn_fence(__ATOMIC_ACQUIRE, "agent");
            asm volatile("s_waitcnt vmcnt(0)" ::: "memory");
        }
    }
    __syncthreads();
}

struct Args {
    const float* x; const float* norm_g; const float* w_in; const float* sinks; const float* rel_bias; const float* g_q; const float* w_q_up; const float* g_kv; const float* w_kv_up;
    const float* w_pa; const float* w_pb; const float* w_pc; const float* w_out; const float* final_g;
    float* out; unsigned char* ws; int ph_lo, ph_hi;
};
struct Frame {
    LAS unsigned char* lds;
    gu32* ctl;
    int tid, lane, wave, G, gw, NGW;
    bf16 *Win, *Wout, *Wproj, *Wq, *Wkv, *XB, *P, *QM, *KVM, *KRM, *Y, *MBF; unsigned char* GT; signed char *WG8, *XQ; float *SA, *SB; unsigned* COLMAX;
    float *RS, *RSQ, *RSKV, *ROPEC, *ROPES, *X1, *OPART, *ML, *SSQ_Q, *SSQ_KV, *SSQ_X, *BLUT; unsigned* ROWMAX;
};
__device__ __forceinline__ void set_ptrs(Frame& F, unsigned char* ws_) {
    GAS unsigned char* wsg = (GAS unsigned char*)ws_; asm volatile("" : "+s"(wsg)); unsigned char* ws = (unsigned char*)wsg;
    { int t = threadIdx.x; asm volatile("" : "+v"(t)); F.tid = t; F.lane = t & 63; F.wave = __builtin_amdgcn_readfirstlane(t >> 6); F.gw = blockIdx.x * NWAVES + F.wave; }
    F.ctl = (gu32*)(ws + WS_CTL);
    F.Win = (bf16*)(ws + WS_WIN); F.Wout = (bf16*)(ws + WS_WOUT); F.Wproj = (bf16*)(ws + WS_WPROJ); F.Wq = (bf16*)(ws + WS_WQ); F.Wkv = (bf16*)(ws + WS_WKV);
    F.XB = (bf16*)(ws + WS_XB); F.P = (bf16*)(ws + WS_P); F.QM = (bf16*)(ws + WS_QM); F.KVM = (bf16*)(ws + WS_KVM); F.KRM = (bf16*)(ws + WS_KRM); F.Y = (bf16*)(ws + WS_Y); F.MBF = (bf16*)(ws + WS_MBF); F.GT = ws + WS_GT;
    F.RS = (float*)(ws + WS_RS); F.RSQ = (float*)(ws + WS_RSQ); F.RSKV = (float*)(ws + WS_RSKV); F.ROPEC = (float*)(ws + WS_ROPEC); F.ROPES = (float*)(ws + WS_ROPES);
    F.X1 = (float*)(ws + WS_X1); F.OPART = (float*)(ws + WS_OPART); F.ML = (float*)(ws + WS_ML);
    F.WG8 = (signed char*)(ws + WS_WG8); F.XQ = (signed char*)(ws + WS_XQ); F.SA = (float*)(ws + WS_SA); F.SB = (float*)(ws + WS_SB); F.COLMAX = (unsigned*)(ws + WS_CTL + CTL_COLMAX);
    F.SSQ_Q = (float*)(ws + WS_CTL + CTL_SSQ_Q); F.SSQ_KV = (float*)(ws + WS_CTL + CTL_SSQ_KV); F.SSQ_X = (float*)(ws + WS_CTL + CTL_SSQ_X); F.ROWMAX = (unsigned*)(ws + WS_CTL + CTL_ROWMAX); F.BLUT = (float*)(ws + WS_CTL + CTL_BLUT);
}
__device__ __forceinline__ float wave_sum(float v) {
#pragma unroll
    for (int o = 1; o < 64; o <<= 1) v += __shfl_xor(v, o);
    return v;
}
__device__ __forceinline__ float wave_max(float v) {
#pragma unroll
    for (int o = 1; o < 64; o <<= 1) v = fmaxf(v, __shfl_xor(v, o));
    return v;
}

__device__ const unsigned char T5B[128] = {0, 1, 2, 3, 4, 5, 6, 7, 8, 9, 10, 11, 12, 13, 14, 15, 16, 16, 16, 17, 17, 18, 18, 18, 19, 19, 19, 20, 20, 20, 20, 21, 21, 21, 21, 22, 22, 22, 22, 22, 23, 23, 23, 23, 23, 23, 24, 24, 24, 24, 24, 24, 25, 25, 25, 25, 25, 25, 25, 26, 26, 26, 26, 26, 26, 26, 26, 27, 27, 27, 27, 27, 27, 27, 27, 27, 27, 28, 28, 28, 28, 28, 28, 28, 28, 28, 28, 29, 29, 29, 29, 29, 29, 29, 29, 29, 29, 29, 29, 30, 30, 30, 30, 30, 30, 30, 30, 30, 30, 30, 30, 30, 30, 31, 31, 31, 31, 31, 31, 31, 31, 31, 31, 31, 31, 31, 31, 31};

__device__ const float ROPE_INV[32] = {1.000000000e+00f, 7.498942614e-01f, 5.623413324e-01f, 4.216965139e-01f, 3.162277639e-01f, 2.371373773e-01f, 1.778279394e-01f, 1.333521307e-01f, 1.000000015e-01f, 7.498941571e-02f, 5.623413250e-02f, 4.216965288e-02f, 3.162277490e-02f, 2.371373773e-02f, 1.778279431e-02f, 1.333521493e-02f, 9.999999776e-03f, 7.498941850e-03f, 5.623413250e-03f, 4.216964822e-03f, 3.162277630e-03f, 2.371373586e-03f, 1.778279431e-03f, 1.333521446e-03f, 1.000000047e-03f, 7.498942432e-04f, 5.623413017e-04f, 4.216965172e-04f, 3.162277571e-04f, 2.371373703e-04f, 1.778279402e-04f, 1.333521504e-04f};
template <int MAP> __device__ __forceinline__ int src_col(int n) {
    if (MAP == 1) { const int pc = bf_tile_col(n >> 8) + (n & 255); return pc < 4096 ? pc : pc + 64; }
    if (MAP == 3) {
        if (n < 12288) return 6720 + n; if (n < 13312) return n - 12288; if (n < 14336) return 2560 + (n - 13312); if (n < 14592) return 1024 + (n - 14336); if (n < 15104) return 4672 + (n - 14592);
        if (n >= 16640) return 3584 + (n - 16640);
        if (n >= 16384) return 1280 + (n - 16384);
        if (n >= 15360) return 1536 + (n - 15360);
        const int r = n - 15104; return r < 64 ? 4096 + ((r & 1) ? 32 + (r >> 1) : (r >> 1)) : -1; }
    if (MAP == 2) { const int h = n / 192, c = n % 192; if (c < 128) return n; const int j = c - 128; return h * 192 + 128 + ((j & 1) ? 32 + (j >> 1) : (j >> 1)); }
    return n;
}
template <int MAP>
__device__ __forceinline__ void conv_item(const float* W, int Nsrc, const float* g, bf16* WT, int ldd, int dk0, int nblk, LAS float* scr, int item, int lane) {
    const int kb = item / nblk, nb = item % nblk, k0 = 64 * kb, n0 = 32 * nb;
    const int sc = src_col<MAP>(n0 + (lane & 31));
    const GAS float* wp = (const GAS float*)W + (size_t)(k0 + (lane >> 5)) * Nsrc + (sc >= 0 ? sc : 0);
    float v[32];
#pragma unroll
    for (int i = 0; i < 32; ++i) v[i] = __builtin_nontemporal_load(wp + (size_t)(2 * i) * Nsrc);
    const int c = lane & 7;
    f32x4 g0 = {1.f, 1.f, 1.f, 1.f}, g1 = {1.f, 1.f, 1.f, 1.f};
    if (g) { g0 = *(const GAS f32x4*)(g + k0 + 8 * c); g1 = *(const GAS f32x4*)(g + k0 + 8 * c + 4); }
#pragma unroll
    for (int i = 0; i < 32; ++i) scr[(2 * i + (lane >> 5)) * 33 + (lane & 31)] = (sc >= 0) ? v[i] : 0.f;
    LDS_WAIT(); asm volatile("" ::: "memory");
#pragma unroll
    for (int j = 0; j < 4; ++j) { const int n = (lane >> 3) + 8 * j; const LAS float* s = scr + (8 * c) * 33 + n;
        v4u o; o.x = pk2(s[0 * 33] * g0[0], s[1 * 33] * g0[1]); o.y = pk2(s[2 * 33] * g0[2], s[3 * 33] * g0[3]); o.z = pk2(s[4 * 33] * g1[0], s[5 * 33] * g1[1]); o.w = pk2(s[6 * 33] * g1[2], s[7 * 33] * g1[3]);
        *(GAS v4u*)(WT + (size_t)(n0 + n) * ldd + dk0 + k0 + 8 * c) = o; }
    LDS_WAIT(); asm volatile("" ::: "memory");
}
__device__ __forceinline__ void gate_max_item(const float* W, const float* g, unsigned* colmax, int item, int lane) {
    const int kb = item / (NG / 32), nb = item % (NG / 32), k0 = 64 * kb, n0 = 32 * nb;
    const int sc = src_col<3>(n0 + (lane & 31));
    const GAS float* wp = (const GAS float*)W + (size_t)(k0 + (lane >> 5)) * IN_COLS + (sc >= 0 ? sc : 0);
    float v[32];
#pragma unroll
    for (int i = 0; i < 32; ++i) v[i] = __builtin_nontemporal_load(wp + (size_t)(2 * i) * IN_COLS);
    if (sc < 0) {
#pragma unroll
        for (int i = 0; i < 32; ++i) v[i] = 0.f; }
    float m = 0.f;
#pragma unroll
    for (int i = 0; i < 32; ++i) m = fmaxf(m, fabsf(v[i] * g[k0 + 2 * i + (lane >> 5)]));
    m = fmaxf(m, __shfl_xor(m, 32));
    if (lane < 32) atomicMax(colmax + n0 + lane, __float_as_uint(m));
}
__device__ __forceinline__ void gate_quant_item(const float* W, const float* g, const unsigned* colmax, signed char* WQ, float* sb, LAS float* scr, int item, int lane) {
    const int kb = item / (NG / 32), nb = item % (NG / 32), k0 = 64 * kb, n0 = 32 * nb;
    const int sc = src_col<3>(n0 + (lane & 31));
    const GAS float* wp = (const GAS float*)W + (size_t)(k0 + (lane >> 5)) * IN_COLS + (sc >= 0 ? sc : 0);
    float v[32];
#pragma unroll
    for (int i = 0; i < 32; ++i) v[i] = __builtin_nontemporal_load(wp + (size_t)(2 * i) * IN_COLS);
    if (sc < 0) {
#pragma unroll
        for (int i = 0; i < 32; ++i) v[i] = 0.f; }
    const float cm = __uint_as_float(colmax[n0 + (lane & 31)]); const float inv = cm > 0.f ? 127.0f / cm : 0.f;
    if (kb == 0 && lane < 32) sb[n0 + lane] = cm * (1.0f / 127.0f);
#pragma unroll
    for (int i = 0; i < 32; ++i) { const int kk = 2 * i + (lane >> 5); float q = __builtin_rintf(v[i] * g[k0 + kk] * inv); q = fminf(fmaxf(q, -127.f), 127.f); scr[kk * 33 + (lane & 31)] = q; }
    LDS_WAIT(); asm volatile("" ::: "memory");
    const int n = lane >> 1, hf = lane & 1;
    unsigned w[8];
#pragma unroll
    for (int d = 0; d < 8; ++d) { unsigned x = 0;
#pragma unroll
        for (int b = 0; b < 4; ++b) x |= ((unsigned)(int)scr[(32 * hf + 4 * d + b) * 33 + n] & 0xffu) << (8 * b);
        w[d] = x; }
    GAS v4u* dst = (GAS v4u*)(WQ + (size_t)(n0 + n) * DM + k0 + 32 * hf);
    dst[0] = (v4u){w[0], w[1], w[2], w[3]}; dst[1] = (v4u){w[4], w[5], w[6], w[7]};
    LDS_WAIT(); asm volatile("" ::: "memory");
}
__device__ __forceinline__ void sincos_d(double a, float& sn, float& cs) {
    const double q = __builtin_rint(a * 0.63661977236758134308);
    double r = __builtin_fma(-q, 1.57079632679489655800e+00, a); r = __builtin_fma(-q, 6.12323399573676603587e-17, r);
    const double r2 = r * r;
    double ps = r2 * (1.0 / 6227020800.0) - (1.0 / 39916800.0); ps = ps * r2 + (1.0 / 362880.0); ps = ps * r2 - (1.0 / 5040.0); ps = ps * r2 + (1.0 / 120.0); ps = ps * r2 - (1.0 / 6.0); ps = ps * r2 * r + r;
    double pc = r2 * (1.0 / 87178291200.0) - (1.0 / 479001600.0); pc = pc * r2 + (1.0 / 3628800.0); pc = pc * r2 - (1.0 / 40320.0); pc = pc * r2 + (1.0 / 720.0); pc = pc * r2 - (1.0 / 24.0); pc = pc * r2 + 0.5; pc = 1.0 - pc * r2;
    const int qi = ((int)q) & 3;
    const double s_ = (qi == 0) ? ps : (qi == 1) ? pc : (qi == 2) ? -ps : -pc;
    const double c_ = (qi == 0) ? pc : (qi == 1) ? -ps : (qi == 2) ? -pc : ps;
    sn = (float)s_; cs = (float)c_;
}
__device__ __forceinline__ void p0_prologue(Frame& F, const Args& A) {
    LAS float* scr = (LAS float*)(F.lds + RING_OFF + F.wave * 16384);
    constexpr int I_GM = 64 * (NG / 32), I_IN = 64 * (NB / 32), I_Q = 16 * (768 / 32), I_KV = 8 * (1024 / 32), I_PA = 16 * 128, I_PB = 8 * 128, I_PC = 8 * 128, I_O = 64 * 128;
    constexpr int PER_L = I_GM + I_IN + I_Q + I_KV + I_PA + I_PB + I_PC + I_O;
    for (int it = F.gw; it < DEPTH * PER_L; it += F.NGW) {
        const int l = it / PER_L; int r = it % PER_L;
        if (r < I_GM) { gate_max_item(A.w_in + (size_t)l * DM * IN_COLS, A.norm_g + l * DM, F.COLMAX + l * NG, r, F.lane); continue; } r -= I_GM;
        if (r < I_IN) { conv_item<1>(A.w_in + (size_t)l * DM * IN_COLS, IN_COLS, A.norm_g + l * DM, F.Win + (size_t)l * NB * DM, DM, 0, NB / 32, scr, r, F.lane); continue; } r -= I_IN;
        if (r < I_Q) { conv_item<2>(A.w_q_up + (size_t)l * 1024 * 768, 768, A.g_q + l * 1024, F.Wq + (size_t)l * 768 * 1024, 1024, 0, 768 / 32, scr, r, F.lane); continue; } r -= I_Q;
        if (r < I_KV) { conv_item<0>(A.w_kv_up + (size_t)l * 512 * 1024, 1024, A.g_kv + l * 512, F.Wkv + (size_t)l * 1024 * 512, 512, 0, 1024 / 32, scr, r, F.lane); continue; } r -= I_KV;
        if (r < I_PA) { conv_item<0>(A.w_pa + (size_t)l * 1024 * DM, DM, nullptr, F.Wproj + (size_t)l * DM * YW, YW, 0, 128, scr, r, F.lane); continue; } r -= I_PA;
        if (r < I_PB) { conv_item<0>(A.w_pb + (size_t)l * 512 * DM, DM, nullptr, F.Wproj + (size_t)l * DM * YW, YW, 1024, 128, scr, r, F.lane); continue; } r -= I_PB;
        if (r < I_PC) { conv_item<0>(A.w_pc + (size_t)l * 512 * DM, DM, nullptr, F.Wproj + (size_t)l * DM * YW, YW, 1536, 128, scr, r, F.lane); continue; } r -= I_PC;
        conv_item<0>(A.w_out + (size_t)l * DM * DM, DM, nullptr, F.Wout + (size_t)l * DM * DM, DM, 0, 128, scr, r, F.lane);
    }
    if (blockIdx.x == 0) { for (int i = threadIdx.x; i < 8 * 128; i += NWAVES * 64) F.BLUT[i] = A.rel_bias[(int)T5B[i & 127] * 8 + (i >> 7)] * LOG2E; }
    for (int i = F.gw * 64 + F.lane; i < S * 32; i += F.NGW * 64) {
        const int pos = i >> 5, j = i & 31;
        const float inv = ROPE_INV[j];
        const float ang = (float)pos * inv;
        float sn, cs; sincos_d((double)ang, sn, cs);
        F.ROPEC[i] = cs; F.ROPES[i] = sn;
    }
}
__device__ __forceinline__ void p0b_gate_quant(Frame& F, const Args& A) {
    LAS float* scr = (LAS float*)(F.lds + RING_OFF + F.wave * 16384);
    constexpr int I_GM = 64 * (NG / 32);
    for (int it = F.gw; it < DEPTH * I_GM; it += F.NGW) { const int l = it / I_GM, r = it % I_GM;
        gate_quant_item(A.w_in + (size_t)l * DM * IN_COLS, A.norm_g + l * DM, F.COLMAX + l * NG, F.WG8 + (size_t)l * NG * DM, F.SB + l * NG, scr, r, F.lane); }
}
template <int MODE>
__device__ __forceinline__ void prep_rows(Frame& F, const float* X, bf16* XBo, float* RSo, float* OUT, const float* gfin, signed char* XQo = nullptr, float* SAo = nullptr) {
    for (int m = F.gw; m < S; m += F.NGW) {
        const GAS f32x4* xr = (const GAS f32x4*)(X + (size_t)m * DM) + F.lane;
        f32x4 v[16]; float s = 0.f;
#pragma unroll
        for (int j = 0; j < 16; ++j) { v[j] = __builtin_nontemporal_load(xr + 64 * j); s += (v[j].x * v[j].x + v[j].y * v[j].y) + (v[j].z * v[j].z + v[j].w * v[j].w); }
        float mx = 0.f;
        if (MODE == 0) {
#pragma unroll
            for (int j = 0; j < 16; ++j) mx = fmaxf(fmaxf(mx, fmaxf(fabsf(v[j].x), fabsf(v[j].y))), fmaxf(fabsf(v[j].z), fabsf(v[j].w)));
            mx = wave_max(mx); }
        const float ssum = wave_sum(s); const float rs = 1.0f / sqrtf(ssum * (1.0f / DM) + EPS);
        if (MODE == 0) {
            if (F.lane == 0) RSo[m] = ssum;
            GAS v2u* o8 = (GAS v2u*)(XBo + (size_t)m * DM) + F.lane;
#pragma unroll
            for (int j = 0; j < 16; ++j) { v2u w; w.x = pk2(v[j].x, v[j].y); w.y = pk2(v[j].z, v[j].w); o8[64 * j] = w; }
            if (F.lane == 0) SAo[m] = mx * (1.0f / 127.0f);
            const float inv = mx > 0.f ? 127.0f / mx : 0.f;
            GAS unsigned* q4 = (GAS unsigned*)(XQo + (size_t)m * DM) + F.lane;
#pragma unroll
            for (int j = 0; j < 16; ++j) { const int a = (int)__builtin_rintf(v[j].x * inv), b = (int)__builtin_rintf(v[j].y * inv), c = (int)__builtin_rintf(v[j].z * inv), d = (int)__builtin_rintf(v[j].w * inv);
                q4[64 * j] = ((unsigned)a & 0xffu) | (((unsigned)b & 0xffu) << 8) | (((unsigned)c & 0xffu) << 16) | (((unsigned)d & 0xffu) << 24); }
        } else {
            GAS f32x4* o = (GAS f32x4*)(OUT + (size_t)m * DM) + F.lane; const GAS f32x4* gg = (const GAS f32x4*)gfin + F.lane;
#pragma unroll
            for (int j = 0; j < 16; ++j) { const f32x4 gv = gg[64 * j]; o[64 * j] = v[j] * rs * gv; }
        }
    }
}

__device__ __forceinline__ void prep_q8(Frame& F, const bf16* XBi, const float* ssx, const unsigned* rmx, float* RSo, float* SAo, signed char* XQo) {
    for (int m = F.gw; m < S; m += F.NGW) {
        const GAS v4u* xr = (const GAS v4u*)(XBi + (size_t)m * DM) + F.lane;
        v4u v[8];
#pragma unroll
        for (int j = 0; j < 8; ++j) v[j] = xr[64 * j];
        const float mx = __uint_as_float(rmx[m]), inv = mx > 0.f ? 127.0f / mx : 0.f;
        if (F.lane == 0) { RSo[m] = ssx[m]; SAo[m] = mx * (1.0f / 127.0f); }
        GAS v2u* q8 = (GAS v2u*)(XQo + (size_t)m * DM) + F.lane;
#pragma unroll
        for (int j = 0; j < 8; ++j) { unsigned o2[2];
#pragma unroll
            for (int h = 0; h < 2; ++h) { const unsigned w0 = h ? v[j].z : v[j].x, w1 = h ? v[j].w : v[j].y;
                const int a = (int)__builtin_rintf(pg8::bf_lo(w0) * inv), b = (int)__builtin_rintf(pg8::bf_hi(w0) * inv), c = (int)__builtin_rintf(pg8::bf_lo(w1) * inv), d = (int)__builtin_rintf(pg8::bf_hi(w1) * inv);
                o2[h] = ((unsigned)a & 0xffu) | (((unsigned)b & 0xffu) << 8) | (((unsigned)c & 0xffu) << 16) | (((unsigned)d & 0xffu) << 24); }
            v2u w; w.x = o2[0]; w.y = o2[1]; q8[64 * j] = w; }
    }
}

__device__ __forceinline__ void final_norm(Frame& F, const bf16* XBi, const float* ssx, float* OUT, const float* gfin) {
    f32x4 gk[8][2];
    { const GAS f32x4* gg = (const GAS f32x4*)gfin + 2 * F.lane;
#pragma unroll
      for (int j = 0; j < 8; ++j) { gk[j][0] = gg[128 * j]; gk[j][1] = gg[128 * j + 1]; } }
    for (int m = F.gw; m < S; m += F.NGW) {
        const GAS v4u* xr = (const GAS v4u*)(XBi + (size_t)m * DM) + F.lane;
        v4u v[8];
#pragma unroll
        for (int j = 0; j < 8; ++j) v[j] = xr[64 * j];
        const float rs = 1.0f / sqrtf(ssx[m] * (1.0f / DM) + EPS);
        GAS f32x4* o = (GAS f32x4*)(OUT + (size_t)m * DM) + 2 * F.lane;
#pragma unroll
        for (int j = 0; j < 8; ++j) { const f32x4 g0 = gk[j][0], g1 = gk[j][1];
            f32x4 a = {pg8::bf_lo(v[j].x), pg8::bf_hi(v[j].x), pg8::bf_lo(v[j].y), pg8::bf_hi(v[j].y)}, b = {pg8::bf_lo(v[j].z), pg8::bf_hi(v[j].z), pg8::bf_lo(v[j].w), pg8::bf_hi(v[j].w)};
            o[128 * j] = a * rs * g0; o[128 * j + 1] = b * rs * g1; }
    }
}

using pg8::f32x4; using pg8::Unit;
__device__ __forceinline__ float fast_sigmoid(float v) { return __builtin_amdgcn_rcpf(1.0f + __builtin_amdgcn_exp2f(-v * LOG2E)); }
__device__ __forceinline__ void atomic_addf(float* p, float v) { unsafeAtomicAdd(p, v); }
struct EpiInProj {
    static constexpr bool PERM = true, AFTER_DRAIN = false, MID = false; typedef pg8::f32x4 acc_t;
    bf16* P; const float* rs; bf16* KRM; const float* ropeC; const float* ropeS; float* ssq_q; float* ssq_kv; bool stats;
    __device__ __forceinline__ void operator()(const f32x4 (&acc)[2][2][4][2], const Unit& u, int wr, int wc, int fr, int fq) const {
        const int pn = u.pn;
        const int pcb = bf_tile_col(u.pn), po = pcb >> 8;
        const int ty = po < 4 ? 1 : po < 6 ? 0 : po < 10 ? 2 : po < 16 ? 0 : po < 18 ? 2 : po < 20 ? 1 : po < 24 ? 0 : 2;
        const int row0 = u.pm * 256 + wr * 64 + fr, col0 = pcb + wc * 32 + 8 * fq;
        float srow[2][4];
#pragma unroll
        for (int ai = 0; ai < 2; ++ai)
#pragma unroll
            for (int m = 0; m < 4; ++m) srow[ai][m] = rs[row0 + ai * 128 + m * 16];
#pragma unroll
        for (int ai = 0; ai < 2; ++ai)
#pragma unroll
            for (int m = 0; m < 4; ++m) srow[ai][m] = 1.0f / sqrtf(srow[ai][m] * (1.0f / DM) + EPS);
#pragma unroll
        for (int ai = 0; ai < 2; ++ai)
#pragma unroll
            for (int m = 0; m < 4; ++m) {
                const int row = row0 + ai * 128 + m * 16; const float s = srow[ai][m];
                bf16* rowp = P + (size_t)row * PP + col0; float ssl = 0.f;
#pragma unroll
                for (int bj = 0; bj < 2; ++bj) {
                    f32x4 v0 = acc[ai][bj][m][0] * s, v1 = acc[ai][bj][m][1] * s;
                    pg8::u32x4 w;
                    if (ty == 3) {
#pragma unroll
                        for (int j = 0; j < 4; ++j) { v0[j] = fast_sigmoid(v0[j]); v1[j] = fast_sigmoid(v1[j]); }
                        w.x = pg8::cvt_pk_f16(v0[0], v0[1]); w.y = pg8::cvt_pk_f16(v0[2], v0[3]); w.z = pg8::cvt_pk_f16(v1[0], v1[1]); w.w = pg8::cvt_pk_f16(v1[2], v1[3]);
                        *(pg8::u32x4*)(rowp + bj * 128) = w;
                    } else if (ty == 4) {
                        if (bj == 0 && wc < 2) {
                            const int j0 = wc * 16 + 4 * fq;
                            const f32x4 c = *(const f32x4*)(ropeC + (size_t)row * 32 + j0), sn = *(const f32x4*)(ropeS + (size_t)row * 32 + j0);
                            const float a0 = v0[0] * c[0] - v0[1] * sn[0], b0 = v0[1] * c[0] + v0[0] * sn[0];
                            const float a1 = v0[2] * c[1] - v0[3] * sn[1], b1 = v0[3] * c[1] + v0[2] * sn[1];
                            const float a2 = v1[0] * c[2] - v1[1] * sn[2], b2 = v1[1] * c[2] + v1[0] * sn[2];
                            const float a3 = v1[2] * c[3] - v1[3] * sn[3], b3 = v1[3] * c[3] + v1[2] * sn[3];
                            w.x = pg8::cvt_pk_bf16(a0, b0); w.y = pg8::cvt_pk_bf16(a1, b1); w.z = pg8::cvt_pk_bf16(a2, b2); w.w = pg8::cvt_pk_bf16(a3, b3);
                            *(pg8::u32x4*)(KRM + (size_t)row * 64 + wc * 32 + 8 * fq) = w;
                        }
                    } else {
                        if (po >= 10 && po < 16) ssl += (v0[0] * v0[0] + v0[1] * v0[1]) + (v0[2] * v0[2] + v0[3] * v0[3]) + (v1[0] * v1[0] + v1[1] * v1[1]) + (v1[2] * v1[2] + v1[3] * v1[3]);
                        if (ty == 1) { v0 = v0 * SC128; v1 = v1 * SC128; }
                        if (ty == 2) {
#pragma unroll
                            for (int j = 0; j < 4; ++j) { v0[j] = v0[j] * fast_sigmoid(v0[j]); v1[j] = v1[j] * fast_sigmoid(v1[j]); }
                        }
                        w.x = pg8::cvt_pk_bf16(v0[0], v0[1]); w.y = pg8::cvt_pk_bf16(v0[2], v0[3]); w.z = pg8::cvt_pk_bf16(v1[0], v1[1]); w.w = pg8::cvt_pk_bf16(v1[2], v1[3]);
                        *(pg8::u32x4*)(rowp + bj * 128) = w;
                    }
                }
                if (stats && po >= 10 && po < 16) { ssl += __shfl_xor(ssl, 16); ssl += __shfl_xor(ssl, 32); if (fq == 0) atomic_addf((po < 14 ? ssq_q : ssq_kv) + row, ssl); }
            }
    }
};
struct EpiGateI8 {
    static constexpr bool PERM = true, AFTER_DRAIN = false, MID = false; typedef pg8::i32x4 acc_t;
    bf16* P; const float* rs; const float* sa; const float* sb; float* ssq_q; bf16* KRM; const float* ropeC; const float* ropeS; unsigned char* GT; float* ssq_kv;
    __device__ __forceinline__ void operator()(const pg8::i32x4 (&acc)[2][2][4][2], const Unit& u, int wr, int wc, int fr, int fq) const {
        const int t = u.pn;
        const int ty = t < 48 ? 0 : t < 52 ? 1 : t < 56 ? 2 : t < 57 ? 3 : t < 59 ? 1 : t < 60 ? 4 : t < 64 ? 5 : t < 65 ? 3 : 6;
        const int row0 = u.pm * 256 + wr * 64 + fr, colw = wc * 32 + 8 * fq, col0 = t * 256 + colw;
        const int pcol = (t < 48 ? C_GA + t * 256 : t < 52 ? C_QA + (t - 48) * 256 : t < 56 ? C_CQ + (t - 52) * 256 : t < 57 ? C_KA : t < 59 ? C_QC + (t - 57) * 256 : t < 60 ? 0 : t < 64 ? C_ZA + (t - 60) * 256 : t < 65 ? C_VA : C_CKV + (t - 65) * 256) + colw;
        const float tsc = ty == 0 ? -LOG2E : ty == 1 ? SC128 : 1.0f;
        f32x4 cs[2][2];
#pragma unroll
        for (int bj = 0; bj < 2; ++bj) { cs[bj][0] = *(const f32x4*)(sb + col0 + bj * 128) * tsc; cs[bj][1] = *(const f32x4*)(sb + col0 + bj * 128 + 4) * tsc; }
        float srow[2][4], arow[2][4];
#pragma unroll
        for (int ai = 0; ai < 2; ++ai)
#pragma unroll
            for (int m = 0; m < 4; ++m) { srow[ai][m] = rs[row0 + ai * 128 + m * 16]; arow[ai][m] = sa[row0 + ai * 128 + m * 16]; }
#pragma unroll
        for (int ai = 0; ai < 2; ++ai)
#pragma unroll
            for (int m = 0; m < 4; ++m) srow[ai][m] = arow[ai][m] / sqrtf(srow[ai][m] * (1.0f / DM) + EPS);
#pragma unroll
        for (int ai = 0; ai < 2; ++ai)
#pragma unroll
            for (int m = 0; m < 4; ++m) {
                const int row = row0 + ai * 128 + m * 16; const float s = srow[ai][m];
                bf16* rowp = P + (size_t)row * PP + pcol; float ssl = 0.f;
#pragma unroll
                for (int bj = 0; bj < 2; ++bj) {
                    float v[8]; pg8::u32x4 w;
#pragma unroll
                    for (int j = 0; j < 8; ++j) v[j] = (float)acc[ai][bj][m][j >> 2][j & 3] * s * cs[bj][j >> 2][j & 3];
                    if (ty == 0) {
#pragma unroll
                        for (int j = 0; j < 8; ++j) v[j] = 1.0f + __builtin_amdgcn_exp2f(v[j]);
                        w.x = __builtin_bit_cast(unsigned, __builtin_amdgcn_cvt_pkrtz(v[0], v[1])); w.y = __builtin_bit_cast(unsigned, __builtin_amdgcn_cvt_pkrtz(v[2], v[3])); w.z = __builtin_bit_cast(unsigned, __builtin_amdgcn_cvt_pkrtz(v[4], v[5])); w.w = __builtin_bit_cast(unsigned, __builtin_amdgcn_cvt_pkrtz(v[6], v[7]));
                        *(GAS pg8::u32x4*)((GAS unsigned char*)GT + ((unsigned)(t * 64 + u.pm) * 131072u + (unsigned)((ai * 4 + m) * 2 + bj) * 8192u + (unsigned)(((wr * 4 + wc) * 64 + fq * 16 + fr) * 16))) = w;
                    } else if (ty == 4) {
                        if (bj == 0 && wc < 2) {
                            const int j0 = wc * 16 + 4 * fq;
                            const f32x4 c = *(const f32x4*)(ropeC + (size_t)row * 32 + j0), sn = *(const f32x4*)(ropeS + (size_t)row * 32 + j0);
                            w.x = pg8::cvt_pk_bf16(v[0] * c[0] - v[1] * sn[0], v[1] * c[0] + v[0] * sn[0]); w.y = pg8::cvt_pk_bf16(v[2] * c[1] - v[3] * sn[1], v[3] * c[1] + v[2] * sn[1]);
                            w.z = pg8::cvt_pk_bf16(v[4] * c[2] - v[5] * sn[2], v[5] * c[2] + v[4] * sn[2]); w.w = pg8::cvt_pk_bf16(v[6] * c[3] - v[7] * sn[3], v[7] * c[3] + v[6] * sn[3]);
                            *(pg8::u32x4*)(KRM + (size_t)row * 64 + wc * 32 + 8 * fq) = w;
                        }
                    } else {
                        if (ty == 5) {
#pragma unroll
                            for (int j = 0; j < 8; ++j) v[j] = v[j] * fast_sigmoid(v[j]); }
                        if (ty == 2 || ty == 6) ssl += (v[0] * v[0] + v[1] * v[1]) + (v[2] * v[2] + v[3] * v[3]) + (v[4] * v[4] + v[5] * v[5]) + (v[6] * v[6] + v[7] * v[7]);
                        w.x = pg8::cvt_pk_bf16(v[0], v[1]); w.y = pg8::cvt_pk_bf16(v[2], v[3]); w.z = pg8::cvt_pk_bf16(v[4], v[5]); w.w = pg8::cvt_pk_bf16(v[6], v[7]);
                        *(pg8::u32x4*)(rowp + bj * 128) = w;
                    }
                }
                if (ty == 2 || ty == 6) { ssl += __shfl_xor(ssl, 16); ssl += __shfl_xor(ssl, 32); if (fq == 0) atomic_addf((ty == 2 ? ssq_q : ssq_kv) + row, ssl); }
            }
    }
};
struct EpiQUp {
    static constexpr bool PERM = true, AFTER_DRAIN = false, MID = false; typedef pg8::f32x4 acc_t;
    bf16* QM; const float* rsq; const float* ropeC; const float* ropeS;
    __device__ __forceinline__ void operator()(const f32x4 (&acc)[2][2][4][2], const Unit& u, int wr, int wc, int fr, int fq) const {
        const int row0 = u.pm * 256 + wr * 64 + fr, col0 = u.pn * 256 + wc * 32 + 8 * fq;
        float srow[2][4];
#pragma unroll
        for (int ai = 0; ai < 2; ++ai)
#pragma unroll
            for (int m = 0; m < 4; ++m) srow[ai][m] = rsq[row0 + ai * 128 + m * 16];
        const int cb0 = (u.pn * 256 + wc * 32) % 192, cb1 = (u.pn * 256 + wc * 32 + 128) % 192;
        const int rbj = __builtin_amdgcn_readfirstlane(cb0 >= 128 ? 0 : cb1 >= 128 ? 1 : -1);
        f32x4 ccv[2][4], snv[2][4];
        if (rbj >= 0) { const int j0r = (((rbj ? cb1 : cb0) - 128) >> 1) + 4 * fq;
#pragma unroll
            for (int ai = 0; ai < 2; ++ai)
#pragma unroll
                for (int m = 0; m < 4; ++m) { const size_t ro = (size_t)(row0 + ai * 128 + m * 16) * 32 + j0r; ccv[ai][m] = *(const f32x4*)(ropeC + ro); snv[ai][m] = *(const f32x4*)(ropeS + ro); } }
#pragma unroll
        for (int ai = 0; ai < 2; ++ai)
#pragma unroll
            for (int m = 0; m < 4; ++m) {
                const int row = row0 + ai * 128 + m * 16; const float s = SC192 / sqrtf(srow[ai][m] * (1.0f / 1024.0f) + EPS);
#pragma unroll
                for (int bj = 0; bj < 2; ++bj) {
                    const int col = col0 + bj * 128, c = col % 192;
                    f32x4 v0 = acc[ai][bj][m][0] * s, v1 = acc[ai][bj][m][1] * s;
                    pg8::u32x4 w;
                    if (bj == rbj) {
                        const f32x4 cc = ccv[ai][m], sn = snv[ai][m];
                        const float a0 = v0[0] * cc[0] - v0[1] * sn[0], b0 = v0[1] * cc[0] + v0[0] * sn[0];
                        const float a1 = v0[2] * cc[1] - v0[3] * sn[1], b1 = v0[3] * cc[1] + v0[2] * sn[1];
                        const float a2 = v1[0] * cc[2] - v1[1] * sn[2], b2 = v1[1] * cc[2] + v1[0] * sn[2];
                        const float a3 = v1[2] * cc[3] - v1[3] * sn[3], b3 = v1[3] * cc[3] + v1[2] * sn[3];
                        w.x = pg8::cvt_pk_bf16(a0, b0); w.y = pg8::cvt_pk_bf16(a1, b1); w.z = pg8::cvt_pk_bf16(a2, b2); w.w = pg8::cvt_pk_bf16(a3, b3);
                    } else {
                        w.x = pg8::cvt_pk_bf16(v0[0], v0[1]); w.y = pg8::cvt_pk_bf16(v0[2], v0[3]); w.z = pg8::cvt_pk_bf16(v1[0], v1[1]); w.w = pg8::cvt_pk_bf16(v1[2], v1[3]);
                    }
                    *(pg8::u32x4*)(QM + (size_t)row * 768 + col) = w;
                }
            }
    }
};
struct EpiKvUp {
    static constexpr bool PERM = true, AFTER_DRAIN = false, MID = false; typedef pg8::f32x4 acc_t;
    bf16* KVM; const float* rskv;
    __device__ __forceinline__ void operator()(const f32x4 (&acc)[2][2][4][2], const Unit& u, int wr, int wc, int fr, int fq) const {
        const int row0 = u.pm * 256 + wr * 64 + fr, col0 = u.pn * 256 + wc * 32 + 8 * fq;
        float srow[2][4];
#pragma unroll
        for (int ai = 0; ai < 2; ++ai)
#pragma unroll
            for (int m = 0; m < 4; ++m) srow[ai][m] = rskv[row0 + ai * 128 + m * 16];
#pragma unroll
        for (int ai = 0; ai < 2; ++ai)
#pragma unroll
            for (int m = 0; m < 4; ++m) {
                const int row = row0 + ai * 128 + m * 16; const float s = 1.0f / sqrtf(srow[ai][m] * (1.0f / 512.0f) + EPS);
#pragma unroll
                for (int bj = 0; bj < 2; ++bj) {
                    const f32x4 v0 = acc[ai][bj][m][0] * s, v1 = acc[ai][bj][m][1] * s;
                    pg8::u32x4 w; w.x = pg8::cvt_pk_bf16(v0[0], v0[1]); w.y = pg8::cvt_pk_bf16(v0[2], v0[3]); w.z = pg8::cvt_pk_bf16(v1[0], v1[1]); w.w = pg8::cvt_pk_bf16(v1[2], v1[3]);
                    *(pg8::u32x4*)(KVM + (size_t)row * 1024 + col0 + bj * 128) = w;
                }
            }
    }
};
struct EpiProjFused {
    static constexpr bool PERM = true, AFTER_DRAIN = false, MID = true; typedef pg8::f32x4 acc_t;
    const unsigned char* GT; bf16* MBF; int t1, t2;
    typedef _Float16 h8 __attribute__((ext_vector_type(8)));
    __device__ __forceinline__ void mid(f32x4 (&acc)[2][2][4][2], const Unit& u, bool second, int wr, int wc, int fr, int fq) const {
        const unsigned slot = (unsigned)(((wr * 4 + wc) * 64 + fq * 16 + fr) * 16);
        const unsigned gx = (unsigned)(((second ? 16 : 0) + u.pn) * 64 + u.pm) * 131072u + slot, gy = gx + 16u * 64u * 131072u;
        const GAS unsigned char* Gb = (const GAS unsigned char*)GT;
#pragma unroll
        for (int ai = 0; ai < 2; ++ai) {
            h8 X[4][2], Y[4][2];
#pragma unroll
            for (int m = 0; m < 4; ++m)
#pragma unroll
                for (int bj = 0; bj < 2; ++bj) { const unsigned co = (unsigned)((ai * 4 + m) * 2 + bj) * 8192u; X[m][bj] = *(const GAS h8*)(Gb + (gx + co)); Y[m][bj] = *(const GAS h8*)(Gb + (gy + co)); }
#pragma unroll
            for (int m = 0; m < 4; ++m) {
#pragma unroll
                for (int bj = 0; bj < 2; ++bj) {
#pragma unroll
                    for (int j = 0; j < 8; ++j) { const float r = (float)Y[m][bj][j] * __builtin_amdgcn_rcpf((float)X[m][bj][j]); acc[ai][bj][m][j >> 2][j & 3] *= r; }
                    __builtin_amdgcn_sched_barrier(0);
                }
            }
            asm volatile("" ::: "memory");
        }
    }
    __device__ __forceinline__ void operator()(const f32x4 (&acc)[2][2][4][2], const Unit& u, int wr, int wc, int fr, int fq) const {
        const int row0 = u.pm * 256 + wr * 64 + fr, col0 = u.pn * 256 + wc * 32 + 8 * fq;
        h8 Gall[2][4][2];
        { const GAS unsigned char* gb_ = (const GAS unsigned char*)GT + ((unsigned)((32 + u.pn) * 64 + u.pm) * 131072u + (unsigned)(((wr * 4 + wc) * 64 + fq * 16 + fr) * 16));
#pragma unroll
          for (int ai = 0; ai < 2; ++ai)
#pragma unroll
            for (int m = 0; m < 4; ++m)
#pragma unroll
                for (int bj = 0; bj < 2; ++bj) Gall[ai][m][bj] = *(const GAS h8*)(gb_ + (unsigned)((ai * 4 + m) * 2 + bj) * 8192u); }
#pragma unroll
        for (int ai = 0; ai < 2; ++ai)
#pragma unroll
            for (int m = 0; m < 4; ++m) {
                const int row = row0 + ai * 128 + m * 16;
#pragma unroll
                for (int bj = 0; bj < 2; ++bj) {
                    const h8 G = Gall[ai][m][bj];
                    float v[8];
#pragma unroll
                    for (int j = 0; j < 8; ++j) v[j] = acc[ai][bj][m][j >> 2][j & 3] * __builtin_amdgcn_rcpf((float)G[j]);
                    pg8::u32x4 w; w.x = pg8::cvt_pk_bf16(v[0], v[1]); w.y = pg8::cvt_pk_bf16(v[2], v[3]); w.z = pg8::cvt_pk_bf16(v[4], v[5]); w.w = pg8::cvt_pk_bf16(v[6], v[7]);
                    *(pg8::u32x4*)(MBF + (size_t)row * DM + col0 + bj * 128) = w;
                }
            }
    }
};
struct EpiOut {
    static constexpr bool PERM = false, AFTER_DRAIN = false, MID = false; typedef pg8::f32x4 acc_t;
    const float* Xp; float* Xn; bf16* XBn; float* ssx; unsigned* rmx; bool LAST; bool stats; bool FIN; bool TIN; bool TOUT;
    __device__ __forceinline__ void operator()(const f32x4 (&acc)[2][2][4][2], const Unit& u, int wr, int wc, int fr, int fq) const {
        const int row0 = u.pm * 256 + wr * 64 + fr, col0 = u.pn * 256 + wc * 32 + 4 * fq;
        const unsigned tb = (unsigned)(u.pn * 64 + u.pm) * 262144u + (unsigned)(((wr * 4 + wc) * 64 + fq * 16 + fr) * 16), rb = ((unsigned)row0 * (unsigned)DM + (unsigned)col0) * 4u;
        const unsigned ib = TIN ? tb : rb, ob = TOUT ? tb : rb;
        const unsigned is_ai = TIN ? 16u * 8192u : 128u * DM * 4u, is_m = TIN ? 4u * 8192u : 16u * DM * 4u, is_bj = TIN ? 2u * 8192u : 512u, is_n = TIN ? 8192u : 64u;
        const unsigned os_ai = TOUT ? 16u * 8192u : 128u * DM * 4u, os_m = TOUT ? 4u * 8192u : 16u * DM * 4u, os_bj = TOUT ? 2u * 8192u : 512u, os_n = TOUT ? 8192u : 64u;
#pragma unroll
        for (int ai = 0; ai < 2; ++ai) {
            f32x4 xin[4][2][2];
#pragma unroll
            for (int m = 0; m < 4; ++m)
#pragma unroll
                for (int bj = 0; bj < 2; ++bj)
#pragma unroll
                    for (int n = 0; n < 2; ++n) xin[m][bj][n] = *(const GAS f32x4*)((const GAS unsigned char*)Xp + (ib + ai * is_ai + m * is_m + bj * is_bj + n * is_n));
#pragma unroll
            for (int m = 0; m < 4; ++m) {
                const int row = row0 + ai * 128 + m * 16; const size_t off = (size_t)row * DM + col0; float ssl = 0.f, mxl = 0.f;
#pragma unroll
                for (int bj = 0; bj < 2; ++bj) {
                    pg8::u32x2 w[2];
#pragma unroll
                    for (int n = 0; n < 2; ++n) { const f32x4 v = xin[m][bj][n] + acc[ai][bj][m][n]; if (!FIN) *(GAS f32x4*)((GAS unsigned char*)Xn + (ob + ai * os_ai + m * os_m + bj * os_bj + n * os_n)) = v;
                        if (!LAST) { w[n].x = pg8::cvt_pk_bf16(v[0], v[1]); w[n].y = pg8::cvt_pk_bf16(v[2], v[3]); ssl += (v[0] * v[0] + v[1] * v[1]) + (v[2] * v[2] + v[3] * v[3]); mxl = fmaxf(fmaxf(mxl, fmaxf(fabsf(v[0]), fabsf(v[1]))), fmaxf(fabsf(v[2]), fabsf(v[3]))); } }
                    if (!LAST) {
                        auto r0 = __builtin_amdgcn_permlane16_swap(w[0].x, w[1].x, false, false); auto r1 = __builtin_amdgcn_permlane16_swap(w[0].y, w[1].y, false, false);
                        pg8::u32x4 w4; w4.x = r0[0]; w4.y = r1[0]; w4.z = r0[1]; w4.w = r1[1];
                        const int cx = (fq & 1) ? 16 + 4 * (fq - 1) - 4 * fq : 0;
                        *(pg8::u32x4*)(XBn + off + bj * 128 + cx) = w4; }
                }
                if (!LAST && stats) { ssl += __shfl_xor(ssl, 16); ssl += __shfl_xor(ssl, 32); mxl = fmaxf(mxl, __shfl_xor(mxl, 16)); mxl = fmaxf(mxl, __shfl_xor(mxl, 32));
                    if (fq == 0) { atomic_addf(ssx + row, ssl); if (!FIN) atomicMax(rmx + row, __float_as_uint(mxl)); } }
            }
            asm volatile("" ::: "memory");
        }
    }
};

__device__ __forceinline__ float dot8(const v4u kv, const LAS float* q) {
    const f32x4 q0 = *(const LAS f32x4*)q, q1 = *(const LAS f32x4*)(q + 4);
    return pg8::bf_lo(kv.x) * q0[0] + pg8::bf_hi(kv.x) * q0[1] + pg8::bf_lo(kv.y) * q0[2] + pg8::bf_hi(kv.y) * q0[3]
         + pg8::bf_lo(kv.z) * q1[0] + pg8::bf_hi(kv.z) * q1[1] + pg8::bf_lo(kv.w) * q1[2] + pg8::bf_hi(kv.w) * q1[3];
}
template <int MODE>
__device__ __forceinline__ void naive_attn_task(Frame& F, const Args& A, int layer, int row, int head, LAS float* wscr) {
    const int lane = F.lane;
    constexpr int DQK = (MODE == 1) ? 192 : 128;
    const bf16 *qp, *kb, *vb, *gatep; bf16* outp; int kpitch, vpitch;
    if (MODE == 0) { qp = F.P + (size_t)row * PP + C_QA + head * 128; kb = F.P + C_KA + (head >> 2) * 128; vb = F.P + C_VA + (head >> 2) * 128; kpitch = PP; vpitch = PP;
        gatep = F.P + (size_t)row * PP + C_ZA + head * 128; outp = F.Y + (size_t)row * YW + head * 128; }
    else if (MODE == 1) { qp = F.QM + (size_t)row * 768 + head * 192; kb = F.KVM + head * 256; vb = F.KVM + head * 256 + 128; kpitch = 1024; vpitch = 1024;
        gatep = F.P + (size_t)row * PP + C_ZB + head * 128; outp = F.Y + (size_t)row * YW + 1024 + head * 128; }
    else { qp = F.P + (size_t)row * PP + C_QC + head * 128; kb = F.P + C_KC + head * 128; vb = F.P + C_VC + head * 128; kpitch = PP; vpitch = PP;
        gatep = F.P + (size_t)row * PP + C_ZC + head * 128; outp = F.Y + (size_t)row * YW + 1536 + head * 128; }
    LAS float* qs = wscr; LAS float* ps = wscr + 192;
    for (int i = lane; i < DQK; i += 64) qs[i] = bf2f(qp[i]);
    LDS_WAIT(); asm volatile("" ::: "memory");
    float o0 = 0.f, o1 = 0.f, mrun = -1e30f, lrun = 0.f, carry = 0.f;
    int klo, khi;
    if (MODE == 0) { klo = row - 127 > 0 ? row - 127 : 0; khi = row; } else if (MODE == 1) { klo = 0; khi = row; } else { klo = 0; khi = row - 1; }
    if (khi >= klo) {
        const int cfirst = klo & ~63, clast = khi & ~63;
        const int nchunk = (clast - cfirst) / 64 + 1;
        for (int ci = 0; ci < nchunk; ++ci) {
            const int c0 = (MODE == 2) ? clast - 64 * ci : cfirst + 64 * ci;
            const int s = c0 + lane; const bool valid = (s >= klo) && (s <= khi);
            const int sl = s > khi ? khi : (s < klo ? klo : s);
            const bf16* kp = kb + (size_t)sl * kpitch;
            float d = 0.f;
#pragma unroll
            for (int c = 0; c < 16; ++c) d += dot8(*(const GAS v4u*)(kp + 8 * c), qs + 8 * c);
            if (MODE == 1) { const bf16* krp = F.KRM + (size_t)sl * 64;
#pragma unroll
                for (int c = 0; c < 8; ++c) d += dot8(*(const GAS v4u*)(krp + 8 * c), qs + 128 + 8 * c); }
            float p;
            if (MODE == 2) {
                const float z = d;
                const float lk = -(fmaxf(z, 0.f) + __builtin_amdgcn_logf(1.0f + __builtin_amdgcn_exp2f(-fabsf(z))));
                float incl = valid ? lk : 0.f;
#pragma unroll
                for (int off = 1; off < 64; off <<= 1) { const float t = __shfl_down(incl, off); if (lane + off < 64) incl += t; }
                float excl = __shfl_down(incl, 1); if (lane == 63) excl = 0.f;
                const float tot = __shfl(incl, 0);
                p = valid ? __builtin_amdgcn_exp2f(z + lk + excl + carry) : 0.f;
                carry += tot;
            } else {
                float sc = d;
                if (MODE == 0) sc += A.rel_bias[(int)T5B[(row - sl) & 127] * 8 + head] * LOG2E;
                sc = valid ? sc : -__builtin_inff();
                const float mn = fmaxf(mrun, wave_max(sc));
                const float alpha = __builtin_amdgcn_exp2f(mrun - mn);
                p = __builtin_amdgcn_exp2f(sc - mn);
                lrun = lrun * alpha + wave_sum(p); o0 *= alpha; o1 *= alpha; mrun = mn;
            }
            ps[lane] = p;
            LDS_WAIT(); asm volatile("" ::: "memory");
            for (int j = 0; j < 64; ++j) {
                int sj = c0 + j; sj = sj > khi ? khi : (sj < klo ? klo : sj);
                const float pj = ps[j];
                const unsigned vv = *(const GAS unsigned*)(vb + (size_t)sj * vpitch + 2 * lane);
                o0 += pj * pg8::bf_lo(vv); o1 += pj * pg8::bf_hi(vv);
            }
            LDS_WAIT(); asm volatile("" ::: "memory");
        }
    }
    if (MODE == 0) { const float sk = A.sinks[layer * 8 + head] * LOG2E; const float mf = fmaxf(mrun, sk); const float a = __builtin_amdgcn_exp2f(mrun - mf);
        const float lf = lrun * a + __builtin_amdgcn_exp2f(sk - mf); const float inv = a / lf; o0 *= inv; o1 *= inv; }
    if (MODE == 1) { const float inv = 1.0f / lrun; o0 *= inv; o1 *= inv; }
    const unsigned gv = *(const GAS unsigned*)(gatep + 2 * lane);
    *(GAS unsigned*)(outp + 2 * lane) = pk2(o0 * pg8::bf_lo(gv), o1 * pg8::bf_hi(gv));
}
__device__ __forceinline__ void naive_attn_phase(Frame& F, const Args& A, int layer) {
    LAS float* wscr = (LAS float*)(F.lds + RING_OFF + F.wave * 2048);
    if (!(ATTN_MFMA_MASK & 2)) for (int t = F.gw; t < S * 4; t += F.NGW) naive_attn_task<1>(F, A, layer, t >> 2, t & 3, wscr);
    if (!(ATTN_MFMA_MASK & 4)) for (int t = F.gw; t < S * 4; t += F.NGW) naive_attn_task<2>(F, A, layer, t >> 2, t & 3, wscr);
    if (!(ATTN_MFMA_MASK & 1)) for (int t = F.gw; t < S * 8; t += F.NGW) naive_attn_task<0>(F, A, layer, t >> 3, t & 7, wscr);
}


namespace att {
typedef short s16x4 __attribute__((ext_vector_type(4)));
typedef float f32x16 __attribute__((ext_vector_type(16)));
constexpr int SHM_T = 16384, OFF_V = 0  , OFF_K = 3 * SHM_T  , OFF_KR = 5 * SHM_T, OFF_WS = 5 * SHM_T + 2 * 8192, OFF_FLAG = OFF_WS + 8 * 256, OFF_LUT = OFF_FLAG + 64, LDS_END = OFF_LUT + 512;
static_assert(LDS_END <= RING_BYTES, "attention LDS");
#define KSWZ(row, colB) ((row) * 256 + ((colB) ^ (((row) & 15) << 4)))
#define KRSWZ(row, chunk) ((row) * 128 + ((((chunk) ^ ((row) >> 1)) & 7) << 4))
__device__ __forceinline__ int v_st(int k, int c) { const int kk = (k & ~0xC) | ((k & 4) << 1) | ((k & 8) >> 1); return ((kk >> 3) * 4 + (c >> 5)) * 512 + ((kk & 7) * 32 + (c & 31)) * 2; }
__device__ __forceinline__ int v_rd_base(int lane) { return ((lane & 3) << 3) | (((lane >> 2) & 3) << 6) | (((lane >> 4) & 1) << 5) | (((lane >> 5) & 1) << 8); }
constexpr int v_rd_off(int d0, int ks, int half) { return d0 * 512 + ks * 4096 + half * 2048; }
__device__ __forceinline__ int crow(int r, int hi) { return (r & 3) + 8 * (r >> 2) + 4 * hi; }
__device__ __forceinline__ unsigned cvtpk(float lo, float hi) { unsigned r; asm volatile("v_cvt_pk_bf16_f32 %0, %1, %2" : "=v"(r) : "v"(lo), "v"(hi)); return r; }
__device__ __forceinline__ void glds16(const void* gsrc, unsigned lds_dst) { unsigned keep;
    asm volatile("s_mov_b32 %0, m0\n\ts_mov_b32 m0, %2\n\ts_nop 0\n\tglobal_load_lds_dwordx4 %1, off\n\ts_mov_b32 m0, %0" : "=&s"(keep) : "v"(gsrc), "s"(lds_dst) : "memory"); }
__device__ __forceinline__ void glds16s(const char* sbase, unsigned voff, unsigned lds_dst) { unsigned keep;
    asm volatile("s_mov_b32 %0, m0\n\ts_mov_b32 m0, %3\n\ts_nop 0\n\tglobal_load_lds_dwordx4 %1, %2\n\ts_mov_b32 m0, %0" : "=&s"(keep) : "v"(voff), "s"(sbase), "s"(lds_dst) : "memory"); }
__device__ __forceinline__ const char* uni_ptr(const void* p) { const unsigned long long v = (unsigned long long)(uintptr_t)p;
    const unsigned lo = __builtin_amdgcn_readfirstlane((unsigned)v), hi_ = __builtin_amdgcn_readfirstlane((unsigned)(v >> 32)); return (const char*)(uintptr_t)(((unsigned long long)hi_ << 32) | lo); }
#define ATT_PK4(P, B_, OUT) do { unsigned a0 = cvtpk(P[B_+0], P[B_+1]), a1 = cvtpk(P[B_+2], P[B_+3]);                          \
        unsigned b0 = cvtpk(P[B_+4], P[B_+5]), b1 = cvtpk(P[B_+6], P[B_+7]);                                             \
        auto r0 = __builtin_amdgcn_permlane32_swap(a0, b0, false, false); auto r1 = __builtin_amdgcn_permlane32_swap(a1, b1, false, false); \
        v4u w_ = {r0[0], r1[0], r0[1], r1[1]}; OUT = __builtin_bit_cast(bf16x8, w_); } while (0)

template <int MODE>
__device__ __forceinline__ void attn_unit(LAS unsigned char* L, const bf16* __restrict__ Qp, int qpitch, const bf16* __restrict__ Kp, const bf16* __restrict__ Vp, int kvpitch,
                                          const bf16* __restrict__ KRp, const bf16* __restrict__ Gp, bf16* __restrict__ Op, int P0, float sink2, const float* __restrict__ biasp,
                                          int jlo_ovr, int jhi_ovr, float* __restrict__ Opart, float* __restrict__ MLp,
                                          gu32* cnt = nullptr, int nparts = 0, const float* Opart0 = nullptr, const float* ML0 = nullptr, volatile LAS unsigned* bflag = nullptr) {
    constexpr int NQ = (MODE == 1) ? 12 : 8;
    constexpr float THR = 8.f, NEG = -__builtin_inff();
    int tid = threadIdx.x; asm volatile("" : "+v"(tid));
    const int wid = __builtin_amdgcn_readfirstlane(tid >> 6), lane = tid & 63, r32 = lane & 31, hi = lane >> 5;
    int j_lo = 0, j_hi = P0 / 64 + 4;
    if (MODE == 0) j_lo = P0 >= 128 ? P0 / 64 - 2 : 0;
    if (MODE == 1) { j_lo = jlo_ovr; j_hi = jhi_ovr; }
    const int NT = j_hi - j_lo;
    const int qlo = P0 + wid * 32, qpos = qlo + r32;
    unsigned ko[2], vo[2];
    const char* const Kb0 = uni_ptr(Kp); const char* const Rb0 = uni_ptr(KRp);
    const unsigned vdiff = (unsigned)__builtin_amdgcn_readfirstlane((int)((const char*)Vp - (const char*)Kp));
#pragma unroll
    for (int i = 0; i < 2; ++i) { const int p = wid * 128 + i * 64 + lane;
        { const int row = p >> 4, phys = p & 15; ko[i] = (unsigned)(row * kvpitch + ((phys ^ (row & 15)) << 3)) * 2u; }
        { const int s = p >> 5, q = p & 31, kk = (s >> 2) * 8 + (q >> 2); const int vr = (kk & ~0xC) | ((kk & 4) << 1) | ((kk & 8) >> 1); vo[i] = (unsigned)(vr * kvpitch + (s & 3) * 32 + (q & 3) * 8) * 2u + vdiff; } }
    const int rp = wid * 64 + lane; const unsigned ro = (unsigned)((rp >> 3) * 64 + (((rp & 7) ^ ((rp >> 4) & 7)) << 3)) * 2u;
    const unsigned ldsK = (unsigned)(uintptr_t)(L + OFF_K) + (unsigned)wid * 2048u, ldsV = (unsigned)(uintptr_t)(L + OFF_V) + (unsigned)wid * 2048u, ldsR = (unsigned)(uintptr_t)(L + OFF_KR) + (unsigned)wid * 1024u;
    const unsigned XK = (unsigned)(r32 * 256 + ((hi ^ (r32 & 15)) << 4)), XR = (unsigned)(r32 * 128 + (((hi ^ (r32 >> 1)) & 7) << 4));
    LAS float* wsf = (LAS float*)(L + OFF_WS + wid * 256); LAS float* li_l = wsf; LAS float* al_l = wsf + 32;
    volatile LAS unsigned* flags = (volatile LAS unsigned*)(L + OFF_FLAG);
    LAS float* blut = (LAS float*)(L + OFF_LUT);
    float blv = 0.f; if (MODE == 0) { if (tid < 128) blv = biasp[tid]; }
    bf16x8 qr[NQ];
#pragma unroll
    for (int d0 = 0; d0 < NQ; ++d0) qr[d0] = *(const GAS bf16x8*)(Qp + (size_t)(wid * 32 + r32) * qpitch + d0 * 16 + hi * 8);
#define ATT_TILE(t) ((MODE == 2) ? (j_hi - 1 - (t)) : (j_lo + (t)))
#define ATT_DMA(jt, bf, vbf) do { const char* kb_ = Kb0 + (size_t)(jt) * 128 * (size_t)kvpitch; \
        glds16s(kb_, ko[0], (unsigned)__builtin_amdgcn_readfirstlane(ldsK + (bf) * SHM_T)); \
        glds16s(kb_, ko[1], (unsigned)__builtin_amdgcn_readfirstlane(ldsK + (bf) * SHM_T + 1024)); \
        glds16s(kb_, vo[0], (unsigned)__builtin_amdgcn_readfirstlane(ldsV + (vbf) * SHM_T)); \
        glds16s(kb_, vo[1], (unsigned)__builtin_amdgcn_readfirstlane(ldsV + (vbf) * SHM_T + 1024)); \
        if (MODE == 1) glds16s(Rb0 + (size_t)(jt) * 8192, ro, (unsigned)__builtin_amdgcn_readfirstlane(ldsR + (bf) * 8192)); } while (0)
    float m_reg = -1e30f, l_reg = 0.f, carry = 0.f;
    f32x16 o[4];
#pragma unroll
    for (int d = 0; d < 4; ++d)
#pragma unroll
        for (int r = 0; r < 16; ++r) o[d][r] = 0.f;
    ATT_DMA(ATT_TILE(0), 0, 0); if (MODE == 0) { if (tid < 128) blut[tid] = blv; } VM_WAIT();
#pragma unroll
    for (int d0 = 0; d0 < NQ; ++d0) asm volatile("" : "+v"(qr[d0]));
    __syncthreads();
    const unsigned vbase = (unsigned)(uintptr_t)(L + OFF_V) + (unsigned)v_rd_base(lane);
    const bool lag = (wid >= 4);
    bool pend = false; int vcur = 0, vprev = 0;
    bf16x8 pa0, pa1, pa2, pa3;
#define ATT_TRRD(dst, off) asm volatile("ds_read_b64_tr_b16 %0, %1 offset:%2" : "=&v"(dst) : "v"(vb0), "i"(off) : "memory")
#define ATT_PV(d0) do { s16x4 l0, l1, l2, l3, h0, h1, h2, h3; constexpr int b_ = v_rd_off(d0, 0, 0); \
        ATT_TRRD(l0, b_); ATT_TRRD(h0, b_ + 2048); ATT_TRRD(l1, b_ + 4096); ATT_TRRD(h1, b_ + 6144); ATT_TRRD(l2, b_ + 8192); ATT_TRRD(h2, b_ + 10240); ATT_TRRD(l3, b_ + 12288); ATT_TRRD(h3, b_ + 14336); \
        asm volatile("s_waitcnt lgkmcnt(0)" ::: "memory"); __builtin_amdgcn_sched_barrier(0); \
        o[d0] = __builtin_amdgcn_mfma_f32_32x32x16_bf16((bf16x8){l0[0], l0[1], l0[2], l0[3], h0[0], h0[1], h0[2], h0[3]}, pa0, o[d0], 0, 0, 0); \
        o[d0] = __builtin_amdgcn_mfma_f32_32x32x16_bf16((bf16x8){l1[0], l1[1], l1[2], l1[3], h1[0], h1[1], h1[2], h1[3]}, pa1, o[d0], 0, 0, 0); \
        o[d0] = __builtin_amdgcn_mfma_f32_32x32x16_bf16((bf16x8){l2[0], l2[1], l2[2], l2[3], h2[0], h2[1], h2[2], h2[3]}, pa2, o[d0], 0, 0, 0); \
        o[d0] = __builtin_amdgcn_mfma_f32_32x32x16_bf16((bf16x8){l3[0], l3[1], l3[2], l3[3], h3[0], h3[1], h3[2], h3[3]}, pa3, o[d0], 0, 0, 0); } while (0)
#define ATT_PV_ALL(vbuf) do { const unsigned vb0 = vbase + (unsigned)((vbuf) * SHM_T); __builtin_amdgcn_s_setprio(1); ATT_PV(0); ATT_PV(1); ATT_PV(2); ATT_PV(3); __builtin_amdgcn_s_setprio(0); } while (0)
    for (int t = 0; t < NT; ++t) {
        const int cur = t & 1, jt = ATT_TILE(t), kb = jt * 64;
        const bool more = (t + 1 < NT);
        vprev = vcur; vcur = t % 3;
        if (more) ATT_DMA(ATT_TILE(t + 1), cur ^ 1, (t + 1) % 3);
        if (lag && pend) { ATT_PV_ALL(vprev); pend = false; }
        bool act;
        if (MODE == 0) act = (kb <= qlo + 31) && (kb + 63 >= qlo - 127);
        else if (MODE == 1) act = (kb <= qlo + 31);
        else act = (kb < qlo + 31) && !__all(carry < -150.f);
        if (act) {
            f32x16 p0, p1;
#pragma unroll
            for (int r = 0; r < 16; ++r) { p0[r] = 0.f; p1[r] = 0.f; }
            {
                unsigned xk = XK, xr = XR; asm volatile("" : "+v"(xk), "+v"(xr));
                const unsigned kbs = (unsigned)(uintptr_t)(L + OFF_K) + (unsigned)cur * SHM_T, rbs = (unsigned)(uintptr_t)(L + OFF_KR) + (unsigned)cur * 8192u;
                bf16x8 f0, f1, f2, f3;
#define ATT_KRD(dst, addr, off) asm volatile("ds_read_b128 %0, %1 offset:%2" : "=&v"(dst) : "v"(addr), "i"(off) : "memory")
#define ATT_KISSUE(s_, A_, B_) do { if ((s_) < 8) { const unsigned a_ = (xk ^ ((unsigned)(s_) << 5)) + kbs; ATT_KRD(A_, a_, 0); ATT_KRD(B_, a_, 8192); } \
                                    else { const unsigned a_ = (xr ^ ((unsigned)((s_) - 8) << 5)) + rbs; ATT_KRD(A_, a_, 0); ATT_KRD(B_, a_, 4096); } } while (0)
                ATT_KISSUE(0, f0, f1); ATT_KISSUE(1, f2, f3);
                __builtin_amdgcn_s_setprio(1);
#pragma unroll
                for (int s = 0; s < NQ; s += 2) {
                    if (s + 1 < NQ) asm volatile("s_waitcnt lgkmcnt(2)" ::: "memory"); else asm volatile("s_waitcnt lgkmcnt(0)" ::: "memory");
                    __builtin_amdgcn_sched_barrier(0);
                    p0 = __builtin_amdgcn_mfma_f32_32x32x16_bf16(f0, qr[s], p0, 0, 0, 0); p1 = __builtin_amdgcn_mfma_f32_32x32x16_bf16(f1, qr[s], p1, 0, 0, 0);
                    __builtin_amdgcn_sched_barrier(0);
                    if (s + 2 < NQ) ATT_KISSUE(s + 2, f0, f1);
                    if (s + 2 < NQ) asm volatile("s_waitcnt lgkmcnt(2)" ::: "memory"); else asm volatile("s_waitcnt lgkmcnt(0)" ::: "memory");
                    __builtin_amdgcn_sched_barrier(0);
                    p0 = __builtin_amdgcn_mfma_f32_32x32x16_bf16(f2, qr[s + 1], p0, 0, 0, 0); p1 = __builtin_amdgcn_mfma_f32_32x32x16_bf16(f3, qr[s + 1], p1, 0, 0, 0);
                    __builtin_amdgcn_sched_barrier(0);
                    if (s + 3 < NQ) ATT_KISSUE(s + 3, f2, f3);
                }
                __builtin_amdgcn_s_setprio(0);
#undef ATT_KISSUE
#undef ATT_KRD
            }
            const int dq = qpos - kb - 4 * hi;
            if (MODE != 2) {
                if (MODE == 0) {
#pragma unroll
                    for (int r = 0; r < 16; ++r) { const int c = (r & 3) + 8 * (r >> 2); const int e0 = dq - c, e1 = dq - c - 32;
                        const float b0 = blut[e0 < 0 ? 0 : (e0 > 127 ? 127 : e0)], b1 = blut[e1 < 0 ? 0 : (e1 > 127 ? 127 : e1)];
                        p0[r] = ((unsigned)e0 < 128u) ? p0[r] + b0 : NEG; p1[r] = ((unsigned)e1 < 128u) ? p1[r] + b1 : NEG; }
                } else {
                    if (kb + 63 > qlo) {
#pragma unroll
                        for (int r = 0; r < 16; ++r) { const int c = (r & 3) + 8 * (r >> 2); if (dq - c < 0) p0[r] = NEG; if (dq - c - 32 < 0) p1[r] = NEG; }
                    }
                }
                float pmax = p0[0];
#pragma unroll
                for (int r = 1; r < 16; ++r) pmax = fmaxf(pmax, p0[r]);
#pragma unroll
                for (int r = 0; r < 16; ++r) pmax = fmaxf(pmax, p1[r]);
                { auto rr = __builtin_amdgcn_permlane32_swap(__float_as_uint(pmax), __float_as_uint(pmax), false, false); pmax = fmaxf(__uint_as_float(rr[0]), __uint_as_float(rr[1])); }
                float mn, alpha;
                if (__all(pmax - m_reg <= THR)) { mn = m_reg; alpha = 1.f; }
                else { mn = fmaxf(m_reg, pmax); alpha = __builtin_amdgcn_exp2f(m_reg - mn); m_reg = mn; }
                float ps = 0.f;
#pragma unroll
                for (int r = 0; r < 16; ++r) { p0[r] = __builtin_amdgcn_exp2f(p0[r] - mn); p1[r] = __builtin_amdgcn_exp2f(p1[r] - mn); ps += p0[r] + p1[r]; }
                { auto rr = __builtin_amdgcn_permlane32_swap(__float_as_uint(ps), __float_as_uint(ps), false, false); ps = __uint_as_float(rr[0]) + __uint_as_float(rr[1]); }
                l_reg = l_reg * alpha + ps;
                if (__any(alpha < 1.f)) {
#pragma unroll
                    for (int r = 0; r < 16; ++r)
#pragma unroll
                        for (int d = 0; d < 4; ++d) o[d][r] *= alpha;
                }
            } else {
                float T[8];
#pragma unroll
                for (int i = 0; i < 8; ++i) {
                    float x[4], zz[4];
#pragma unroll
                    for (int a = 0; a < 4; ++a) { const int r = (i & 3) * 4 + a; const float z = (i < 4) ? p0[r] : p1[r]; const int c = (r & 3) + 8 * (r >> 2) + ((i < 4) ? 0 : 32);
                        const bool past = (dq - c) > 0;
                        const float lk = -(fmaxf(z, 0.f) + __builtin_amdgcn_logf(1.0f + __builtin_amdgcn_exp2f(-fabsf(z))));
                        x[a] = past ? lk : 0.f; zz[a] = past ? (z + lk) : NEG; }
                    const float e2 = x[3], e1 = x[3] + x[2], e0 = e1 + x[1];
                    T[i] = e0 + x[0];
                    if (i < 4) { p0[(i & 3) * 4 + 0] = zz[0] + e0; p0[(i & 3) * 4 + 1] = zz[1] + e1; p0[(i & 3) * 4 + 2] = zz[2] + e2; p0[(i & 3) * 4 + 3] = zz[3]; }
                    else       { p1[(i & 3) * 4 + 0] = zz[0] + e0; p1[(i & 3) * 4 + 1] = zz[1] + e1; p1[(i & 3) * 4 + 2] = zz[2] + e2; p1[(i & 3) * 4 + 3] = zz[3]; }
                }
                float U[8], PT[8];
#pragma unroll
                for (int i = 0; i < 8; ++i) { auto rr = __builtin_amdgcn_permlane32_swap(__float_as_uint(T[i]), __float_as_uint(T[i]), false, false);
                    const float tlo = __uint_as_float(rr[0]), thi = __uint_as_float(rr[1]); U[i] = tlo + thi; PT[i] = hi ? 0.f : thi; }
                float su = carry;
#pragma unroll
                for (int i = 7; i >= 0; --i) {
                    const float A = su + PT[i];
#pragma unroll
                    for (int a = 0; a < 4; ++a) { const int r = (i & 3) * 4 + a; if (i < 4) p0[r] = __builtin_amdgcn_exp2f(p0[r] + A); else p1[r] = __builtin_amdgcn_exp2f(p1[r] + A); }
                    su += U[i];
                }
                carry = su;
            }
            ATT_PK4(p0, 0, pa0); ATT_PK4(p0, 8, pa1); ATT_PK4(p1, 0, pa2); ATT_PK4(p1, 8, pa3);
            if (lag) pend = true; else ATT_PV_ALL(vcur);
        }
        VM_WAIT();
        if (MODE == 2) { if (lane == 0) flags[cur * 8 + wid] = __all(carry < -150.f) ? 1u : 0u; }
        __syncthreads();
        if (MODE == 2) { bool alld = true;
#pragma unroll
            for (int w = 0; w < 8; ++w) alld = alld && (flags[cur * 8 + w] != 0u);
            if (alld) break; }
    }
    if (pend) { ATT_PV_ALL(vcur); }
#undef ATT_PV_ALL
#undef ATT_PV
#undef ATT_TRRD
    const int orow = wid * 32 + r32;
    const GAS unsigned char* const Gub = (const GAS unsigned char*)uni_ptr(Gp); GAS unsigned char* const Oub = (GAS unsigned char*)uni_ptr(Op);
    const unsigned goff = (unsigned)(orow * PP + 8 * hi) * 2u, yoff = (unsigned)(orow * YW + 8 * hi) * 2u;
    auto fin_d0 = [&](const int d0, const f32x16& val, const float inv, const v4u g0, const v4u g1) __attribute__((always_inline)) {
#pragma unroll
        for (int pr = 0; pr < 2; ++pr) { float x[8];
#pragma unroll
            for (int i = 0; i < 4; ++i) { auto rr = __builtin_amdgcn_permlane32_swap(__float_as_uint(val[8 * pr + i] * inv), __float_as_uint(val[8 * pr + 4 + i] * inv), false, false);
                x[i] = __uint_as_float(rr[0]); x[4 + i] = __uint_as_float(rr[1]); }
            const v4u g = pr ? g1 : g0; v4u w;
            w.x = cvtpk(x[0] * pg8::bf_lo(g.x), x[1] * pg8::bf_hi(g.x)); w.y = cvtpk(x[2] * pg8::bf_lo(g.y), x[3] * pg8::bf_hi(g.y));
            w.z = cvtpk(x[4] * pg8::bf_lo(g.z), x[5] * pg8::bf_hi(g.z)); w.w = cvtpk(x[6] * pg8::bf_lo(g.w), x[7] * pg8::bf_hi(g.w));
            *(GAS v4u*)(Oub + (yoff + (unsigned)(d0 * 32 + 16 * pr) * 2u)) = w; }
    };
    auto finish = [&](const float inv) __attribute__((always_inline)) {
        v4u gw[4][2];
#pragma unroll
        for (int d0 = 0; d0 < 4; ++d0)
#pragma unroll
            for (int pr = 0; pr < 2; ++pr) gw[d0][pr] = *(const GAS v4u*)(Gub + (goff + (unsigned)(d0 * 32 + 16 * pr) * 2u));
#pragma unroll
        for (int d0 = 0; d0 < 4; ++d0) fin_d0(d0, o[d0], inv, gw[d0][0], gw[d0][1]);
    };
    const unsigned slot16 = (unsigned)(wid * 64 + lane) * 16u;
    if (MODE == 1) {
        const char* const Pub = uni_ptr(Opart);
#pragma unroll
        for (int d0 = 0; d0 < 4; ++d0)
#pragma unroll
            for (int g = 0; g < 4; ++g) { const f32x4 v = {o[d0][4 * g], o[d0][4 * g + 1], o[d0][4 * g + 2], o[d0][4 * g + 3]};
                asm volatile("global_store_dwordx4 %0, %1, %2 sc1" :: "v"(slot16 + (unsigned)(d0 * 4 + g) * 8192u), "v"(v), "s"(Pub) : "memory"); }
        if (hi == 0) { __hip_atomic_store((GAS unsigned long long*)(MLp + (size_t)orow * 2), ((unsigned long long)__float_as_uint(l_reg) << 32) | __float_as_uint(m_reg), RLX_AGENT); }
        VM_WAIT();
        __syncthreads();
        if (tid == 0) { const unsigned old = __hip_atomic_fetch_add(cnt, 1u, RLX_AGENT); *bflag = (old + 1u == (unsigned)nparts) ? 1u : 0u; }
        __syncthreads();
        const bool lastp = (*bflag != 0u);
        if (lastp) {
            __builtin_amdgcn_fence(__ATOMIC_ACQUIRE, "agent"); VM_WAIT();
            const GAS unsigned char* const P0ub = (const GAS unsigned char*)uni_ptr(Opart0);
            f32x2 mlv[4]; float wp[4]; float mmx = -1e30f, Ls = 0.f;
#pragma unroll
            for (int p = 0; p < 4; ++p) if (p < nparts) mlv[p] = *(const GAS f32x2*)(ML0 + (size_t)p * 512 + orow * 2);
#pragma unroll
            for (int p = 0; p < 4; ++p) if (p < nparts) mmx = fmaxf(mmx, mlv[p].x);
#pragma unroll
            for (int p = 0; p < 4; ++p) { wp[p] = 0.f; if (p < nparts) { wp[p] = __builtin_amdgcn_exp2f(mlv[p].x - mmx); Ls += wp[p] * mlv[p].y; } }
            const float invL = 1.0f / Ls;
#pragma unroll
            for (int d0 = 0; d0 < 4; ++d0) {
                f32x4 pv[4][4];
#pragma unroll
                for (int g = 0; g < 4; ++g)
#pragma unroll
                    for (int p = 0; p < 4; ++p) if (p < nparts) pv[g][p] = *(const GAS f32x4*)(P0ub + (slot16 + (unsigned)p * 131072u + (unsigned)(d0 * 4 + g) * 8192u));
                const v4u g0 = *(const GAS v4u*)(Gub + (goff + (unsigned)(d0 * 32) * 2u)), g1 = *(const GAS v4u*)(Gub + (goff + (unsigned)(d0 * 32 + 16) * 2u));
                f32x16 mv;
#pragma unroll
                for (int g = 0; g < 4; ++g) { f32x4 acc4 = pv[g][0] * wp[0];
#pragma unroll
                    for (int p = 1; p < 4; ++p) if (p < nparts) acc4 += pv[g][p] * wp[p];
                    mv[4 * g] = acc4[0]; mv[4 * g + 1] = acc4[1]; mv[4 * g + 2] = acc4[2]; mv[4 * g + 3] = acc4[3]; }
                fin_d0(d0, mv, invL, g0, g1);
                asm volatile("" ::: "memory"); __builtin_amdgcn_sched_barrier(0);
            }
        }
        __syncthreads();
        return;
    }
    if (MODE == 2) finish(1.0f);
    else { const float mf = fmaxf(m_reg, sink2); const float a = __builtin_amdgcn_exp2f(m_reg - mf); finish(a / (l_reg * a + __builtin_amdgcn_exp2f(sink2 - mf))); }
    __syncthreads();
#undef ATT_TILE
#undef ATT_DMA
}
}

__device__ __forceinline__ void attn_phase(Frame& F, const Args& A, int layer, int rep) {
    volatile LAS unsigned* MISC = (volatile LAS unsigned*)(F.lds + MISC_OFF);
    gu32* qhead = F.ctl + CW_QUEUE + 64 * (2 * layer + rep);
    unsigned nid = 0u;
    if (threadIdx.x == 0) nid = __hip_atomic_fetch_add(qhead, 1u, RLX_AGENT);
    for (;;) {
        if (threadIdx.x == 0) MISC[16] = nid;
        __syncthreads();
        const unsigned id = MISC[16];
        __syncthreads();
        if (id >= 1408u) break;
        if (threadIdx.x == 0) nid = __hip_atomic_fetch_add(qhead, 1u, RLX_AGENT);
        if (id < 640u && !(ATTN_MFMA_MASK & 2)) continue;
        if (id >= 640u && id < 896u && !(ATTN_MFMA_MASK & 4)) continue;
        if (id >= 896u && !(ATTN_MFMA_MASK & 1)) continue;
        if (id < 640u) {
            int h, qb, p;
            if (id < 384u) { const int idx = (int)(id >> 2); h = (int)(id & 3);
                if (idx < 16) { qb = 16 + idx; p = 0; } else if (idx < 48) { const int k = idx - 16; qb = 32 + (k >> 1); p = k & 1; } else { const int k = idx - 48; qb = 48 + k / 3; p = k % 3; } }
            else { const int jj = (int)id - 384, c = 15 - (jj >> 4), r = jj & 15; h = r & 3; const int g = r >> 2; qb = 16 * g + c; p = g; }
            const int P0 = qb * 256, jlo = 64 * p, jhi_full = 4 * (qb + 1), jhi = (64 * (p + 1) < jhi_full) ? 64 * (p + 1) : jhi_full;
            const size_t slot = (size_t)((h * 64 + qb) * 4 + p);
            const size_t slot0 = (size_t)((h * 64 + qb) * 4);
            att::attn_unit<1>(F.lds + RING_OFF, F.QM + (size_t)P0 * 768 + h * 192, 768, F.KVM + h * 256, F.KVM + h * 256 + 128, 1024, F.KRM,
                              F.P + (size_t)P0 * PP + C_ZB + h * 128, F.Y + (size_t)P0 * YW + 1024 + h * 128, P0, 0.f, nullptr, jlo, jhi, F.OPART + slot * 32768, F.ML + slot * 512,
                              F.ctl + CW_MLACNT + 256 * layer + h * 64 + qb, (qb >> 4) + 1, F.OPART + slot0 * 32768, F.ML + slot0 * 512, MISC + 17); }
        else if (id < 896u) { const int i = (int)id - 640, qb = 63 - (i >> 2), h = i & 3, P0 = qb * 256;
            att::attn_unit<2>(F.lds + RING_OFF, F.P + (size_t)P0 * PP + C_QC + h * 128, PP, F.P + C_KC + h * 128, F.P + C_VC + h * 128, PP, nullptr,
                              F.P + (size_t)P0 * PP + C_ZC + h * 128, F.Y + (size_t)P0 * YW + 1536 + h * 128, P0, 0.f, nullptr, 0, 0, nullptr, nullptr); }
        else { const int i = (int)id - 896, qb = i >> 3, h = i & 7, P0 = qb * 256;
            att::attn_unit<0>(F.lds + RING_OFF, F.P + (size_t)P0 * PP + C_QA + h * 128, PP, F.P + C_KA + (h >> 2) * 128, F.P + C_VA + (h >> 2) * 128, PP, nullptr,
                              F.P + (size_t)P0 * PP + C_ZA + h * 128, F.Y + (size_t)P0 * YW + h * 128, P0, A.sinks[layer * 8 + h] * LOG2E, F.BLUT + h * 128, 0, 0, nullptr, nullptr); }
    }
}
__global__ void __launch_bounds__(NWAVES * 64, 2) hybrid_fwd(Args args) {
    extern __shared__ __attribute__((aligned(16))) unsigned char lds[];
    Frame F;
    F.lds = (LAS unsigned char*)lds;
    volatile LAS unsigned* MISC = (volatile LAS unsigned*)(F.lds + MISC_OFF);
    F.G = gridDim.x; F.NGW = F.G * NWAVES;
    set_ptrs(F, args.ws);
    for (int u = threadIdx.x; u < (LDS_BYTES - LDSCTL_OFF) / 4; u += NWAVES * 64) ((LAS unsigned*)(F.lds + LDSCTL_OFF))[u] = 0u;
    __syncthreads();
    XcdBarrier bar; bar.bar = (unsigned*)(F.ctl + CW_BAR); bar.x = 0; bar.st = nullptr;
    if (!MK_PER_PHASE) bar = xcd_barrier_post((unsigned*)(F.ctl + CW_BAR), MISC + 8);
    const int lo = args.ph_lo, hi = args.ph_hi;
#define IN(k) (lo <= (k) && (k) < hi)
#define SEAM(k) do { if (IN(k) && IN((k) + 1)) xcd_barrier(bar); } while (0)

    { if (IN(0)) { set_ptrs(F, args.ws); p0_prologue(F, args); set_ptrs(F, args.ws); prep_rows<0>(F, args.x, F.XB, F.RS, nullptr, nullptr, F.XQ, F.SA); } }
    SEAM(0);
    { if (IN(1)) { set_ptrs(F, args.ws); p0b_gate_quant(F, args); } }
    SEAM(1);
    for (int l = 0; l < DEPTH; ++l) {
        const int pb = 2 + 6 * l;
        { if (IN(pb) && l > 0) { set_ptrs(F, args.ws); prep_q8(F, F.XB, F.SSQ_X + (l - 1) * S, F.ROWMAX + (l - 1) * S, F.RS, F.SA, F.XQ); } }
        if (l > 0) SEAM(pb);
        { if (IN(pb + 1)) { set_ptrs(F, args.ws);
            { pg8::Gemm g{F.XB, F.Win + (size_t)l * NB * DM, S, NB, DM, DM, DM}; pg8::StaticOrder So; So.init(S, NB, F.G, (int)blockIdx.x);
              EpiInProj E{F.P, F.RS, F.KRM, F.ROPEC, F.ROPES, F.SSQ_Q + l * S, F.SSQ_KV + l * S, true};
              pg8::gemm_phase<EpiInProj, pg8::StaticOrder, true, true>(F.lds + RING_OFF, g, So, E); }
            set_ptrs(F, args.ws);
            { pg8::Gemm g{(const bf16*)F.XQ, (const bf16*)(F.WG8 + (size_t)l * NG * DM), S, NG, DM / 2, DM / 2, DM / 2}; pg8::StaticOrder So; So.init(S, NG, F.G, (int)blockIdx.x);
              EpiGateI8 E{F.P, F.RS, F.SA, F.SB + l * NG, F.SSQ_Q + l * S, F.KRM, F.ROPEC, F.ROPES, F.GT, F.SSQ_KV + l * S};
              pg8::gemm_phase<EpiGateI8, pg8::StaticOrder, true, true>(F.lds + RING_OFF, g, So, E); }
        } }
        SEAM(pb + 1);
        { if (IN(pb + 2)) { set_ptrs(F, args.ws);
            { pg8::Gemm g{F.P + C_CQ, F.Wq + (size_t)l * 768 * 1024, S, 768, 1024, PP, 1024}; pg8::StaticOrder So; So.init(S, 768, F.G, (int)blockIdx.x);
              EpiQUp E{F.QM, F.SSQ_Q + l * S, F.ROPEC, F.ROPES};
              pg8::gemm_phase<EpiQUp, pg8::StaticOrder, true, true>(F.lds + RING_OFF, g, So, E); }
            set_ptrs(F, args.ws);
            { pg8::Gemm g{F.P + C_CKV, F.Wkv + (size_t)l * 1024 * 512, S, 1024, 512, PP, 512}; pg8::StaticOrder So; So.init(S, 1024, F.G, (int)blockIdx.x);
              EpiKvUp E{F.KVM, F.SSQ_KV + l * S};
              pg8::gemm_phase<EpiKvUp, pg8::StaticOrder, true, true>(F.lds + RING_OFF, g, So, E); }
        } }
        SEAM(pb + 2);
        { if (IN(pb + 3)) { set_ptrs(F, args.ws); attn_phase(F, args, l, 0); if (ATTN_MFMA_MASK != 7) { __syncthreads(); naive_attn_phase(F, args, l); } } }
        SEAM(pb + 3);
        { if (IN(pb + 4)) {
            { set_ptrs(F, args.ws); pg8::Gemm g{F.Y, F.Wproj + (size_t)l * DM * YW, S, DM, YW, YW, YW}; pg8::StaticOrder So; So.init(S, DM, F.G, (int)blockIdx.x);
              EpiProjFused E{F.GT, F.MBF, 16, 24}; pg8::gemm_phase<EpiProjFused, pg8::StaticOrder, true, true>(F.lds + RING_OFF, g, So, E); }
        } }
        SEAM(pb + 4);
        { if (IN(pb + 5)) { set_ptrs(F, args.ws);
            pg8::Gemm g{F.MBF, F.Wout + (size_t)l * DM * DM, S, DM, DM, DM, DM}; pg8::StaticOrder So; So.init(S, DM, F.G, (int)blockIdx.x);
            EpiOut E{(l == 0) ? args.x : F.X1, (l == 0) ? F.X1 : args.out, F.XB, F.SSQ_X + l * S, F.ROWMAX + l * S, false, true, l == DEPTH - 1, l > 0, l < DEPTH - 1};
            pg8::gemm_phase<EpiOut, pg8::StaticOrder, true, true>(F.lds + RING_OFF, g, So, E);
        } }
        SEAM(pb + 5);
    }
    if (IN(14)) { set_ptrs(F, args.ws); final_norm(F, F.XB, F.SSQ_X + (DEPTH - 1) * S, args.out, args.final_g); }
#undef IN
#undef SEAM
}

extern "C" void kernel_launch(void* const* d_in, const int* in_sizes, int n_in, void* d_out, int out_size, void* d_ws, size_t ws_size, hipStream_t stream) {
    static int grid = 0;
    if (grid == 0) {
        if (n_in != 14 || in_sizes[0] != S * DM || out_size != S * DM || ws_size < WS_END) { fprintf(stderr, "kernel_launch: unexpected shapes (n_in %d, in0 %d, out %d, ws %zu)\n", n_in, n_in > 0 ? in_sizes[0] : -1, out_size, ws_size); grid = -1; return; }
        int dev = 0, cus = 0, per_cu = 0;
        if (hipGetDevice(&dev) != hipSuccess || hipDeviceGetAttribute(&cus, hipDeviceAttributeMultiprocessorCount, dev) != hipSuccess) { grid = -1; return; }
        if (hipFuncSetAttribute((const void*)hybrid_fwd, hipFuncAttributeMaxDynamicSharedMemorySize, LDS_BYTES) != hipSuccess) { fprintf(stderr, "kernel_launch: hipFuncSetAttribute failed\n"); grid = -1; return; }
        if (hipOccupancyMaxActiveBlocksPerMultiprocessor(&per_cu, (const void*)hybrid_fwd, NWAVES * 64, LDS_BYTES) != hipSuccess || per_cu < 1)
            fprintf(stderr, "kernel_launch: occupancy query reports %d workgroups per CU\n", per_cu);
        (void)hipGetLastError();
        grid = cus;
    }
    if (grid < 0) return;
    if (hipMemsetAsync((char*)d_ws + WS_CTL, 0, CTL_ZERO_BYTES, stream) != hipSuccess) { fprintf(stderr, "kernel_launch: memset failed\n"); return; }
    Args a{};
    a.x = (const float*)d_in[0]; a.norm_g = (const float*)d_in[1]; a.w_in = (const float*)d_in[2]; a.sinks = (const float*)d_in[3]; a.rel_bias = (const float*)d_in[4];
    a.g_q = (const float*)d_in[5]; a.w_q_up = (const float*)d_in[6]; a.g_kv = (const float*)d_in[7]; a.w_kv_up = (const float*)d_in[8];
    a.w_pa = (const float*)d_in[9]; a.w_pb = (const float*)d_in[10]; a.w_pc = (const float*)d_in[11]; a.w_out = (const float*)d_in[12]; a.final_g = (const float*)d_in[13];
    a.out = (float*)d_out; a.ws = (unsigned char*)d_ws;
    constexpr int NPH = 15;
    if (MK_PER_PHASE) {
        for (int p = 0; p < NPH; ++p) { a.ph_lo = p; a.ph_hi = p + 1; hipLaunchKernelGGL(hybrid_fwd, dim3(grid), dim3(NWAVES * 64), LDS_BYTES, stream, a); }
    } else {
        a.ph_lo = 0; a.ph_hi = NPH;
        hipLaunchKernelGGL(hybrid_fwd, dim3(grid), dim3(NWAVES * 64), LDS_BYTES, stream, a);
    }
    const hipError_t le = hipPeekAtLastError();
    if (le != hipSuccess) fprintf(stderr, "kernel_launch: launch failed: %s\n", hipGetErrorName(le));
}
```

```cpp
#include <hip/hip_runtime.h>
#include <cstdio>
#include <cstdint>

#ifndef MK_PER_PHASE
#define MK_PER_PHASE 0
#endif
#ifndef ATTN_MFMA_MASK
#define ATTN_MFMA_MASK 7
#endif

namespace pg8 {
#define PG8_LAS __attribute__((address_space(3)))
typedef unsigned short bf16_t;
typedef short bf16x8 __attribute__((ext_vector_type(8)));
typedef float f32x4 __attribute__((ext_vector_type(4)));
typedef float f32x2 __attribute__((ext_vector_type(2)));
typedef unsigned u32x4 __attribute__((ext_vector_type(4)));
typedef unsigned u32x2 __attribute__((ext_vector_type(2)));
typedef int i32x4 __attribute__((ext_vector_type(4)));
constexpr int BM = 256, BK = 64, HALF = 128, HTB = HALF * BK * 2, STAGE_BYTES = 8 * HTB, NXCD = 8, WGM = 8;

__host__ __device__ __forceinline__ int lds_byte(int r, int c) { const int st = (r >> 4) * 2 + (c >> 5), rr = r & 15, cc = c & 31, ob = rr * 64 + cc * 2; return st * 1024 + (ob ^ (((ob >> 9) & 1) << 5)); }
__host__ __device__ __forceinline__ void stage_rc(int b, int& R, int& C) { const int st = b / 1024, sb = b % 1024, swz = sb ^ (((sb >> 9) & 1) << 5); R = (st >> 1) * 16 + swz / 64; C = (st & 1) * 32 + (swz % 64) / 2; }
__host__ __device__ __forceinline__ int perm32(int rho) { const int n = rho >> 4, i = rho & 15; return 8 * (i >> 2) + 4 * n + (i & 3); }

struct Unit { int pm, pn; };
struct Gemm { const bf16_t* A; const bf16_t* Bt; int M, N, K, lda, ldb; };

struct StaticOrder {
    int nM, nN, nwg, G, c;
    __host__ __device__ void init(int M, int N, int G_, int c_) { nM = M / BM; nN = N / BM; nwg = nM * nN; G = G_; c = c_; }
    __host__ __device__ bool next(int i, Unit& u) const {
        const long L = (long)i * G + c; if (L >= nwg) return false;
        int wgid = (int)L; { const int q = nwg / NXCD, r = nwg % NXCD, xcd = wgid % NXCD, off = wgid / NXCD; wgid = (xcd < r ? xcd * (q + 1) : r * (q + 1) + (xcd - r) * q) + off; }
        const int nig = WGM * nN, gid = wgid / nig, fm = gid * WGM, gsz = (nM - fm) < WGM ? (nM - fm) : WGM;
        u.pm = fm + ((wgid % nig) % gsz); u.pn = (wgid % nig) / gsz; return true;
    }
    __device__ __forceinline__ void a_ready(const Unit&) const {}
    __device__ __forceinline__ void done(const Unit&) const {}
};

__device__ __forceinline__ unsigned cvt_pk_bf16(float lo, float hi) { unsigned r; asm volatile("v_cvt_pk_bf16_f32 %0, %1, %2" : "=v"(r) : "v"(lo), "v"(hi)); return r; }
__device__ __forceinline__ unsigned cvt_pk_f16(float lo, float hi) { typedef _Float16 h2 __attribute__((ext_vector_type(2))); h2 v; v.x = (_Float16)lo; v.y = (_Float16)hi; return __builtin_bit_cast(unsigned, v); }
__device__ __forceinline__ float bf_lo(unsigned w) { return __uint_as_float(w << 16); }
__device__ __forceinline__ float bf_hi(unsigned w) { return __uint_as_float(w & 0xffff0000u); }

__device__ __forceinline__ f32x4 mma16(bf16x8 b, bf16x8 a, f32x4 c) { return __builtin_amdgcn_mfma_f32_16x16x32_bf16(b, a, c, 0, 0, 0); }
__device__ __forceinline__ i32x4 mma16(bf16x8 b, bf16x8 a, i32x4 c) { return __builtin_amdgcn_mfma_i32_16x16x64_i8(__builtin_bit_cast(i32x4, b), __builtin_bit_cast(i32x4, a), c, 0, 0, 0); }
template <class Epi, class Sched, bool ALIGN_EPI = false, bool SP2 = false>
__device__ __forceinline__ void gemm_phase(PG8_LAS unsigned char* lds, const Gemm g, const Sched& S, const Epi& E) {
    int tid = threadIdx.x; asm volatile("" : "+v"(tid));
    const int wid = __builtin_amdgcn_readfirstlane(tid >> 6), lane = tid & 63, wr = wid >> 2, wc = wid & 3, fr = lane & 15, fq = lane >> 4;
    const int K = g.K, nt = K / BK;
    unsigned voffA[2], voffB[2];
#pragma unroll
    for (int i = 0; i < 2; ++i) { int R, C; stage_rc(tid * 16 + i * 8192, R, C); const int Rb = Epi::PERM ? ((R & ~31) + perm32(R & 31)) : R;
        voffA[i] = (unsigned)(R * g.lda + C) * 2u; voffB[i] = (unsigned)(Rb * g.ldb + C) * 2u; }
    const size_t kstep = (size_t)(BK * 2);
    const size_t hstepA = (size_t)HALF * g.lda * 2, hstepB = (size_t)HALF * g.ldb * 2;
    const size_t tstepA = 2 * hstepA, tstepB = 2 * hstepB;
    const unsigned ldsw = (unsigned)wid * 1024u;
    const int aoff = lds_byte(wr * 64 + fr, fq * 8), boff = lds_byte(wc * 32 + fr, fq * 8);
#define PG8_SA(b, h) (((b) * 2 + (h)) * HTB)
#define PG8_SB(b, h) ((4 + (b) * 2 + (h)) * HTB)
#define PG8_STAGE(bufoff, gbase, voff) do { _Pragma("unroll") for (int _i = 0; _i < 2; ++_i) \
        __builtin_amdgcn_global_load_lds((const unsigned*)((const char*)(gbase) + (voff)[_i]), (PG8_LAS unsigned*)(lds + (bufoff) + ldsw + _i * 8192), 16, 0, 0); } while (0)
#define PG8_LDA(dst, b, h) do { _Pragma("unroll") for (int m = 0; m < 4; ++m) _Pragma("unroll") for (int k = 0; k < 2; ++k) dst[m][k] = *(const PG8_LAS bf16x8*)(lds + PG8_SA(b, h) + aoff + m * 2048 + k * 1024); } while (0)
#define PG8_LDB(dst, b, h) do { _Pragma("unroll") for (int n = 0; n < 2; ++n) _Pragma("unroll") for (int k = 0; k < 2; ++k) dst[n][k] = *(const PG8_LAS bf16x8*)(lds + PG8_SB(b, h) + boff + n * 2048 + k * 1024); } while (0)
#define PG8_MMA(ai, bj, At, Bt) do { __builtin_amdgcn_s_setprio(1); _Pragma("unroll") for (int m = 0; m < 4; ++m) _Pragma("unroll") for (int n = 0; n < 2; ++n) _Pragma("unroll") for (int k = 0; k < 2; ++k) \
        acc[ai][bj][m][n] = mma16(Bt[n][k], At[m][k], acc[ai][bj][m][n]); __builtin_amdgcn_s_setprio(0); } while (0)
#define PG8_WAIT_V(n) asm volatile("s_waitcnt vmcnt(" #n ")" ::: "memory")
#define PG8_WAIT_L(n) asm volatile("s_waitcnt lgkmcnt(" #n ")" ::: "memory")
#define PG8_BAR __builtin_amdgcn_s_barrier()
#define PG8_SCHED __builtin_amdgcn_sched_barrier(0)
    Unit cur, nxt; int ui = 0;
    if (!S.next(0, cur)) return;
    typedef typename Epi::acc_t acc_t;
    acc_t acc[2][2][4][2];
#pragma unroll
    for (int a = 0; a < 2; ++a)
#pragma unroll
        for (int b = 0; b < 2; ++b)
#pragma unroll
            for (int m = 0; m < 4; ++m)
#pragma unroll
                for (int n = 0; n < 2; ++n) acc[a][b][m][n] = (acc_t){0, 0, 0, 0};
    bf16x8 At[4][2], B0[2][2], B1[2][2];
    const char* cA = (const char*)g.A + (size_t)cur.pm * tstepA; const char* cB = (const char*)g.Bt + (size_t)cur.pn * tstepB;
    S.a_ready(cur);
    if constexpr (SP2) {
        PG8_STAGE(PG8_SB(0, 0), cB, voffB); PG8_STAGE(PG8_SB(0, 1), cB + hstepB, voffB); PG8_STAGE(PG8_SA(0, 0), cA, voffA); PG8_STAGE(PG8_SA(0, 1), cA + hstepA, voffA);
        if (wr == 1) PG8_BAR;
        PG8_WAIT_V(2); PG8_BAR;
        PG8_STAGE(PG8_SB(1, 0), cB + kstep, voffB); PG8_STAGE(PG8_SA(1, 0), cA + kstep, voffA); PG8_STAGE(PG8_SB(1, 1), cB + hstepB + kstep, voffB);
        PG8_WAIT_V(6); PG8_BAR;
    } else {
        PG8_STAGE(PG8_SB(0, 0), cB, voffB); PG8_STAGE(PG8_SA(0, 0), cA, voffA); PG8_STAGE(PG8_SB(0, 1), cB + hstepB, voffB); PG8_STAGE(PG8_SA(0, 1), cA + hstepA, voffA);
        if (wr == 1) PG8_BAR;
        PG8_WAIT_V(4); PG8_BAR;
        PG8_STAGE(PG8_SB(1, 0), cB + kstep, voffB); PG8_STAGE(PG8_SA(1, 0), cA + kstep, voffA); PG8_STAGE(PG8_SB(1, 1), cB + hstepB + kstep, voffB);
        PG8_WAIT_V(6); PG8_BAR;
    }
    for (;;) {
        const bool has_next = S.next(ui + 1, nxt);
        const char* nA = has_next ? (const char*)g.A + (size_t)nxt.pm * tstepA : cA; const char* nB = has_next ? (const char*)g.Bt + (size_t)nxt.pn * tstepB : cB;
        for (int t = 0; t < nt; t += 2) {
            const bool last = (t == nt - 2);
            const char* a1 = cA + (size_t)(t + 1) * kstep;
            const char* a2 = last ? nA : cA + (size_t)(t + 2) * kstep; const char* b2 = last ? nB : cB + (size_t)(t + 2) * kstep;
            const char* a3 = a2 + kstep; const char* b3 = b2 + kstep;
            if (last && has_next) S.a_ready(nxt);
            if constexpr (Epi::MID) { if (t == E.t1 || t == E.t2) E.mid(acc, cur, t == E.t2, wr, wc, fr, fq); }
            if constexpr (SP2) {
            PG8_LDB(B0, 0, 0); PG8_LDB(B1, 0, 1); PG8_SCHED; PG8_LDA(At, 0, 0); PG8_STAGE(PG8_SA(1, 1), a1 + hstepA, voffA);
            PG8_WAIT_V(8); PG8_WAIT_L(0); PG8_BAR; PG8_MMA(0, 0, At, B0); PG8_MMA(0, 1, At, B1); PG8_BAR; PG8_SCHED;
            PG8_LDA(At, 0, 1); PG8_STAGE(PG8_SB(0, 0), b2, voffB); PG8_STAGE(PG8_SB(0, 1), b2 + hstepB, voffB); PG8_STAGE(PG8_SA(0, 0), a2, voffA);
            PG8_WAIT_V(8); PG8_WAIT_L(0); PG8_BAR; PG8_MMA(1, 0, At, B0); PG8_MMA(1, 1, At, B1); PG8_BAR; PG8_SCHED;
            PG8_LDB(B0, 1, 0); PG8_LDB(B1, 1, 1); PG8_SCHED; PG8_LDA(At, 1, 0); PG8_STAGE(PG8_SA(0, 1), a2 + hstepA, voffA);
            PG8_WAIT_V(8); PG8_WAIT_L(0); PG8_BAR; PG8_MMA(0, 0, At, B0); PG8_MMA(0, 1, At, B1); PG8_BAR; PG8_SCHED;
            PG8_LDA(At, 1, 1); PG8_STAGE(PG8_SB(1, 0), b3, voffB); PG8_STAGE(PG8_SB(1, 1), b3 + hstepB, voffB); PG8_STAGE(PG8_SA(1, 0), a3, voffA);
            PG8_WAIT_V(8); PG8_WAIT_L(0); PG8_BAR; PG8_MMA(1, 0, At, B0); PG8_MMA(1, 1, At, B1); PG8_BAR; PG8_SCHED;
            } else {
            PG8_LDB(B0, 0, 0); PG8_SCHED; PG8_LDA(At, 0, 0); PG8_STAGE(PG8_SA(1, 1), a1 + hstepA, voffA);
            PG8_WAIT_L(8); PG8_BAR; PG8_WAIT_L(0); PG8_MMA(0, 0, At, B0); PG8_BAR; PG8_SCHED;
            PG8_LDB(B1, 0, 1); PG8_STAGE(PG8_SB(0, 0), b2, voffB);
            PG8_BAR; PG8_WAIT_L(0); PG8_MMA(0, 1, At, B1); PG8_BAR;
            PG8_LDA(At, 0, 1); PG8_STAGE(PG8_SA(0, 0), a2, voffA);
            PG8_BAR; PG8_WAIT_L(0); PG8_MMA(1, 0, At, B0); PG8_BAR; PG8_SCHED;
            PG8_STAGE(PG8_SB(0, 1), b2 + hstepB, voffB);
            PG8_WAIT_V(6); PG8_BAR; PG8_MMA(1, 1, At, B1); PG8_BAR;
            PG8_LDB(B0, 1, 0); PG8_SCHED; PG8_LDA(At, 1, 0); PG8_STAGE(PG8_SA(0, 1), a2 + hstepA, voffA);
            PG8_WAIT_L(8); PG8_BAR; PG8_WAIT_L(0); PG8_MMA(0, 0, At, B0); PG8_BAR; PG8_SCHED;
            PG8_LDB(B1, 1, 1); PG8_STAGE(PG8_SB(1, 0), b3, voffB);
            PG8_BAR; PG8_WAIT_L(0); PG8_MMA(0, 1, At, B1); PG8_BAR;
            PG8_LDA(At, 1, 1); PG8_STAGE(PG8_SA(1, 0), a3, voffA);
            PG8_BAR; PG8_WAIT_L(0); PG8_MMA(1, 0, At, B0); PG8_BAR; PG8_SCHED;
            PG8_STAGE(PG8_SB(1, 1), b3 + hstepB, voffB);
            PG8_WAIT_V(6); PG8_BAR; PG8_MMA(1, 1, At, B1); PG8_BAR;
            }
        }
        if constexpr (ALIGN_EPI) { if (wr == 0) PG8_BAR; }
        E(acc, cur, wr, wc, fr, fq); S.done(cur);
        if (!has_next) break;
#pragma unroll
        for (int a = 0; a < 2; ++a)
#pragma unroll
            for (int b = 0; b < 2; ++b)
#pragma unroll
                for (int m = 0; m < 4; ++m)
#pragma unroll
                    for (int n = 0; n < 2; ++n) acc[a][b][m][n] = (acc_t){0, 0, 0, 0};
        cur = nxt; cA = nA; cB = nB; ++ui;
        if constexpr (ALIGN_EPI) { if (wr == 1) PG8_BAR; }
    }
    PG8_WAIT_V(0);
    if constexpr (!ALIGN_EPI) { if (wr == 0) PG8_BAR; }
    PG8_BAR;
#undef PG8_SA
#undef PG8_SB
#undef PG8_STAGE
#undef PG8_LDA
#undef PG8_LDB
#undef PG8_MMA
#undef PG8_WAIT_V
#undef PG8_WAIT_L
#undef PG8_BAR
#undef PG8_SCHED
}
}

constexpr int NWAVES = 8;
constexpr int S = 16384, DM = 4096, DEPTH = 2;
constexpr int PP = 6656;
constexpr int NP = 19200;
constexpr int IN_COLS = 19008;
constexpr int NB = 2048;
constexpr int NG = 17152;
__host__ __device__ constexpr int bf_tile_col(int t) { return t < 2 ? 4096 + 256 * t : 5120 + 256 * (t - 2); }
constexpr int C_QA = 0, C_KA = 1024, C_VA = 1280, C_ZA = 1536, C_CQ = 2560, C_CKV = 3584, C_ZB = 4096, C_QC = 4608, C_KC = 5120, C_VC = 5632, C_ZC = 6144,
              C_GA = 6656, C_GB = 10752, C_GC = 14848, C_KR = 18944;
constexpr float EPS = 1e-6f;
constexpr float LOG2E = 1.4426950408889634f;
constexpr float SC128 = 0.08838834764831845f * LOG2E;
constexpr float SC192 = 0.07216878364870322f * LOG2E;
constexpr int YW = 2048;

constexpr size_t MiB = 1u << 20;
constexpr size_t WS_CTL = 0, CTL_ZERO_BYTES = 1 * MiB;
constexpr size_t WS_RS = 1 * MiB;
constexpr size_t WS_RSQ = WS_RS + 65536, WS_RSKV = WS_RSQ + 65536;
constexpr size_t WS_ROPEC = 2 * MiB, WS_ROPES = 4 * MiB;
constexpr size_t WS_WQ = 6 * MiB;
constexpr size_t WS_WKV = 10 * MiB;
constexpr size_t WS_WPROJ = 16 * MiB;
constexpr size_t WS_WOUT = 48 * MiB;
constexpr size_t WS_WIN = 112 * MiB;
constexpr size_t WS_WG8 = 210 * MiB;
constexpr size_t WS_XQ = 344 * MiB;
constexpr size_t WS_SA = WS_RS + 3 * 65536;
constexpr size_t WS_SB = WS_RS + 4 * 65536;
constexpr size_t WS_XB = 416 * MiB;
constexpr size_t WS_P = 544 * MiB;
constexpr size_t WS_GT = 752 * MiB;
constexpr size_t WS_QM = 1144 * MiB;
constexpr size_t WS_KVM = 1168 * MiB;
constexpr size_t WS_KRM = 1200 * MiB;
constexpr size_t WS_Y = 1204 * MiB;
constexpr size_t WS_MBF = 1524 * MiB;
constexpr size_t WS_X1 = 1652 * MiB;
constexpr size_t WS_OPART = 1908 * MiB;
constexpr size_t WS_ML = 2036 * MiB;
constexpr size_t WS_END = 2040 * MiB;
static_assert(WS_WIN + (size_t)2 * NB * DM * 2 <= WS_WG8 && WS_WG8 + (size_t)2 * NG * DM <= WS_XQ && WS_XQ + (size_t)S * DM <= WS_XB && WS_P + (size_t)S * PP * 2 <= WS_GT && WS_GT + (size_t)3 * S * DM * 2 <= WS_QM && WS_SB + 2 * NG * 4 <= WS_ROPEC, "ws map");
constexpr int CW_TMO = 0, CW_CODE = 1;
constexpr int CW_BAR = 4096;
constexpr int CW_MLACNT = 20480;
constexpr int CW_QUEUE = 16384;
constexpr size_t CTL_COLMAX = 640 * 1024;
constexpr size_t CTL_BLUT = 904 * 1024;
constexpr size_t CTL_ROWMAX = 776 * 1024;
constexpr size_t CTL_SSQ_Q = 256 * 1024, CTL_SSQ_KV = 384 * 1024, CTL_SSQ_X = 512 * 1024;

constexpr int RING_OFF = 0, RING_BYTES = 131072;
constexpr int LDSCTL_OFF = RING_BYTES, MISC_OFF = LDSCTL_OFF + 320;
constexpr int LDS_BYTES = 147456;

#define GAS __attribute__((address_space(1)))
#define LAS __attribute__((address_space(3)))
typedef unsigned short bf16;
typedef unsigned v4u __attribute__((ext_vector_type(4)));
typedef unsigned v2u __attribute__((ext_vector_type(2)));
typedef float f32x4 __attribute__((ext_vector_type(4)));
typedef float f32x2 __attribute__((ext_vector_type(2)));
typedef short bf16x8 __attribute__((ext_vector_type(8)));
typedef GAS unsigned gu32;
#define RLX_AGENT __ATOMIC_RELAXED, __HIP_MEMORY_SCOPE_AGENT
#define LDS_WAIT() asm volatile("s_waitcnt lgkmcnt(0)" ::: "memory")
#define VM_WAIT() asm volatile("s_waitcnt vmcnt(0)" ::: "memory")
__device__ __forceinline__ unsigned f2bf(float f) { unsigned u = __builtin_bit_cast(unsigned, f); return (u + 0x7fffu + ((u >> 16) & 1u)) >> 16; }
__device__ __forceinline__ unsigned pk2(float lo, float hi) { return f2bf(lo) | (f2bf(hi) << 16); }
__device__ __forceinline__ float bf2f(unsigned short b) { return __uint_as_float(((unsigned)b) << 16); }

#define XB_TMO      128
#define XB_XCNT(j)  (256  + 64 * (j))
#define XB_XSUB(j)  (1280 + 64 * (j))
#define XB_XGEN(j)  (2304 + 64 * (j))
#define XB_TOP      3328
#define XB_TOPGEN   3392
#define XCD_BAR_WORDS 3456
#define XB_SPIN_CAP (1u << 18)
__device__ __forceinline__ unsigned xb_ld(unsigned* p)              { return __hip_atomic_load(p, __ATOMIC_RELAXED, __HIP_MEMORY_SCOPE_AGENT); }
__device__ __forceinline__ unsigned xb_add(unsigned* p, unsigned v) { return __hip_atomic_fetch_add(p, v, __ATOMIC_RELAXED, __HIP_MEMORY_SCOPE_AGENT); }
__device__ __forceinline__ unsigned xb_xcc_id() { return (unsigned)__builtin_amdgcn_s_getreg((3 << 11) | 20) & 0xFu; }
#define XB_SPIN(cond, bar) do { unsigned _sp = 0; while (cond) { __builtin_amdgcn_s_sleep(1); \
    if ((++_sp & 255u) == 0u) { if (xb_ld(&(bar)[XB_TMO])) break; if (_sp > XB_SPIN_CAP) { atomicAdd(&(bar)[XB_TMO], 1u); break; } } } } while (0)
struct XcdBarrier { unsigned* bar; unsigned x; volatile LAS unsigned* st; };
__device__ __forceinline__ XcdBarrier xcd_barrier_post(unsigned* bar, volatile LAS unsigned* st) {
    XcdBarrier b; b.bar = bar; b.x = xb_xcc_id(); b.st = st;
    if (threadIdx.x == 0) (void)xb_add(&bar[XB_XCNT(b.x)], 1u);
    return b;
}
__device__ __forceinline__ void xcd_barrier_complete(unsigned* bar, unsigned x, unsigned& nloc, unsigned& nx) {
    const unsigned G = gridDim.x * gridDim.y * gridDim.z;
    unsigned sum, cnt, mine, sp = 0u;
    for (;;) {
        sum = 0u; cnt = 0u; mine = 0u;
#pragma unroll
        for (unsigned j = 0; j < 16; ++j) { const unsigned c = xb_ld(&bar[XB_XCNT(j)]); sum += c; cnt += (c > 0u) ? 1u : 0u; mine = (j == x) ? c : mine; }
        if (sum == G) break;
        __builtin_amdgcn_s_sleep(1);
        if ((++sp & 255u) == 0u) { if (xb_ld(&bar[XB_TMO])) break; if (sp > XB_SPIN_CAP) { atomicAdd(&bar[XB_TMO], 1u); break; } }
    }
    nloc = mine > 0u ? mine : 1u; nx = cnt > 0u ? cnt : 1u;
}
__device__ __forceinline__ void xcd_barrier(const XcdBarrier& b) {
    asm volatile("s_waitcnt vmcnt(0)" ::: "memory");
    __syncthreads();
    if (threadIdx.x == 0) {
        unsigned* bar = b.bar;
        __builtin_amdgcn_s_waitcnt(0);
        unsigned nloc = b.st[0], nx = b.st[1];
        if (nloc == 0u) { xcd_barrier_complete(bar, b.x, nloc, nx); b.st[0] = nloc; b.st[1] = nx; }
        const unsigned old = xb_add(&bar[XB_XSUB(b.x)], 1u);
        const unsigned gen = old / nloc;
        if (old + 1u == (gen + 1u) * nloc) {
            __builtin_amdgcn_fence(__ATOMIC_RELEASE, "agent");
            asm volatile("s_waitcnt vmcnt(0)" ::: "memory");
            const unsigned og = xb_add(&bar[XB_TOP], 1u);
            const unsigned tg = og / nx;
            if (og + 1u == (tg + 1u) * nx) xb_add(&bar[XB_TOPGEN], 1u);
            else XB_SPIN(xb_ld(&bar[XB_TOPGEN]) == tg, bar);
            __builtin_amdgcn_fence(__ATOMIC_ACQUIRE, "agent");
            xb_add(&bar[XB_XGEN(b.x)], 1u);
            asm volatile("s_waitcnt vmcnt(0)" ::: "memory");
        } else {
            XB_SPIN(xb_ld(&bar[XB_XGEN(b.x)]) == gen, bar);
            __builtin_amdgcn_fence(__ATOMIC_ACQUIRE, "agent");
            asm volatile("s_waitcnt vmcnt(0)" ::: "memory");
        }
    }
    __syncthreads();
}

struct Args {
    const float* x; const float* norm_g; const float* w_in; const float* sinks; const float* rel_bias; const float* g_q; const float* w_q_up; const float* g_kv; const float* w_kv_up;
    const float* w_pa; const float* w_pb; const float* w_pc; const float* w_out; const float* final_g;
    float* out; unsigned char* ws; int ph_lo, ph_hi;
};
struct Frame {
    LAS unsigned char* lds;
    gu32* ctl;
    int tid, lane, wave, G, gw, NGW;
    bf16 *Win, *Wout, *Wproj, *Wq, *Wkv, *XB, *P, *QM, *KVM, *KRM, *Y, *MBF; unsigned char* GT; signed char *WG8, *XQ; float *SA, *SB; unsigned* COLMAX;
    float *RS, *RSQ, *RSKV, *ROPEC, *ROPES, *X1, *OPART, *ML, *SSQ_Q, *SSQ_KV, *SSQ_X, *BLUT; unsigned* ROWMAX;
};
__device__ __forceinline__ void set_ptrs(Frame& F, unsigned char* ws_) {
    GAS unsigned char* wsg = (GAS unsigned char*)ws_; asm volatile("" : "+s"(wsg)); unsigned char* ws = (unsigned char*)wsg;
    { int t = threadIdx.x; asm volatile("" : "+v"(t)); F.tid = t; F.lane = t & 63; F.wave = __builtin_amdgcn_readfirstlane(t >> 6); F.gw = blockIdx.x * NWAVES + F.wave; }
    F.ctl = (gu32*)(ws + WS_CTL);
    F.Win = (bf16*)(ws + WS_WIN); F.Wout = (bf16*)(ws + WS_WOUT); F.Wproj = (bf16*)(ws + WS_WPROJ); F.Wq = (bf16*)(ws + WS_WQ); F.Wkv = (bf16*)(ws + WS_WKV);
    F.XB = (bf16*)(ws + WS_XB); F.P = (bf16*)(ws + WS_P); F.QM = (bf16*)(ws + WS_QM); F.KVM = (bf16*)(ws + WS_KVM); F.KRM = (bf16*)(ws + WS_KRM); F.Y = (bf16*)(ws + WS_Y); F.MBF = (bf16*)(ws + WS_MBF); F.GT = ws + WS_GT;
    F.RS = (float*)(ws + WS_RS); F.RSQ = (float*)(ws + WS_RSQ); F.RSKV = (float*)(ws + WS_RSKV); F.ROPEC = (float*)(ws + WS_ROPEC); F.ROPES = (float*)(ws + WS_ROPES);
    F.X1 = (float*)(ws + WS_X1); F.OPART = (float*)(ws + WS_OPART); F.ML = (float*)(ws + WS_ML);
    F.WG8 = (signed char*)(ws + WS_WG8); F.XQ = (signed char*)(ws + WS_XQ); F.SA = (float*)(ws + WS_SA); F.SB = (float*)(ws + WS_SB); F.COLMAX = (unsigned*)(ws + WS_CTL + CTL_COLMAX);
    F.SSQ_Q = (float*)(ws + WS_CTL + CTL_SSQ_Q); F.SSQ_KV = (float*)(ws + WS_CTL + CTL_SSQ_KV); F.SSQ_X = (float*)(ws + WS_CTL + CTL_SSQ_X); F.ROWMAX = (unsigned*)(ws + WS_CTL + CTL_ROWMAX); F.BLUT = (float*)(ws + WS_CTL + CTL_BLUT);
}
__device__ __forceinline__ float wave_sum(float v) {
#pragma unroll
    for (int o = 1; o < 64; o <<= 1) v += __shfl_xor(v, o);
    return v;
}
__device__ __forceinline__ float wave_max(float v) {
#pragma unroll
    for (int o = 1; o < 64; o <<= 1) v = fmaxf(v, __shfl_xor(v, o));
    return v;
}

__device__ const unsigned char T5B[128] = {0, 1, 2, 3, 4, 5, 6, 7, 8, 9, 10, 11, 12, 13, 14, 15, 16, 16, 16, 17, 17, 18, 18, 18, 19, 19, 19, 20, 20, 20, 20, 21, 21, 21, 21, 22, 22, 22, 22, 22, 23, 23, 23, 23, 23, 23, 24, 24, 24, 24, 24, 24, 25, 25, 25, 25, 25, 25, 25, 26, 26, 26, 26, 26, 26, 26, 26, 27, 27, 27, 27, 27, 27, 27, 27, 27, 27, 28, 28, 28, 28, 28, 28, 28, 28, 28, 28, 29, 29, 29, 29, 29, 29, 29, 29, 29, 29, 29, 29, 30, 30, 30, 30, 30, 30, 30, 30, 30, 30, 30, 30, 30, 30, 31, 31, 31, 31, 31, 31, 31, 31, 31, 31, 31, 31, 31, 31, 31};

__device__ const float ROPE_INV[32] = {1.000000000e+00f, 7.498942614e-01f, 5.623413324e-01f, 4.216965139e-01f, 3.162277639e-01f, 2.371373773e-01f, 1.778279394e-01f, 1.333521307e-01f, 1.000000015e-01f, 7.498941571e-02f, 5.623413250e-02f, 4.216965288e-02f, 3.162277490e-02f, 2.371373773e-02f, 1.778279431e-02f, 1.333521493e-02f, 9.999999776e-03f, 7.498941850e-03f, 5.623413250e-03f, 4.216964822e-03f, 3.162277630e-03f, 2.371373586e-03f, 1.778279431e-03f, 1.333521446e-03f, 1.000000047e-03f, 7.498942432e-04f, 5.623413017e-04f, 4.216965172e-04f, 3.162277571e-04f, 2.371373703e-04f, 1.778279402e-04f, 1.333521504e-04f};
template <int MAP> __device__ __forceinline__ int src_col(int n) {
    if (MAP == 1) { const int pc = bf_tile_col(n >> 8) + (n & 255); return pc < 4096 ? pc : pc + 64; }
    if (MAP == 3) {
        if (n < 12288) return 6720 + n; if (n < 13312) return n - 12288; if (n < 14336) return 2560 + (n - 13312); if (n < 14592) return 1024 + (n - 14336); if (n < 15104) return 4672 + (n - 14592);
        if (n >= 16640) return 3584 + (n - 16640);
        if (n >= 16384) return 1280 + (n - 16384);
        if (n >= 15360) return 1536 + (n - 15360);
        const int r = n - 15104; return r < 64 ? 4096 + ((r & 1) ? 32 + (r >> 1) : (r >> 1)) : -1; }
    if (MAP == 2) { const int h = n / 192, c = n % 192; if (c < 128) return n; const int j = c - 128; return h * 192 + 128 + ((j & 1) ? 32 + (j >> 1) : (j >> 1)); }
    return n;
}
template <int MAP>
__device__ __forceinline__ void conv_item(const float* W, int Nsrc, const float* g, bf16* WT, int ldd, int dk0, int nblk, LAS float* scr, int item, int lane) {
    const int kb = item / nblk, nb = item % nblk, k0 = 64 * kb, n0 = 32 * nb;
    const int sc = src_col<MAP>(n0 + (lane & 31));
    const GAS float* wp = (const GAS float*)W + (size_t)(k0 + (lane >> 5)) * Nsrc + (sc >= 0 ? sc : 0);
    float v[32];
#pragma unroll
    for (int i = 0; i < 32; ++i) v[i] = __builtin_nontemporal_load(wp + (size_t)(2 * i) * Nsrc);
    const int c = lane & 7;
    f32x4 g0 = {1.f, 1.f, 1.f, 1.f}, g1 = {1.f, 1.f, 1.f, 1.f};
    if (g) { g0 = *(const GAS f32x4*)(g + k0 + 8 * c); g1 = *(const GAS f32x4*)(g + k0 + 8 * c + 4); }
#pragma unroll
    for (int i = 0; i < 32; ++i) scr[(2 * i + (lane >> 5)) * 33 + (lane & 31)] = (sc >= 0) ? v[i] : 0.f;
    LDS_WAIT(); asm volatile("" ::: "memory");
#pragma unroll
    for (int j = 0; j < 4; ++j) { const int n = (lane >> 3) + 8 * j; const LAS float* s = scr + (8 * c) * 33 + n;
        v4u o; o.x = pk2(s[0 * 33] * g0[0], s[1 * 33] * g0[1]); o.y = pk2(s[2 * 33] * g0[2], s[3 * 33] * g0[3]); o.z = pk2(s[4 * 33] * g1[0], s[5 * 33] * g1[1]); o.w = pk2(s[6 * 33] * g1[2], s[7 * 33] * g1[3]);
        *(GAS v4u*)(WT + (size_t)(n0 + n) * ldd + dk0 + k0 + 8 * c) = o; }
    LDS_WAIT(); asm volatile("" ::: "memory");
}
__device__ __forceinline__ void gate_max_item(const float* W, const float* g, unsigned* colmax, int item, int lane) {
    const int kb = item / (NG / 32), nb = item % (NG / 32), k0 = 64 * kb, n0 = 32 * nb;
    const int sc = src_col<3>(n0 + (lane & 31));
    const GAS float* wp = (const GAS float*)W + (size_t)(k0 + (lane >> 5)) * IN_COLS + (sc >= 0 ? sc : 0);
    float v[32];
#pragma unroll
    for (int i = 0; i < 32; ++i) v[i] = __builtin_nontemporal_load(wp + (size_t)(2 * i) * IN_COLS);
    if (sc < 0) {
#pragma unroll
        for (int i = 0; i < 32; ++i) v[i] = 0.f; }
    float m = 0.f;
#pragma unroll
    for (int i = 0; i < 32; ++i) m = fmaxf(m, fabsf(v[i] * g[k0 + 2 * i + (lane >> 5)]));
    m = fmaxf(m, __shfl_xor(m, 32));
    if (lane < 32) atomicMax(colmax + n0 + lane, __float_as_uint(m));
}
__device__ __forceinline__ void gate_quant_item(const float* W, const float* g, const unsigned* colmax, signed char* WQ, float* sb, LAS float* scr, int item, int lane) {
    const int kb = item / (NG / 32), nb = item % (NG / 32), k0 = 64 * kb, n0 = 32 * nb;
    const int sc = src_col<3>(n0 + (lane & 31));
    const GAS float* wp = (const GAS float*)W + (size_t)(k0 + (lane >> 5)) * IN_COLS + (sc >= 0 ? sc : 0);
    float v[32];
#pragma unroll
    for (int i = 0; i < 32; ++i) v[i] = __builtin_nontemporal_load(wp + (size_t)(2 * i) * IN_COLS);
    if (sc < 0) {
#pragma unroll
        for (int i = 0; i < 32; ++i) v[i] = 0.f; }
    const float cm = __uint_as_float(colmax[n0 + (lane & 31)]); const float inv = cm > 0.f ? 127.0f / cm : 0.f;
    if (kb == 0 && lane < 32) sb[n0 + lane] = cm * (1.0f / 127.0f);
#pragma unroll
    for (int i = 0; i < 32; ++i) { const int kk = 2 * i + (lane >> 5); float q = __builtin_rintf(v[i] * g[k0 + kk] * inv); q = fminf(fmaxf(q, -127.f), 127.f); scr[kk * 33 + (lane & 31)] = q; }
    LDS_WAIT(); asm volatile("" ::: "memory");
    const int n = lane >> 1, hf = lane & 1;
    unsigned w[8];
#pragma unroll
    for (int d = 0; d < 8; ++d) { unsigned x = 0;
#pragma unroll
        for (int b = 0; b < 4; ++b) x |= ((unsigned)(int)scr[(32 * hf + 4 * d + b) * 33 + n] & 0xffu) << (8 * b);
        w[d] = x; }
    GAS v4u* dst = (GAS v4u*)(WQ + (size_t)(n0 + n) * DM + k0 + 32 * hf);
    dst[0] = (v4u){w[0], w[1], w[2], w[3]}; dst[1] = (v4u){w[4], w[5], w[6], w[7]};
    LDS_WAIT(); asm volatile("" ::: "memory");
}
__device__ __forceinline__ void sincos_d(double a, float& sn, float& cs) {
    const double q = __builtin_rint(a * 0.63661977236758134308);
    double r = __builtin_fma(-q, 1.57079632679489655800e+00, a); r = __builtin_fma(-q, 6.12323399573676603587e-17, r);
    const double r2 = r * r;
    double ps = r2 * (1.0 / 6227020800.0) - (1.0 / 39916800.0); ps = ps * r2 + (1.0 / 362880.0); ps = ps * r2 - (1.0 / 5040.0); ps = ps * r2 + (1.0 / 120.0); ps = ps * r2 - (1.0 / 6.0); ps = ps * r2 * r + r;
    double pc = r2 * (1.0 / 87178291200.0) - (1.0 / 479001600.0); pc = pc * r2 + (1.0 / 3628800.0); pc = pc * r2 - (1.0 / 40320.0); pc = pc * r2 + (1.0 / 720.0); pc = pc * r2 - (1.0 / 24.0); pc = pc * r2 + 0.5; pc = 1.0 - pc * r2;
    const int qi = ((int)q) & 3;
    const double s_ = (qi == 0) ? ps : (qi == 1) ? pc : (qi == 2) ? -ps : -pc;
    const double c_ = (qi == 0) ? pc : (qi == 1) ? -ps : (qi == 2) ? -pc : ps;
    sn = (float)s_; cs = (float)c_;
}
__device__ __forceinline__ void p0_prologue(Frame& F, const Args& A) {
    LAS float* scr = (LAS float*)(F.lds + RING_OFF + F.wave * 16384);
    constexpr int I_GM = 64 * (NG / 32), I_IN = 64 * (NB / 32), I_Q = 16 * (768 / 32), I_KV = 8 * (1024 / 32), I_PA = 16 * 128, I_PB = 8 * 128, I_PC = 8 * 128, I_O = 64 * 128;
    constexpr int PER_L = I_GM + I_IN + I_Q + I_KV + I_PA + I_PB + I_PC + I_O;
    for (int it = F.gw; it < DEPTH * PER_L; it += F.NGW) {
        const int l = it / PER_L; int r = it % PER_L;
        if (r < I_GM) { gate_max_item(A.w_in + (size_t)l * DM * IN_COLS, A.norm_g + l * DM, F.COLMAX + l * NG, r, F.lane); continue; } r -= I_GM;
        if (r < I_IN) { conv_item<1>(A.w_in + (size_t)l * DM * IN_COLS, IN_COLS, A.norm_g + l * DM, F.Win + (size_t)l * NB * DM, DM, 0, NB / 32, scr, r, F.lane); continue; } r -= I_IN;
        if (r < I_Q) { conv_item<2>(A.w_q_up + (size_t)l * 1024 * 768, 768, A.g_q + l * 1024, F.Wq + (size_t)l * 768 * 1024, 1024, 0, 768 / 32, scr, r, F.lane); continue; } r -= I_Q;
        if (r < I_KV) { conv_item<0>(A.w_kv_up + (size_t)l * 512 * 1024, 1024, A.g_kv + l * 512, F.Wkv + (size_t)l * 1024 * 512, 512, 0, 1024 / 32, scr, r, F.lane); continue; } r -= I_KV;
        if (r < I_PA) { conv_item<0>(A.w_pa + (size_t)l * 1024 * DM, DM, nullptr, F.Wproj + (size_t)l * DM * YW, YW, 0, 128, scr, r, F.lane); continue; } r -= I_PA;
        if (r < I_PB) { conv_item<0>(A.w_pb + (size_t)l * 512 * DM, DM, nullptr, F.Wproj + (size_t)l * DM * YW, YW, 1024, 128, scr, r, F.lane); continue; } r -= I_PB;
        if (r < I_PC) { conv_item<0>(A.w_pc + (size_t)l * 512 * DM, DM, nullptr, F.Wproj + (size_t)l * DM * YW, YW, 1536, 128, scr, r, F.lane); continue; } r -= I_PC;
        conv_item<0>(A.w_out + (size_t)l * DM * DM, DM, nullptr, F.Wout + (size_t)l * DM * DM, DM, 0, 128, scr, r, F.lane);
    }
    if (blockIdx.x == 0) { for (int i = threadIdx.x; i < 8 * 128; i += NWAVES * 64) F.BLUT[i] = A.rel_bias[(int)T5B[i & 127] * 8 + (i >> 7)] * LOG2E; }
    for (int i = F.gw * 64 + F.lane; i < S * 32; i += F.NGW * 64) {
        const int pos = i >> 5, j = i & 31;
        const float inv = ROPE_INV[j];
        const float ang = (float)pos * inv;
        float sn, cs; sincos_d((double)ang, sn, cs);
        F.ROPEC[i] = cs; F.ROPES[i] = sn;
    }
}
__device__ __forceinline__ void p0b_gate_quant(Frame& F, const Args& A) {
    LAS float* scr = (LAS float*)(F.lds + RING_OFF + F.wave * 16384);
    constexpr int I_GM = 64 * (NG / 32);
    for (int it = F.gw; it < DEPTH * I_GM; it += F.NGW) { const int l = it / I_GM, r = it % I_GM;
        gate_quant_item(A.w_in + (size_t)l * DM * IN_COLS, A.norm_g + l * DM, F.COLMAX + l * NG, F.WG8 + (size_t)l * NG * DM, F.SB + l * NG, scr, r, F.lane); }
}
template <int MODE>
__device__ __forceinline__ void prep_rows(Frame& F, const float* X, bf16* XBo, float* RSo, float* OUT, const float* gfin, signed char* XQo = nullptr, float* SAo = nullptr) {
    for (int m = F.gw; m < S; m += F.NGW) {
        const GAS f32x4* xr = (const GAS f32x4*)(X + (size_t)m * DM) + F.lane;
        f32x4 v[16]; float s = 0.f;
#pragma unroll
        for (int j = 0; j < 16; ++j) { v[j] = __builtin_nontemporal_load(xr + 64 * j); s += (v[j].x * v[j].x + v[j].y * v[j].y) + (v[j].z * v[j].z + v[j].w * v[j].w); }
        float mx = 0.f;
        if (MODE == 0) {
#pragma unroll
            for (int j = 0; j < 16; ++j) mx = fmaxf(fmaxf(mx, fmaxf(fabsf(v[j].x), fabsf(v[j].y))), fmaxf(fabsf(v[j].z), fabsf(v[j].w)));
            mx = wave_max(mx); }
        const float ssum = wave_sum(s); const float rs = 1.0f / sqrtf(ssum * (1.0f / DM) + EPS);
        if (MODE == 0) {
            if (F.lane == 0) RSo[m] = ssum;
            GAS v2u* o8 = (GAS v2u*)(XBo + (size_t)m * DM) + F.lane;
#pragma unroll
            for (int j = 0; j < 16; ++j) { v2u w; w.x = pk2(v[j].x, v[j].y); w.y = pk2(v[j].z, v[j].w); o8[64 * j] = w; }
            if (F.lane == 0) SAo[m] = mx * (1.0f / 127.0f);
            const float inv = mx > 0.f ? 127.0f / mx : 0.f;
            GAS unsigned* q4 = (GAS unsigned*)(XQo + (size_t)m * DM) + F.lane;
#pragma unroll
            for (int j = 0; j < 16; ++j) { const int a = (int)__builtin_rintf(v[j].x * inv), b = (int)__builtin_rintf(v[j].y * inv), c = (int)__builtin_rintf(v[j].z * inv), d = (int)__builtin_rintf(v[j].w * inv);
                q4[64 * j] = ((unsigned)a & 0xffu) | (((unsigned)b & 0xffu) << 8) | (((unsigned)c & 0xffu) << 16) | (((unsigned)d & 0xffu) << 24); }
        } else {
            GAS f32x4* o = (GAS f32x4*)(OUT + (size_t)m * DM) + F.lane; const GAS f32x4* gg = (const GAS f32x4*)gfin + F.lane;
#pragma unroll
            for (int j = 0; j < 16; ++j) { const f32x4 gv = gg[64 * j]; o[64 * j] = v[j] * rs * gv; }
        }
    }
}

__device__ __forceinline__ void prep_q8(Frame& F, const bf16* XBi, const float* ssx, const unsigned* rmx, float* RSo, float* SAo, signed char* XQo) {
    for (int m = F.gw; m < S; m += F.NGW) {
        const GAS v4u* xr = (const GAS v4u*)(XBi + (size_t)m * DM) + F.lane;
        v4u v[8];
#pragma unroll
        for (int j = 0; j < 8; ++j) v[j] = xr[64 * j];
        const float mx = __uint_as_float(rmx[m]), inv = mx > 0.f ? 127.0f / mx : 0.f;
        if (F.lane == 0) { RSo[m] = ssx[m]; SAo[m] = mx * (1.0f / 127.0f); }
        GAS v2u* q8 = (GAS v2u*)(XQo + (size_t)m * DM) + F.lane;
#pragma unroll
        for (int j = 0; j < 8; ++j) { unsigned o2[2];
#pragma unroll
            for (int h = 0; h < 2; ++h) { const unsigned w0 = h ? v[j].z : v[j].x, w1 = h ? v[j].w : v[j].y;
                const int a = (int)__builtin_rintf(pg8::bf_lo(w0) * inv), b = (int)__builtin_rintf(pg8::bf_hi(w0) * inv), c = (int)__builtin_rintf(pg8::bf_lo(w1) * inv), d = (int)__builtin_rintf(pg8::bf_hi(w1) * inv);
                o2[h] = ((unsigned)a & 0xffu) | (((unsigned)b & 0xffu) << 8) | (((unsigned)c & 0xffu) << 16) | (((unsigned)d & 0xffu) << 24); }
            v2u w; w.x = o2[0]; w.y = o2[1]; q8[64 * j] = w; }
    }
}

__device__ __forceinline__ void final_norm(Frame& F, const bf16* XBi, const float* ssx, float* OUT, const float* gfin) {
    f32x4 gk[8][2];
    { const GAS f32x4* gg = (const GAS f32x4*)gfin + 2 * F.lane;
#pragma unroll
      for (int j = 0; j < 8; ++j) { gk[j][0] = gg[128 * j]; gk[j][1] = gg[128 * j + 1]; } }
    for (int m = F.gw; m < S; m += F.NGW) {
        const GAS v4u* xr = (const GAS v4u*)(XBi + (size_t)m * DM) + F.lane;
        v4u v[8];
#pragma unroll
        for (int j = 0; j < 8; ++j) v[j] = xr[64 * j];
        const float rs = 1.0f / sqrtf(ssx[m] * (1.0f / DM) + EPS);
        GAS f32x4* o = (GAS f32x4*)(OUT + (size_t)m * DM) + 2 * F.lane;
#pragma unroll
        for (int j = 0; j < 8; ++j) { const f32x4 g0 = gk[j][0], g1 = gk[j][1];
            f32x4 a = {pg8::bf_lo(v[j].x), pg8::bf_hi(v[j].x), pg8::bf_lo(v[j].y), pg8::bf_hi(v[j].y)}, b = {pg8::bf_lo(v[j].z), pg8::bf_hi(v[j].z), pg8::bf_lo(v[j].w), pg8::bf_hi(v[j].w)};
            o[128 * j] = a * rs * g0; o[128 * j + 1] = b * rs * g1; }
    }
}

using pg8::f32x4; using pg8::Unit;
__device__ __forceinline__ float fast_sigmoid(float v) { return __builtin_amdgcn_rcpf(1.0f + __builtin_amdgcn_exp2f(-v * LOG2E)); }
__device__ __forceinline__ void atomic_addf(float* p, float v) { unsafeAtomicAdd(p, v); }
struct EpiInProj {
    static constexpr bool PERM = true, AFTER_DRAIN = false, MID = false; typedef pg8::f32x4 acc_t;
    bf16* P; const float* rs; bf16* KRM; const float* ropeC; const float* ropeS; float* ssq_q; float* ssq_kv; bool stats;
    __device__ __forceinline__ void operator()(const f32x4 (&acc)[2][2][4][2], const Unit& u, int wr, int wc, int fr, int fq) const {
        const int pn = u.pn;
        const int pcb = bf_tile_col(u.pn), po = pcb >> 8;
        const int ty = po < 4 ? 1 : po < 6 ? 0 : po < 10 ? 2 : po < 16 ? 0 : po < 18 ? 2 : po < 20 ? 1 : po < 24 ? 0 : 2;
        const int row0 = u.pm * 256 + wr * 64 + fr, col0 = pcb + wc * 32 + 8 * fq;
        float srow[2][4];
#pragma unroll
        for (int ai = 0; ai < 2; ++ai)
#pragma unroll
            for (int m = 0; m < 4; ++m) srow[ai][m] = rs[row0 + ai * 128 + m * 16];
#pragma unroll
        for (int ai = 0; ai < 2; ++ai)
#pragma unroll
            for (int m = 0; m < 4; ++m) srow[ai][m] = 1.0f / sqrtf(srow[ai][m] * (1.0f / DM) + EPS);
#pragma unroll
        for (int ai = 0; ai < 2; ++ai)
#pragma unroll
            for (int m = 0; m < 4; ++m) {
                const int row = row0 + ai * 128 + m * 16; const float s = srow[ai][m];
                bf16* rowp = P + (size_t)row * PP + col0; float ssl = 0.f;
#pragma unroll
                for (int bj = 0; bj < 2; ++bj) {
                    f32x4 v0 = acc[ai][bj][m][0] * s, v1 = acc[ai][bj][m][1] * s;
                    pg8::u32x4 w;
                    if (ty == 3) {
#pragma unroll
                        for (int j = 0; j < 4; ++j) { v0[j] = fast_sigmoid(v0[j]); v1[j] = fast_sigmoid(v1[j]); }
                        w.x = pg8::cvt_pk_f16(v0[0], v0[1]); w.y = pg8::cvt_pk_f16(v0[2], v0[3]); w.z = pg8::cvt_pk_f16(v1[0], v1[1]); w.w = pg8::cvt_pk_f16(v1[2], v1[3]);
                        *(pg8::u32x4*)(rowp + bj * 128) = w;
                    } else if (ty == 4) {
                        if (bj == 0 && wc < 2) {
                            const int j0 = wc * 16 + 4 * fq;
                            const f32x4 c = *(const f32x4*)(ropeC + (size_t)row * 32 + j0), sn = *(const f32x4*)(ropeS + (size_t)row * 32 + j0);
                            const float a0 = v0[0] * c[0] - v0[1] * sn[0], b0 = v0[1] * c[0] + v0[0] * sn[0];
                            const float a1 = v0[2] * c[1] - v0[3] * sn[1], b1 = v0[3] * c[1] + v0[2] * sn[1];
                            const float a2 = v1[0] * c[2] - v1[1] * sn[2], b2 = v1[1] * c[2] + v1[0] * sn[2];
                            const float a3 = v1[2] * c[3] - v1[3] * sn[3], b3 = v1[3] * c[3] + v1[2] * sn[3];
                            w.x = pg8::cvt_pk_bf16(a0, b0); w.y = pg8::cvt_pk_bf16(a1, b1); w.z = pg8::cvt_pk_bf16(a2, b2); w.w = pg8::cvt_pk_bf16(a3, b3);
                            *(pg8::u32x4*)(KRM + (size_t)row * 64 + wc * 32 + 8 * fq) = w;
                        }
                    } else {
                        if (po >= 10 && po < 16) ssl += (v0[0] * v0[0] + v0[1] * v0[1]) + (v0[2] * v0[2] + v0[3] * v0[3]) + (v1[0] * v1[0] + v1[1] * v1[1]) + (v1[2] * v1[2] + v1[3] * v1[3]);
                        if (ty == 1) { v0 = v0 * SC128; v1 = v1 * SC128; }
                        if (ty == 2) {
#pragma unroll
                            for (int j = 0; j < 4; ++j) { v0[j] = v0[j] * fast_sigmoid(v0[j]); v1[j] = v1[j] * fast_sigmoid(v1[j]); }
                        }
                        w.x = pg8::cvt_pk_bf16(v0[0], v0[1]); w.y = pg8::cvt_pk_bf16(v0[2], v0[3]); w.z = pg8::cvt_pk_bf16(v1[0], v1[1]); w.w = pg8::cvt_pk_bf16(v1[2], v1[3]);
                        *(pg8::u32x4*)(rowp + bj * 128) = w;
                    }
                }
                if (stats && po >= 10 && po < 16) { ssl += __shfl_xor(ssl, 16); ssl += __shfl_xor(ssl, 32); if (fq == 0) atomic_addf((po < 14 ? ssq_q : ssq_kv) + row, ssl); }
            }
    }
};
struct EpiGateI8 {
    static constexpr bool PERM = true, AFTER_DRAIN = false, MID = false; typedef pg8::i32x4 acc_t;
    bf16* P; const float* rs; const float* sa; const float* sb; float* ssq_q; bf16* KRM; const float* ropeC; const float* ropeS; unsigned char* GT; float* ssq_kv;
    __device__ __forceinline__ void operator()(const pg8::i32x4 (&acc)[2][2][4][2], const Unit& u, int wr, int wc, int fr, int fq) const {
        const int t = u.pn;
        const int ty = t < 48 ? 0 : t < 52 ? 1 : t < 56 ? 2 : t < 57 ? 3 : t < 59 ? 1 : t < 60 ? 4 : t < 64 ? 5 : t < 65 ? 3 : 6;
        const int row0 = u.pm * 256 + wr * 64 + fr, colw = wc * 32 + 8 * fq, col0 = t * 256 + colw;
        const int pcol = (t < 48 ? C_GA + t * 256 : t < 52 ? C_QA + (t - 48) * 256 : t < 56 ? C_CQ + (t - 52) * 256 : t < 57 ? C_KA : t < 59 ? C_QC + (t - 57) * 256 : t < 60 ? 0 : t < 64 ? C_ZA + (t - 60) * 256 : t < 65 ? C_VA : C_CKV + (t - 65) * 256) + colw;
        const float tsc = ty == 0 ? -LOG2E : ty == 1 ? SC128 : 1.0f;
        f32x4 cs[2][2];
#pragma unroll
        for (int bj = 0; bj < 2; ++bj) { cs[bj][0] = *(const f32x4*)(sb + col0 + bj * 128) * tsc; cs[bj][1] = *(const f32x4*)(sb + col0 + bj * 128 + 4) * tsc; }
        float srow[2][4], arow[2][4];
#pragma unroll
        for (int ai = 0; ai < 2; ++ai)
#pragma unroll
            for (int m = 0; m < 4; ++m) { srow[ai][m] = rs[row0 + ai * 128 + m * 16]; arow[ai][m] = sa[row0 + ai * 128 + m * 16]; }
#pragma unroll
        for (int ai = 0; ai < 2; ++ai)
#pragma unroll
            for (int m = 0; m < 4; ++m) srow[ai][m] = arow[ai][m] / sqrtf(srow[ai][m] * (1.0f / DM) + EPS);
#pragma unroll
        for (int ai = 0; ai < 2; ++ai)
#pragma unroll
            for (int m = 0; m < 4; ++m) {
                const int row = row0 + ai * 128 + m * 16; const float s = srow[ai][m];
                bf16* rowp = P + (size_t)row * PP + pcol; float ssl = 0.f;
#pragma unroll
                for (int bj = 0; bj < 2; ++bj) {
                    float v[8]; pg8::u32x4 w;
#pragma unroll
                    for (int j = 0; j < 8; ++j) v[j] = (float)acc[ai][bj][m][j >> 2][j & 3] * s * cs[bj][j >> 2][j & 3];
                    if (ty == 0) {
#pragma unroll
                        for (int j = 0; j < 8; ++j) v[j] = 1.0f + __builtin_amdgcn_exp2f(v[j]);
                        w.x = __builtin_bit_cast(unsigned, __builtin_amdgcn_cvt_pkrtz(v[0], v[1])); w.y = __builtin_bit_cast(unsigned, __builtin_amdgcn_cvt_pkrtz(v[2], v[3])); w.z = __builtin_bit_cast(unsigned, __builtin_amdgcn_cvt_pkrtz(v[4], v[5])); w.w = __builtin_bit_cast(unsigned, __builtin_amdgcn_cvt_pkrtz(v[6], v[7]));
                        *(GAS pg8::u32x4*)((GAS unsigned char*)GT + ((unsigned)(t * 64 + u.pm) * 131072u + (unsigned)((ai * 4 + m) * 2 + bj) * 8192u + (unsigned)(((wr * 4 + wc) * 64 + fq * 16 + fr) * 16))) = w;
                    } else if (ty == 4) {
                        if (bj == 0 && wc < 2) {
                            const int j0 = wc * 16 + 4 * fq;
                            const f32x4 c = *(const f32x4*)(ropeC + (size_t)row * 32 + j0), sn = *(const f32x4*)(ropeS + (size_t)row * 32 + j0);
                            w.x = pg8::cvt_pk_bf16(v[0] * c[0] - v[1] * sn[0], v[1] * c[0] + v[0] * sn[0]); w.y = pg8::cvt_pk_bf16(v[2] * c[1] - v[3] * sn[1], v[3] * c[1] + v[2] * sn[1]);
                            w.z = pg8::cvt_pk_bf16(v[4] * c[2] - v[5] * sn[2], v[5] * c[2] + v[4] * sn[2]); w.w = pg8::cvt_pk_bf16(v[6] * c[3] - v[7] * sn[3], v[7] * c[3] + v[6] * sn[3]);
                            *(pg8::u32x4*)(KRM + (size_t)row * 64 + wc * 32 + 8 * fq) = w;
                        }
                    } else {
                        if (ty == 5) {
#pragma unroll
                            for (int j = 0; j < 8; ++j) v[j] = v[j] * fast_sigmoid(v[j]); }
                        if (ty == 2 || ty == 6) ssl += (v[0] * v[0] + v[1] * v[1]) + (v[2] * v[2] + v[3] * v[3]) + (v[4] * v[4] + v[5] * v[5]) + (v[6] * v[6] + v[7] * v[7]);
                        w.x = pg8::cvt_pk_bf16(v[0], v[1]); w.y = pg8::cvt_pk_bf16(v[2], v[3]); w.z = pg8::cvt_pk_bf16(v[4], v[5]); w.w = pg8::cvt_pk_bf16(v[6], v[7]);
                        *(pg8::u32x4*)(rowp + bj * 128) = w;
                    }
                }
                if (ty == 2 || ty == 6) { ssl += __shfl_xor(ssl, 16); ssl += __shfl_xor(ssl, 32); if (fq == 0) atomic_addf((ty == 2 ? ssq_q : ssq_kv) + row, ssl); }
            }
    }
};
struct EpiQUp {
    static constexpr bool PERM = true, AFTER_DRAIN = false, MID = false; typedef pg8::f32x4 acc_t;
    bf16* QM; const float* rsq; const float* ropeC; const float* ropeS;
    __device__ __forceinline__ void operator()(const f32x4 (&acc)[2][2][4][2], const Unit& u, int wr, int wc, int fr, int fq) const {
        const int row0 = u.pm * 256 + wr * 64 + fr, col0 = u.pn * 256 + wc * 32 + 8 * fq;
        float srow[2][4];
#pragma unroll
        for (int ai = 0; ai < 2; ++ai)
#pragma unroll
            for (int m = 0; m < 4; ++m) srow[ai][m] = rsq[row0 + ai * 128 + m * 16];
        const int cb0 = (u.pn * 256 + wc * 32) % 192, cb1 = (u.pn * 256 + wc * 32 + 128) % 192;
        const int rbj = __builtin_amdgcn_readfirstlane(cb0 >= 128 ? 0 : cb1 >= 128 ? 1 : -1);
        f32x4 ccv[2][4], snv[2][4];
        if (rbj >= 0) { const int j0r = (((rbj ? cb1 : cb0) - 128) >> 1) + 4 * fq;
#pragma unroll
            for (int ai = 0; ai < 2; ++ai)
#pragma unroll
                for (int m = 0; m < 4; ++m) { const size_t ro = (size_t)(row0 + ai * 128 + m * 16) * 32 + j0r; ccv[ai][m] = *(const f32x4*)(ropeC + ro); snv[ai][m] = *(const f32x4*)(ropeS + ro); } }
#pragma unroll
        for (int ai = 0; ai < 2; ++ai)
#pragma unroll
            for (int m = 0; m < 4; ++m) {
                const int row = row0 + ai * 128 + m * 16; const float s = SC192 / sqrtf(srow[ai][m] * (1.0f / 1024.0f) + EPS);
#pragma unroll
                for (int bj = 0; bj < 2; ++bj) {
                    const int col = col0 + bj * 128, c = col % 192;
                    f32x4 v0 = acc[ai][bj][m][0] * s, v1 = acc[ai][bj][m][1] * s;
                    pg8::u32x4 w;
                    if (bj == rbj) {
                        const f32x4 cc = ccv[ai][m], sn = snv[ai][m];
                        const float a0 = v0[0] * cc[0] - v0[1] * sn[0], b0 = v0[1] * cc[0] + v0[0] * sn[0];
                        const float a1 = v0[2] * cc[1] - v0[3] * sn[1], b1 = v0[3] * cc[1] + v0[2] * sn[1];
                        const float a2 = v1[0] * cc[2] - v1[1] * sn[2], b2 = v1[1] * cc[2] + v1[0] * sn[2];
                        const float a3 = v1[2] * cc[3] - v1[3] * sn[3], b3 = v1[3] * cc[3] + v1[2] * sn[3];
                        w.x = pg8::cvt_pk_bf16(a0, b0); w.y = pg8::cvt_pk_bf16(a1, b1); w.z = pg8::cvt_pk_bf16(a2, b2); w.w = pg8::cvt_pk_bf16(a3, b3);
                    } else {
                        w.x = pg8::cvt_pk_bf16(v0[0], v0[1]); w.y = pg8::cvt_pk_bf16(v0[2], v0[3]); w.z = pg8::cvt_pk_bf16(v1[0], v1[1]); w.w = pg8::cvt_pk_bf16(v1[2], v1[3]);
                    }
                    *(pg8::u32x4*)(QM + (size_t)row * 768 + col) = w;
                }
            }
    }
};
struct EpiKvUp {
    static constexpr bool PERM = true, AFTER_DRAIN = false, MID = false; typedef pg8::f32x4 acc_t;
    bf16* KVM; const float* rskv;
    __device__ __forceinline__ void operator()(const f32x4 (&acc)[2][2][4][2], const Unit& u, int wr, int wc, int fr, int fq) const {
        const int row0 = u.pm * 256 + wr * 64 + fr, col0 = u.pn * 256 + wc * 32 + 8 * fq;
        float srow[2][4];
#pragma unroll
        for (int ai = 0; ai < 2; ++ai)
#pragma unroll
            for (int m = 0; m < 4; ++m) srow[ai][m] = rskv[row0 + ai * 128 + m * 16];
#pragma unroll
        for (int ai = 0; ai < 2; ++ai)
#pragma unroll
            for (int m = 0; m < 4; ++m) {
                const int row = row0 + ai * 128 + m * 16; const float s = 1.0f / sqrtf(srow[ai][m] * (1.0f / 512.0f) + EPS);
#pragma unroll
                for (int bj = 0; bj < 2; ++bj) {
                    const f32x4 v0 = acc[ai][bj][m][0] * s, v1 = acc[ai][bj][m][1] * s;
                    pg8::u32x4 w; w.x = pg8::cvt_pk_bf16(v0[0], v0[1]); w.y = pg8::cvt_pk_bf16(v0[2], v0[3]); w.z = pg8::cvt_pk_bf16(v1[0], v1[1]); w.w = pg8::cvt_pk_bf16(v1[2], v1[3]);
                    *(pg8::u32x4*)(KVM + (size_t)row * 1024 + col0 + bj * 128) = w;
                }
            }
    }
};
struct EpiProjFused {
    static constexpr bool PERM = true, AFTER_DRAIN = false, MID = true; typedef pg8::f32x4 acc_t;
    const unsigned char* GT; bf16* MBF; int t1, t2;
    typedef _Float16 h8 __attribute__((ext_vector_type(8)));
    __device__ __forceinline__ void mid(f32x4 (&acc)[2][2][4][2], const Unit& u, bool second, int wr, int wc, int fr, int fq) const {
        const unsigned slot = (unsigned)(((wr * 4 + wc) * 64 + fq * 16 + fr) * 16);
        const unsigned gx = (unsigned)(((second ? 16 : 0) + u.pn) * 64 + u.pm) * 131072u + slot, gy = gx + 16u * 64u * 131072u;
        const GAS unsigned char* Gb = (const GAS unsigned char*)GT;
        h8 XA[2][2], YA[2][2], XB[2][2], YB[2][2];
#define HK_LOAD(X_, Y_, ai_, mp_) do { _Pragma("unroll") for (int mm = 0; mm < 2; ++mm) _Pragma("unroll") for (int bj = 0; bj < 2; ++bj) { \
            const unsigned co = (unsigned)(((ai_) * 4 + (mp_) * 2 + mm) * 2 + bj) * 8192u; X_[mm][bj] = *(const GAS h8*)(Gb + (gx + co)); Y_[mm][bj] = *(const GAS h8*)(Gb + (gy + co)); } } while (0)
#define HK_APPLY(X_, Y_, ai_, mp_) do { _Pragma("unroll") for (int mm = 0; mm < 2; ++mm) _Pragma("unroll") for (int bj = 0; bj < 2; ++bj) _Pragma("unroll") for (int j = 0; j < 8; ++j) { \
            const float r = (float)Y_[mm][bj][j] * __builtin_amdgcn_rcpf((float)X_[mm][bj][j]); acc[ai_][bj][(mp_) * 2 + mm][j >> 2][j & 3] *= r; } } while (0)
        HK_LOAD(XA, YA, 0, 0); HK_LOAD(XB, YB, 0, 1); __builtin_amdgcn_sched_barrier(0);
        HK_APPLY(XA, YA, 0, 0); __builtin_amdgcn_sched_barrier(0); HK_LOAD(XA, YA, 1, 0); __builtin_amdgcn_sched_barrier(0);
        HK_APPLY(XB, YB, 0, 1); __builtin_amdgcn_sched_barrier(0); HK_LOAD(XB, YB, 1, 1); __builtin_amdgcn_sched_barrier(0);
        HK_APPLY(XA, YA, 1, 0); __builtin_amdgcn_sched_barrier(0);
        HK_APPLY(XB, YB, 1, 1);
        asm volatile("" ::: "memory");
#undef HK_LOAD
#undef HK_APPLY
    }
    __device__ __forceinline__ void operator()(const f32x4 (&acc)[2][2][4][2], const Unit& u, int wr, int wc, int fr, int fq) const {
        const int row0 = u.pm * 256 + wr * 64 + fr, col0 = u.pn * 256 + wc * 32 + 8 * fq;
        h8 Gall[2][4][2];
        { const GAS unsigned char* gb_ = (const GAS unsigned char*)GT + ((unsigned)((32 + u.pn) * 64 + u.pm) * 131072u + (unsigned)(((wr * 4 + wc) * 64 + fq * 16 + fr) * 16));
#pragma unroll
          for (int ai = 0; ai < 2; ++ai)
#pragma unroll
            for (int m = 0; m < 4; ++m)
#pragma unroll
                for (int bj = 0; bj < 2; ++bj) Gall[ai][m][bj] = *(const GAS h8*)(gb_ + (unsigned)((ai * 4 + m) * 2 + bj) * 8192u); }
#pragma unroll
        for (int ai = 0; ai < 2; ++ai)
#pragma unroll
            for (int m = 0; m < 4; ++m) {
                const int row = row0 + ai * 128 + m * 16;
#pragma unroll
                for (int bj = 0; bj < 2; ++bj) {
                    const h8 G = Gall[ai][m][bj];
                    float v[8];
#pragma unroll
                    for (int j = 0; j < 8; ++j) v[j] = acc[ai][bj][m][j >> 2][j & 3] * __builtin_amdgcn_rcpf((float)G[j]);
                    pg8::u32x4 w; w.x = pg8::cvt_pk_bf16(v[0], v[1]); w.y = pg8::cvt_pk_bf16(v[2], v[3]); w.z = pg8::cvt_pk_bf16(v[4], v[5]); w.w = pg8::cvt_pk_bf16(v[6], v[7]);
                    *(pg8::u32x4*)(MBF + (size_t)row * DM + col0 + bj * 128) = w;
                }
            }
    }
};
struct EpiOut {
    static constexpr bool PERM = false, AFTER_DRAIN = false, MID = false; typedef pg8::f32x4 acc_t;
    const float* Xp; float* Xn; bf16* XBn; float* ssx; unsigned* rmx; bool LAST; bool stats; bool FIN; bool TIN; bool TOUT;
    __device__ __forceinline__ void operator()(const f32x4 (&acc)[2][2][4][2], const Unit& u, int wr, int wc, int fr, int fq) const {
        const int row0 = u.pm * 256 + wr * 64 + fr, col0 = u.pn * 256 + wc * 32 + 4 * fq;
        const unsigned tb = (unsigned)(u.pn * 64 + u.pm) * 262144u + (unsigned)(((wr * 4 + wc) * 64 + fq * 16 + fr) * 16), rb = ((unsigned)row0 * (unsigned)DM + (unsigned)col0) * 4u;
        const unsigned ib = TIN ? tb : rb, ob = TOUT ? tb : rb;
        const unsigned is_ai = TIN ? 16u * 8192u : 128u * DM * 4u, is_m = TIN ? 4u * 8192u : 16u * DM * 4u, is_bj = TIN ? 2u * 8192u : 512u, is_n = TIN ? 8192u : 64u;
        const unsigned os_ai = TOUT ? 16u * 8192u : 128u * DM * 4u, os_m = TOUT ? 4u * 8192u : 16u * DM * 4u, os_bj = TOUT ? 2u * 8192u : 512u, os_n = TOUT ? 8192u : 64u;
#pragma unroll
        for (int ai = 0; ai < 2; ++ai) {
            f32x4 xin[4][2][2];
#pragma unroll
            for (int m = 0; m < 4; ++m)
#pragma unroll
                for (int bj = 0; bj < 2; ++bj)
#pragma unroll
                    for (int n = 0; n < 2; ++n) xin[m][bj][n] = *(const GAS f32x4*)((const GAS unsigned char*)Xp + (ib + ai * is_ai + m * is_m + bj * is_bj + n * is_n));
#pragma unroll
            for (int m = 0; m < 4; ++m) {
                const int row = row0 + ai * 128 + m * 16; const size_t off = (size_t)row * DM + col0; float ssl = 0.f, mxl = 0.f;
#pragma unroll
                for (int bj = 0; bj < 2; ++bj) {
                    pg8::u32x2 w[2];
#pragma unroll
                    for (int n = 0; n < 2; ++n) { const f32x4 v = xin[m][bj][n] + acc[ai][bj][m][n]; if (!FIN) *(GAS f32x4*)((GAS unsigned char*)Xn + (ob + ai * os_ai + m * os_m + bj * os_bj + n * os_n)) = v;
                        if (!LAST) { w[n].x = pg8::cvt_pk_bf16(v[0], v[1]); w[n].y = pg8::cvt_pk_bf16(v[2], v[3]); ssl += (v[0] * v[0] + v[1] * v[1]) + (v[2] * v[2] + v[3] * v[3]); mxl = fmaxf(fmaxf(mxl, fmaxf(fabsf(v[0]), fabsf(v[1]))), fmaxf(fabsf(v[2]), fabsf(v[3]))); } }
                    if (!LAST) {
                        auto r0 = __builtin_amdgcn_permlane16_swap(w[0].x, w[1].x, false, false); auto r1 = __builtin_amdgcn_permlane16_swap(w[0].y, w[1].y, false, false);
                        pg8::u32x4 w4; w4.x = r0[0]; w4.y = r1[0]; w4.z = r0[1]; w4.w = r1[1];
                        const int cx = (fq & 1) ? 16 + 4 * (fq - 1) - 4 * fq : 0;
                        *(pg8::u32x4*)(XBn + off + bj * 128 + cx) = w4; }
                }
                if (!LAST && stats) { ssl += __shfl_xor(ssl, 16); ssl += __shfl_xor(ssl, 32); mxl = fmaxf(mxl, __shfl_xor(mxl, 16)); mxl = fmaxf(mxl, __shfl_xor(mxl, 32));
                    if (fq == 0) { atomic_addf(ssx + row, ssl); if (!FIN) atomicMax(rmx + row, __float_as_uint(mxl)); } }
            }
            asm volatile("" ::: "memory");
        }
    }
};

__device__ __forceinline__ float dot8(const v4u kv, const LAS float* q) {
    const f32x4 q0 = *(const LAS f32x4*)q, q1 = *(const LAS f32x4*)(q + 4);
    return pg8::bf_lo(kv.x) * q0[0] + pg8::bf_hi(kv.x) * q0[1] + pg8::bf_lo(kv.y) * q0[2] + pg8::bf_hi(kv.y) * q0[3]
         + pg8::bf_lo(kv.z) * q1[0] + pg8::bf_hi(kv.z) * q1[1] + pg8::bf_lo(kv.w) * q1[2] + pg8::bf_hi(kv.w) * q1[3];
}
template <int MODE>
__device__ __forceinline__ void naive_attn_task(Frame& F, const Args& A, int layer, int row, int head, LAS float* wscr) {
    const int lane = F.lane;
    constexpr int DQK = (MODE == 1) ? 192 : 128;
    const bf16 *qp, *kb, *vb, *gatep; bf16* outp; int kpitch, vpitch;
    if (MODE == 0) { qp = F.P + (size_t)row * PP + C_QA + head * 128; kb = F.P + C_KA + (head >> 2) * 128; vb = F.P + C_VA + (head >> 2) * 128; kpitch = PP; vpitch = PP;
        gatep = F.P + (size_t)row * PP + C_ZA + head * 128; outp = F.Y + (size_t)row * YW + head * 128; }
    else if (MODE == 1) { qp = F.QM + (size_t)row * 768 + head * 192; kb = F.KVM + head * 256; vb = F.KVM + head * 256 + 128; kpitch = 1024; vpitch = 1024;
        gatep = F.P + (size_t)row * PP + C_ZB + head * 128; outp = F.Y + (size_t)row * YW + 1024 + head * 128; }
    else { qp = F.P + (size_t)row * PP + C_QC + head * 128; kb = F.P + C_KC + head * 128; vb = F.P + C_VC + head * 128; kpitch = PP; vpitch = PP;
        gatep = F.P + (size_t)row * PP + C_ZC + head * 128; outp = F.Y + (size_t)row * YW + 1536 + head * 128; }
    LAS float* qs = wscr; LAS float* ps = wscr + 192;
    for (int i = lane; i < DQK; i += 64) qs[i] = bf2f(qp[i]);
    LDS_WAIT(); asm volatile("" ::: "memory");
    float o0 = 0.f, o1 = 0.f, mrun = -1e30f, lrun = 0.f, carry = 0.f;
    int klo, khi;
    if (MODE == 0) { klo = row - 127 > 0 ? row - 127 : 0; khi = row; } else if (MODE == 1) { klo = 0; khi = row; } else { klo = 0; khi = row - 1; }
    if (khi >= klo) {
        const int cfirst = klo & ~63, clast = khi & ~63;
        const int nchunk = (clast - cfirst) / 64 + 1;
        for (int ci = 0; ci < nchunk; ++ci) {
            const int c0 = (MODE == 2) ? clast - 64 * ci : cfirst + 64 * ci;
            const int s = c0 + lane; const bool valid = (s >= klo) && (s <= khi);
            const int sl = s > khi ? khi : (s < klo ? klo : s);
            const bf16* kp = kb + (size_t)sl * kpitch;
            float d = 0.f;
#pragma unroll
            for (int c = 0; c < 16; ++c) d += dot8(*(const GAS v4u*)(kp + 8 * c), qs + 8 * c);
            if (MODE == 1) { const bf16* krp = F.KRM + (size_t)sl * 64;
#pragma unroll
                for (int c = 0; c < 8; ++c) d += dot8(*(const GAS v4u*)(krp + 8 * c), qs + 128 + 8 * c); }
            float p;
            if (MODE == 2) {
                const float z = d;
                const float lk = -(fmaxf(z, 0.f) + __builtin_amdgcn_logf(1.0f + __builtin_amdgcn_exp2f(-fabsf(z))));
                float incl = valid ? lk : 0.f;
#pragma unroll
                for (int off = 1; off < 64; off <<= 1) { const float t = __shfl_down(incl, off); if (lane + off < 64) incl += t; }
                float excl = __shfl_down(incl, 1); if (lane == 63) excl = 0.f;
                const float tot = __shfl(incl, 0);
                p = valid ? __builtin_amdgcn_exp2f(z + lk + excl + carry) : 0.f;
                carry += tot;
            } else {
                float sc = d;
                if (MODE == 0) sc += A.rel_bias[(int)T5B[(row - sl) & 127] * 8 + head] * LOG2E;
                sc = valid ? sc : -__builtin_inff();
                const float mn = fmaxf(mrun, wave_max(sc));
                const float alpha = __builtin_amdgcn_exp2f(mrun - mn);
                p = __builtin_amdgcn_exp2f(sc - mn);
                lrun = lrun * alpha + wave_sum(p); o0 *= alpha; o1 *= alpha; mrun = mn;
            }
            ps[lane] = p;
            LDS_WAIT(); asm volatile("" ::: "memory");
            for (int j = 0; j < 64; ++j) {
                int sj = c0 + j; sj = sj > khi ? khi : (sj < klo ? klo : sj);
                const float pj = ps[j];
                const unsigned vv = *(const GAS unsigned*)(vb + (size_t)sj * vpitch + 2 * lane);
                o0 += pj * pg8::bf_lo(vv); o1 += pj * pg8::bf_hi(vv);
            }
            LDS_WAIT(); asm volatile("" ::: "memory");
        }
    }
    if (MODE == 0) { const float sk = A.sinks[layer * 8 + head] * LOG2E; const float mf = fmaxf(mrun, sk); const float a = __builtin_amdgcn_exp2f(mrun - mf);
        const float lf = lrun * a + __builtin_amdgcn_exp2f(sk - mf); const float inv = a / lf; o0 *= inv; o1 *= inv; }
    if (MODE == 1) { const float inv = 1.0f / lrun; o0 *= inv; o1 *= inv; }
    const unsigned gv = *(const GAS unsigned*)(gatep + 2 * lane);
    *(GAS unsigned*)(outp + 2 * lane) = pk2(o0 * pg8::bf_lo(gv), o1 * pg8::bf_hi(gv));
}
__device__ __forceinline__ void naive_attn_phase(Frame& F, const Args& A, int layer) {
    LAS float* wscr = (LAS float*)(F.lds + RING_OFF + F.wave * 2048);
    if (!(ATTN_MFMA_MASK & 2)) for (int t = F.gw; t < S * 4; t += F.NGW) naive_attn_task<1>(F, A, layer, t >> 2, t & 3, wscr);
    if (!(ATTN_MFMA_MASK & 4)) for (int t = F.gw; t < S * 4; t += F.NGW) naive_attn_task<2>(F, A, layer, t >> 2, t & 3, wscr);
    if (!(ATTN_MFMA_MASK & 1)) for (int t = F.gw; t < S * 8; t += F.NGW) naive_attn_task<0>(F, A, layer, t >> 3, t & 7, wscr);
}


namespace att {
typedef short s16x4 __attribute__((ext_vector_type(4)));
typedef float f32x16 __attribute__((ext_vector_type(16)));
constexpr int SHM_T = 16384, OFF_V = 0  , OFF_K = 3 * SHM_T  , OFF_KR = 5 * SHM_T, OFF_WS = 5 * SHM_T + 2 * 8192, OFF_FLAG = OFF_WS + 8 * 256, OFF_LUT = OFF_FLAG + 64, LDS_END = OFF_LUT + 512;
static_assert(LDS_END <= RING_BYTES, "attention LDS");
#define KSWZ(row, colB) ((row) * 256 + ((colB) ^ (((row) & 15) << 4)))
#define KRSWZ(row, chunk) ((row) * 128 + ((((chunk) ^ ((row) >> 1)) & 7) << 4))
__device__ __forceinline__ int v_st(int k, int c) { const int kk = (k & ~0xC) | ((k & 4) << 1) | ((k & 8) >> 1); return ((kk >> 3) * 4 + (c >> 5)) * 512 + ((kk & 7) * 32 + (c & 31)) * 2; }
__device__ __forceinline__ int v_rd_base(int lane) { return ((lane & 3) << 3) | (((lane >> 2) & 3) << 6) | (((lane >> 4) & 1) << 5) | (((lane >> 5) & 1) << 8); }
constexpr int v_rd_off(int d0, int ks, int half) { return d0 * 512 + ks * 4096 + half * 2048; }
__device__ __forceinline__ int crow(int r, int hi) { return (r & 3) + 8 * (r >> 2) + 4 * hi; }
__device__ __forceinline__ unsigned cvtpk(float lo, float hi) { unsigned r; asm volatile("v_cvt_pk_bf16_f32 %0, %1, %2" : "=v"(r) : "v"(lo), "v"(hi)); return r; }
__device__ __forceinline__ void glds16(const void* gsrc, unsigned lds_dst) { unsigned keep;
    asm volatile("s_mov_b32 %0, m0\n\ts_mov_b32 m0, %2\n\ts_nop 0\n\tglobal_load_lds_dwordx4 %1, off\n\ts_mov_b32 m0, %0" : "=&s"(keep) : "v"(gsrc), "s"(lds_dst) : "memory"); }
__device__ __forceinline__ void glds16s(const char* sbase, unsigned voff, unsigned lds_dst) { unsigned keep;
    asm volatile("s_mov_b32 %0, m0\n\ts_mov_b32 m0, %3\n\ts_nop 0\n\tglobal_load_lds_dwordx4 %1, %2\n\ts_mov_b32 m0, %0" : "=&s"(keep) : "v"(voff), "s"(sbase), "s"(lds_dst) : "memory"); }
__device__ __forceinline__ const char* uni_ptr(const void* p) { const unsigned long long v = (unsigned long long)(uintptr_t)p;
    const unsigned lo = __builtin_amdgcn_readfirstlane((unsigned)v), hi_ = __builtin_amdgcn_readfirstlane((unsigned)(v >> 32)); return (const char*)(uintptr_t)(((unsigned long long)hi_ << 32) | lo); }
#define ATT_PK4(P, B_, OUT) do { unsigned a0 = cvtpk(P[B_+0], P[B_+1]), a1 = cvtpk(P[B_+2], P[B_+3]);                          \
        unsigned b0 = cvtpk(P[B_+4], P[B_+5]), b1 = cvtpk(P[B_+6], P[B_+7]);                                             \
        auto r0 = __builtin_amdgcn_permlane32_swap(a0, b0, false, false); auto r1 = __builtin_amdgcn_permlane32_swap(a1, b1, false, false); \
        v4u w_ = {r0[0], r1[0], r0[1], r1[1]}; OUT = __builtin_bit_cast(bf16x8, w_); } while (0)

template <int MODE>
__device__ __forceinline__ void attn_unit(LAS unsigned char* L, const bf16* __restrict__ Qp, int qpitch, const bf16* __restrict__ Kp, const bf16* __restrict__ Vp, int kvpitch,
                                          const bf16* __restrict__ KRp, const bf16* __restrict__ Gp, bf16* __restrict__ Op, int P0, float sink2, const float* __restrict__ biasp,
                                          int jlo_ovr, int jhi_ovr, float* __restrict__ Opart, float* __restrict__ MLp,
                                          gu32* cnt = nullptr, int nparts = 0, const float* Opart0 = nullptr, const float* ML0 = nullptr, volatile LAS unsigned* bflag = nullptr) {
    constexpr int NQ = (MODE == 1) ? 12 : 8;
    constexpr float THR = 8.f, NEG = -__builtin_inff();
    int tid = threadIdx.x; asm volatile("" : "+v"(tid));
    const int wid = __builtin_amdgcn_readfirstlane(tid >> 6), lane = tid & 63, r32 = lane & 31, hi = lane >> 5;
    int j_lo = 0, j_hi = P0 / 64 + 4;
    if (MODE == 0) j_lo = P0 >= 128 ? P0 / 64 - 2 : 0;
    if (MODE == 1) { j_lo = jlo_ovr; j_hi = jhi_ovr; }
    const int NT = j_hi - j_lo;
    const int qlo = P0 + wid * 32, qpos = qlo + r32;
    unsigned ko[2], vo[2];
    const char* const Kb0 = uni_ptr(Kp); const char* const Rb0 = uni_ptr(KRp);
    const unsigned vdiff = (unsigned)__builtin_amdgcn_readfirstlane((int)((const char*)Vp - (const char*)Kp));
#pragma unroll
    for (int i = 0; i < 2; ++i) { const int p = wid * 128 + i * 64 + lane;
        { const int row = p >> 4, phys = p & 15; ko[i] = (unsigned)(row * kvpitch + ((phys ^ (row & 15)) << 3)) * 2u; }
        { const int s = p >> 5, q = p & 31, kk = (s >> 2) * 8 + (q >> 2); const int vr = (kk & ~0xC) | ((kk & 4) << 1) | ((kk & 8) >> 1); vo[i] = (unsigned)(vr * kvpitch + (s & 3) * 32 + (q & 3) * 8) * 2u + vdiff; } }
    const int rp = wid * 64 + lane; const unsigned ro = (unsigned)((rp >> 3) * 64 + (((rp & 7) ^ ((rp >> 4) & 7)) << 3)) * 2u;
    const unsigned ldsK = (unsigned)(uintptr_t)(L + OFF_K) + (unsigned)wid * 2048u, ldsV = (unsigned)(uintptr_t)(L + OFF_V) + (unsigned)wid * 2048u, ldsR = (unsigned)(uintptr_t)(L + OFF_KR) + (unsigned)wid * 1024u;
    const unsigned XK = (unsigned)(r32 * 256 + ((hi ^ (r32 & 15)) << 4)), XR = (unsigned)(r32 * 128 + (((hi ^ (r32 >> 1)) & 7) << 4));
    LAS float* wsf = (LAS float*)(L + OFF_WS + wid * 256); LAS float* li_l = wsf; LAS float* al_l = wsf + 32;
    volatile LAS unsigned* flags = (volatile LAS unsigned*)(L + OFF_FLAG);
    LAS float* blut = (LAS float*)(L + OFF_LUT);
    float blv = 0.f; if (MODE == 0) { if (tid < 128) blv = biasp[tid]; }
    bf16x8 qr[NQ];
#pragma unroll
    for (int d0 = 0; d0 < NQ; ++d0) qr[d0] = *(const GAS bf16x8*)(Qp + (size_t)(wid * 32 + r32) * qpitch + d0 * 16 + hi * 8);
#define ATT_TILE(t) ((MODE == 2) ? (j_hi - 1 - (t)) : (j_lo + (t)))
#define ATT_DMA(jt, bf, vbf) do { const char* kb_ = Kb0 + (size_t)(jt) * 128 * (size_t)kvpitch; \
        glds16s(kb_, ko[0], (unsigned)__builtin_amdgcn_readfirstlane(ldsK + (bf) * SHM_T)); \
        glds16s(kb_, ko[1], (unsigned)__builtin_amdgcn_readfirstlane(ldsK + (bf) * SHM_T + 1024)); \
        glds16s(kb_, vo[0], (unsigned)__builtin_amdgcn_readfirstlane(ldsV + (vbf) * SHM_T)); \
        glds16s(kb_, vo[1], (unsigned)__builtin_amdgcn_readfirstlane(ldsV + (vbf) * SHM_T + 1024)); \
        if (MODE == 1) glds16s(Rb0 + (size_t)(jt) * 8192, ro, (unsigned)__builtin_amdgcn_readfirstlane(ldsR + (bf) * 8192)); } while (0)
    float m_reg = -1e30f, l_reg = 0.f, carry = 0.f;
    f32x16 o[4];
#pragma unroll
    for (int d = 0; d < 4; ++d)
#pragma unroll
        for (int r = 0; r < 16; ++r) o[d][r] = 0.f;
    ATT_DMA(ATT_TILE(0), 0, 0); if (MODE == 0) { if (tid < 128) blut[tid] = blv; } VM_WAIT();
#pragma unroll
    for (int d0 = 0; d0 < NQ; ++d0) asm volatile("" : "+v"(qr[d0]));
    __syncthreads();
    const unsigned vbase = (unsigned)(uintptr_t)(L + OFF_V) + (unsigned)v_rd_base(lane);
    const bool lag = (wid >= 4);
    bool pend = false; int vcur = 0, vprev = 0;
    bf16x8 pa0, pa1, pa2, pa3;
#define ATT_TRRD(dst, off) asm volatile("ds_read_b64_tr_b16 %0, %1 offset:%2" : "=&v"(dst) : "v"(vb0), "i"(off) : "memory")
#define ATT_PV(d0) do { s16x4 l0, l1, l2, l3, h0, h1, h2, h3; constexpr int b_ = v_rd_off(d0, 0, 0); \
        ATT_TRRD(l0, b_); ATT_TRRD(h0, b_ + 2048); ATT_TRRD(l1, b_ + 4096); ATT_TRRD(h1, b_ + 6144); ATT_TRRD(l2, b_ + 8192); ATT_TRRD(h2, b_ + 10240); ATT_TRRD(l3, b_ + 12288); ATT_TRRD(h3, b_ + 14336); \
        asm volatile("s_waitcnt lgkmcnt(0)" ::: "memory"); __builtin_amdgcn_sched_barrier(0); \
        o[d0] = __builtin_amdgcn_mfma_f32_32x32x16_bf16((bf16x8){l0[0], l0[1], l0[2], l0[3], h0[0], h0[1], h0[2], h0[3]}, pa0, o[d0], 0, 0, 0); \
        o[d0] = __builtin_amdgcn_mfma_f32_32x32x16_bf16((bf16x8){l1[0], l1[1], l1[2], l1[3], h1[0], h1[1], h1[2], h1[3]}, pa1, o[d0], 0, 0, 0); \
        o[d0] = __builtin_amdgcn_mfma_f32_32x32x16_bf16((bf16x8){l2[0], l2[1], l2[2], l2[3], h2[0], h2[1], h2[2], h2[3]}, pa2, o[d0], 0, 0, 0); \
        o[d0] = __builtin_amdgcn_mfma_f32_32x32x16_bf16((bf16x8){l3[0], l3[1], l3[2], l3[3], h3[0], h3[1], h3[2], h3[3]}, pa3, o[d0], 0, 0, 0); } while (0)
#define ATT_PV_ALL(vbuf) do { const unsigned vb0 = vbase + (unsigned)((vbuf) * SHM_T); __builtin_amdgcn_s_setprio(1); ATT_PV(0); ATT_PV(1); ATT_PV(2); ATT_PV(3); __builtin_amdgcn_s_setprio(0); } while (0)
    for (int t = 0; t < NT; ++t) {
        const int cur = t & 1, jt = ATT_TILE(t), kb = jt * 64;
        const bool more = (t + 1 < NT);
        vprev = vcur; vcur = t % 3;
        if (more) ATT_DMA(ATT_TILE(t + 1), cur ^ 1, (t + 1) % 3);
        if (lag && pend) { ATT_PV_ALL(vprev); pend = false; }
        bool act;
        if (MODE == 0) act = (kb <= qlo + 31) && (kb + 63 >= qlo - 127);
        else if (MODE == 1) act = (kb <= qlo + 31);
        else act = (kb < qlo + 31) && !__all(carry < -150.f);
        if (act) {
            f32x16 p0, p1;
#pragma unroll
            for (int r = 0; r < 16; ++r) { p0[r] = 0.f; p1[r] = 0.f; }
            {
                unsigned xk = XK, xr = XR; asm volatile("" : "+v"(xk), "+v"(xr));
                const unsigned kbs = (unsigned)(uintptr_t)(L + OFF_K) + (unsigned)cur * SHM_T, rbs = (unsigned)(uintptr_t)(L + OFF_KR) + (unsigned)cur * 8192u;
                bf16x8 f0, f1, f2, f3;
#define ATT_KRD(dst, addr, off) asm volatile("ds_read_b128 %0, %1 offset:%2" : "=&v"(dst) : "v"(addr), "i"(off) : "memory")
#define ATT_KISSUE(s_, A_, B_) do { if ((s_) < 8) { const unsigned a_ = (xk ^ ((unsigned)(s_) << 5)) + kbs; ATT_KRD(A_, a_, 0); ATT_KRD(B_, a_, 8192); } \
                                    else { const unsigned a_ = (xr ^ ((unsigned)((s_) - 8) << 5)) + rbs; ATT_KRD(A_, a_, 0); ATT_KRD(B_, a_, 4096); } } while (0)
                ATT_KISSUE(0, f0, f1); ATT_KISSUE(1, f2, f3);
                __builtin_amdgcn_s_setprio(1);
#pragma unroll
                for (int s = 0; s < NQ; s += 2) {
                    if (s + 1 < NQ) asm volatile("s_waitcnt lgkmcnt(2)" ::: "memory"); else asm volatile("s_waitcnt lgkmcnt(0)" ::: "memory");
                    __builtin_amdgcn_sched_barrier(0);
                    p0 = __builtin_amdgcn_mfma_f32_32x32x16_bf16(f0, qr[s], p0, 0, 0, 0); p1 = __builtin_amdgcn_mfma_f32_32x32x16_bf16(f1, qr[s], p1, 0, 0, 0);
                    __builtin_amdgcn_sched_barrier(0);
                    if (s + 2 < NQ) ATT_KISSUE(s + 2, f0, f1);
                    if (s + 2 < NQ) asm volatile("s_waitcnt lgkmcnt(2)" ::: "memory"); else asm volatile("s_waitcnt lgkmcnt(0)" ::: "memory");
                    __builtin_amdgcn_sched_barrier(0);
                    p0 = __builtin_amdgcn_mfma_f32_32x32x16_bf16(f2, qr[s + 1], p0, 0, 0, 0); p1 = __builtin_amdgcn_mfma_f32_32x32x16_bf16(f3, qr[s + 1], p1, 0, 0, 0);
                    __builtin_amdgcn_sched_barrier(0);
                    if (s + 3 < NQ) ATT_KISSUE(s + 3, f2, f3);
                }
                __builtin_amdgcn_s_setprio(0);
#undef ATT_KISSUE
#undef ATT_KRD
            }
            const int dq = qpos - kb - 4 * hi;
            if (MODE != 2) {
                if (MODE == 0) {
#pragma unroll
                    for (int r = 0; r < 16; ++r) { const int c = (r & 3) + 8 * (r >> 2); const int e0 = dq - c, e1 = dq - c - 32;
                        const float b0 = blut[e0 < 0 ? 0 : (e0 > 127 ? 127 : e0)], b1 = blut[e1 < 0 ? 0 : (e1 > 127 ? 127 : e1)];
                        p0[r] = ((unsigned)e0 < 128u) ? p0[r] + b0 : NEG; p1[r] = ((unsigned)e1 < 128u) ? p1[r] + b1 : NEG; }
                } else {
                    if (kb + 63 > qlo) {
#pragma unroll
                        for (int r = 0; r < 16; ++r) { const int c = (r & 3) + 8 * (r >> 2); if (dq - c < 0) p0[r] = NEG; if (dq - c - 32 < 0) p1[r] = NEG; }
                    }
                }
                float pmax = p0[0];
#pragma unroll
                for (int r = 1; r < 16; ++r) pmax = fmaxf(pmax, p0[r]);
#pragma unroll
                for (int r = 0; r < 16; ++r) pmax = fmaxf(pmax, p1[r]);
                { auto rr = __builtin_amdgcn_permlane32_swap(__float_as_uint(pmax), __float_as_uint(pmax), false, false); pmax = fmaxf(__uint_as_float(rr[0]), __uint_as_float(rr[1])); }
                float mn, alpha;
                if (__all(pmax - m_reg <= THR)) { mn = m_reg; alpha = 1.f; }
                else { mn = fmaxf(m_reg, pmax); alpha = __builtin_amdgcn_exp2f(m_reg - mn); m_reg = mn; }
                float ps = 0.f;
#pragma unroll
                for (int r = 0; r < 16; ++r) { p0[r] = __builtin_amdgcn_exp2f(p0[r] - mn); p1[r] = __builtin_amdgcn_exp2f(p1[r] - mn); ps += p0[r] + p1[r]; }
                { auto rr = __builtin_amdgcn_permlane32_swap(__float_as_uint(ps), __float_as_uint(ps), false, false); ps = __uint_as_float(rr[0]) + __uint_as_float(rr[1]); }
                l_reg = l_reg * alpha + ps;
                if (__any(alpha < 1.f)) {
#pragma unroll
                    for (int r = 0; r < 16; ++r)
#pragma unroll
                        for (int d = 0; d < 4; ++d) o[d][r] *= alpha;
                }
            } else {
                float T[8];
#pragma unroll
                for (int i = 0; i < 8; ++i) {
                    float x[4], zz[4];
#pragma unroll
                    for (int a = 0; a < 4; ++a) { const int r = (i & 3) * 4 + a; const float z = (i < 4) ? p0[r] : p1[r]; const int c = (r & 3) + 8 * (r >> 2) + ((i < 4) ? 0 : 32);
                        const bool past = (dq - c) > 0;
                        const float lk = -(fmaxf(z, 0.f) + __builtin_amdgcn_logf(1.0f + __builtin_amdgcn_exp2f(-fabsf(z))));
                        x[a] = past ? lk : 0.f; zz[a] = past ? (z + lk) : NEG; }
                    const float e2 = x[3], e1 = x[3] + x[2], e0 = e1 + x[1];
                    T[i] = e0 + x[0];
                    if (i < 4) { p0[(i & 3) * 4 + 0] = zz[0] + e0; p0[(i & 3) * 4 + 1] = zz[1] + e1; p0[(i & 3) * 4 + 2] = zz[2] + e2; p0[(i & 3) * 4 + 3] = zz[3]; }
                    else       { p1[(i & 3) * 4 + 0] = zz[0] + e0; p1[(i & 3) * 4 + 1] = zz[1] + e1; p1[(i & 3) * 4 + 2] = zz[2] + e2; p1[(i & 3) * 4 + 3] = zz[3]; }
                }
                float U[8], PT[8];
#pragma unroll
                for (int i = 0; i < 8; ++i) { auto rr = __builtin_amdgcn_permlane32_swap(__float_as_uint(T[i]), __float_as_uint(T[i]), false, false);
                    const float tlo = __uint_as_float(rr[0]), thi = __uint_as_float(rr[1]); U[i] = tlo + thi; PT[i] = hi ? 0.f : thi; }
                float su = carry;
#pragma unroll
                for (int i = 7; i >= 0; --i) {
                    const float A = su + PT[i];
#pragma unroll
                    for (int a = 0; a < 4; ++a) { const int r = (i & 3) * 4 + a; if (i < 4) p0[r] = __builtin_amdgcn_exp2f(p0[r] + A); else p1[r] = __builtin_amdgcn_exp2f(p1[r] + A); }
                    su += U[i];
                }
                carry = su;
            }
            ATT_PK4(p0, 0, pa0); ATT_PK4(p0, 8, pa1); ATT_PK4(p1, 0, pa2); ATT_PK4(p1, 8, pa3);
            if (lag) pend = true; else ATT_PV_ALL(vcur);
        }
        VM_WAIT();
        if (MODE == 2) { if (lane == 0) flags[cur * 8 + wid] = __all(carry < -150.f) ? 1u : 0u; }
        __syncthreads();
        if (MODE == 2) { bool alld = true;
#pragma unroll
            for (int w = 0; w < 8; ++w) alld = alld && (flags[cur * 8 + w] != 0u);
            if (alld) break; }
    }
    if (pend) { ATT_PV_ALL(vcur); }
#undef ATT_PV_ALL
#undef ATT_PV
#undef ATT_TRRD
    const int orow = wid * 32 + r32;
    const GAS unsigned char* const Gub = (const GAS unsigned char*)uni_ptr(Gp); GAS unsigned char* const Oub = (GAS unsigned char*)uni_ptr(Op);
    const unsigned goff = (unsigned)(orow * PP + 8 * hi) * 2u, yoff = (unsigned)(orow * YW + 8 * hi) * 2u;
    auto fin_d0 = [&](const int d0, const f32x16& val, const float inv, const v4u g0, const v4u g1) __attribute__((always_inline)) {
#pragma unroll
        for (int pr = 0; pr < 2; ++pr) { float x[8];
#pragma unroll
            for (int i = 0; i < 4; ++i) { auto rr = __builtin_amdgcn_permlane32_swap(__float_as_uint(val[8 * pr + i] * inv), __float_as_uint(val[8 * pr + 4 + i] * inv), false, false);
                x[i] = __uint_as_float(rr[0]); x[4 + i] = __uint_as_float(rr[1]); }
            const v4u g = pr ? g1 : g0; v4u w;
            w.x = cvtpk(x[0] * pg8::bf_lo(g.x), x[1] * pg8::bf_hi(g.x)); w.y = cvtpk(x[2] * pg8::bf_lo(g.y), x[3] * pg8::bf_hi(g.y));
            w.z = cvtpk(x[4] * pg8::bf_lo(g.z), x[5] * pg8::bf_hi(g.z)); w.w = cvtpk(x[6] * pg8::bf_lo(g.w), x[7] * pg8::bf_hi(g.w));
            *(GAS v4u*)(Oub + (yoff + (unsigned)(d0 * 32 + 16 * pr) * 2u)) = w; }
    };
    auto finish = [&](const float inv) __attribute__((always_inline)) {
        v4u gw[4][2];
#pragma unroll
        for (int d0 = 0; d0 < 4; ++d0)
#pragma unroll
            for (int pr = 0; pr < 2; ++pr) gw[d0][pr] = *(const GAS v4u*)(Gub + (goff + (unsigned)(d0 * 32 + 16 * pr) * 2u));
#pragma unroll
        for (int d0 = 0; d0 < 4; ++d0) fin_d0(d0, o[d0], inv, gw[d0][0], gw[d0][1]);
    };
    const unsigned slot16 = (unsigned)(wid * 64 + lane) * 16u;
    if (MODE == 1) {
        const char* const Pub = uni_ptr(Opart);
#pragma unroll
        for (int d0 = 0; d0 < 4; ++d0)
#pragma unroll
            for (int g = 0; g < 4; ++g) { const f32x4 v = {o[d0][4 * g], o[d0][4 * g + 1], o[d0][4 * g + 2], o[d0][4 * g + 3]};
                asm volatile("global_store_dwordx4 %0, %1, %2 sc1" :: "v"(slot16 + (unsigned)(d0 * 4 + g) * 8192u), "v"(v), "s"(Pub) : "memory"); }
        if (hi == 0) { __hip_atomic_store((GAS unsigned long long*)(MLp + (size_t)orow * 2), ((unsigned long long)__float_as_uint(l_reg) << 32) | __float_as_uint(m_reg), RLX_AGENT); }
        VM_WAIT();
        __syncthreads();
        if (tid == 0) { const unsigned old = __hip_atomic_fetch_add(cnt, 1u, RLX_AGENT); *bflag = (old + 1u == (unsigned)nparts) ? 1u : 0u; }
        __syncthreads();
        const bool lastp = (*bflag != 0u);
        if (lastp) {
            __builtin_amdgcn_fence(__ATOMIC_ACQUIRE, "agent"); VM_WAIT();
            const GAS unsigned char* const P0ub = (const GAS unsigned char*)uni_ptr(Opart0);
            f32x2 mlv[4]; float wp[4]; float mmx = -1e30f, Ls = 0.f;
#pragma unroll
            for (int p = 0; p < 4; ++p) if (p < nparts) mlv[p] = *(const GAS f32x2*)(ML0 + (size_t)p * 512 + orow * 2);
#pragma unroll
            for (int p = 0; p < 4; ++p) if (p < nparts) mmx = fmaxf(mmx, mlv[p].x);
#pragma unroll
            for (int p = 0; p < 4; ++p) { wp[p] = 0.f; if (p < nparts) { wp[p] = __builtin_amdgcn_exp2f(mlv[p].x - mmx); Ls += wp[p] * mlv[p].y; } }
            const float invL = 1.0f / Ls;
#pragma unroll
            for (int d0 = 0; d0 < 4; ++d0) {
                f32x4 pv[4][4];
#pragma unroll
                for (int g = 0; g < 4; ++g)
#pragma unroll
                    for (int p = 0; p < 4; ++p) if (p < nparts) pv[g][p] = *(const GAS f32x4*)(P0ub + (slot16 + (unsigned)p * 131072u + (unsigned)(d0 * 4 + g) * 8192u));
                const v4u g0 = *(const GAS v4u*)(Gub + (goff + (unsigned)(d0 * 32) * 2u)), g1 = *(const GAS v4u*)(Gub + (goff + (unsigned)(d0 * 32 + 16) * 2u));
                f32x16 mv;
#pragma unroll
                for (int g = 0; g < 4; ++g) { f32x4 acc4 = pv[g][0] * wp[0];
#pragma unroll
                    for (int p = 1; p < 4; ++p) if (p < nparts) acc4 += pv[g][p] * wp[p];
                    mv[4 * g] = acc4[0]; mv[4 * g + 1] = acc4[1]; mv[4 * g + 2] = acc4[2]; mv[4 * g + 3] = acc4[3]; }
                fin_d0(d0, mv, invL, g0, g1);
                asm volatile("" ::: "memory"); __builtin_amdgcn_sched_barrier(0);
            }
        }
        __syncthreads();
        return;
    }
    if (MODE == 2) finish(1.0f);
    else { const float mf = fmaxf(m_reg, sink2); const float a = __builtin_amdgcn_exp2f(m_reg - mf); finish(a / (l_reg * a + __builtin_amdgcn_exp2f(sink2 - mf))); }
    __syncthreads();
#undef ATT_TILE
#undef ATT_DMA
}
}

__device__ __forceinline__ void attn_phase(Frame& F, const Args& A, int layer, int rep) {
    volatile LAS unsigned* MISC = (volatile LAS unsigned*)(F.lds + MISC_OFF);
    gu32* qhead = F.ctl + CW_QUEUE + 64 * (2 * layer + rep);
    unsigned nid = 0u;
    if (threadIdx.x == 0) nid = __hip_atomic_fetch_add(qhead, 1u, RLX_AGENT);
    for (;;) {
        if (threadIdx.x == 0) MISC[16] = nid;
        __syncthreads();
        const unsigned id = MISC[16];
        __syncthreads();
        if (id >= 1408u) break;
        if (threadIdx.x == 0) nid = __hip_atomic_fetch_add(qhead, 1u, RLX_AGENT);
        if (id < 640u && !(ATTN_MFMA_MASK & 2)) continue;
        if (id >= 640u && id < 896u && !(ATTN_MFMA_MASK & 4)) continue;
        if (id >= 896u && !(ATTN_MFMA_MASK & 1)) continue;
        if (id < 640u) {
            int h, qb, p;
            if (id < 384u) { const int idx = (int)(id >> 2); h = (int)(id & 3);
                if (idx < 16) { qb = 16 + idx; p = 0; } else if (idx < 48) { const int k = idx - 16; qb = 32 + (k >> 1); p = k & 1; } else { const int k = idx - 48; qb = 48 + k / 3; p = k % 3; } }
            else { const int jj = (int)id - 384, c = 15 - (jj >> 4), r = jj & 15; h = r & 3; const int g = r >> 2; qb = 16 * g + c; p = g; }
            const int P0 = qb * 256, jlo = 64 * p, jhi_full = 4 * (qb + 1), jhi = (64 * (p + 1) < jhi_full) ? 64 * (p + 1) : jhi_full;
            const size_t slot = (size_t)((h * 64 + qb) * 4 + p);
            const size_t slot0 = (size_t)((h * 64 + qb) * 4);
            att::attn_unit<1>(F.lds + RING_OFF, F.QM + (size_t)P0 * 768 + h * 192, 768, F.KVM + h * 256, F.KVM + h * 256 + 128, 1024, F.KRM,
                              F.P + (size_t)P0 * PP + C_ZB + h * 128, F.Y + (size_t)P0 * YW + 1024 + h * 128, P0, 0.f, nullptr, jlo, jhi, F.OPART + slot * 32768, F.ML + slot * 512,
                              F.ctl + CW_MLACNT + 256 * layer + h * 64 + qb, (qb >> 4) + 1, F.OPART + slot0 * 32768, F.ML + slot0 * 512, MISC + 17); }
        else if (id < 896u) { const int i = (int)id - 640, qb = 63 - (i >> 2), h = i & 3, P0 = qb * 256;
            att::attn_unit<2>(F.lds + RING_OFF, F.P + (size_t)P0 * PP + C_QC + h * 128, PP, F.P + C_KC + h * 128, F.P + C_VC + h * 128, PP, nullptr,
                              F.P + (size_t)P0 * PP + C_ZC + h * 128, F.Y + (size_t)P0 * YW + 1536 + h * 128, P0, 0.f, nullptr, 0, 0, nullptr, nullptr); }
        else { const int i = (int)id - 896, qb = i >> 3, h = i & 7, P0 = qb * 256;
            att::attn_unit<0>(F.lds + RING_OFF, F.P + (size_t)P0 * PP + C_QA + h * 128, PP, F.P + C_KA + (h >> 2) * 128, F.P + C_VA + (h >> 2) * 128, PP, nullptr,
                              F.P + (size_t)P0 * PP + C_ZA + h * 128, F.Y + (size_t)P0 * YW + h * 128, P0, A.sinks[layer * 8 + h] * LOG2E, F.BLUT + h * 128, 0, 0, nullptr, nullptr); }
    }
}
__global__ void __launch_bounds__(NWAVES * 64, 2) hybrid_fwd(Args args) {
    extern __shared__ __attribute__((aligned(16))) unsigned char lds[];
    Frame F;
    F.lds = (LAS unsigned char*)lds;
    volatile LAS unsigned* MISC = (volatile LAS unsigned*)(F.lds + MISC_OFF);
    F.G = gridDim.x; F.NGW = F.G * NWAVES;
    set_ptrs(F, args.ws);
    for (int u = threadIdx.x; u < (LDS_BYTES - LDSCTL_OFF) / 4; u += NWAVES * 64) ((LAS unsigned*)(F.lds + LDSCTL_OFF))[u] = 0u;
    __syncthreads();
    XcdBarrier bar; bar.bar = (unsigned*)(F.ctl + CW_BAR); bar.x = 0; bar.st = nullptr;
    if (!MK_PER_PHASE) bar = xcd_barrier_post((unsigned*)(F.ctl + CW_BAR), MISC + 8);
    const int lo = args.ph_lo, hi = args.ph_hi;
#define IN(k) (lo <= (k) && (k) < hi)
#define SEAM(k) do { if (IN(k) && IN((k) + 1)) xcd_barrier(bar); } while (0)

    { if (IN(0)) { set_ptrs(F, args.ws); p0_prologue(F, args); set_ptrs(F, args.ws); prep_rows<0>(F, args.x, F.XB, F.RS, nullptr, nullptr, F.XQ, F.SA); } }
    SEAM(0);
    { if (IN(1)) { set_ptrs(F, args.ws); p0b_gate_quant(F, args); } }
    SEAM(1);
    for (int l = 0; l < DEPTH; ++l) {
        const int pb = 2 + 6 * l;
        { if (IN(pb) && l > 0) { set_ptrs(F, args.ws); prep_q8(F, F.XB, F.SSQ_X + (l - 1) * S, F.ROWMAX + (l - 1) * S, F.RS, F.SA, F.XQ); } }
        if (l > 0) SEAM(pb);
        { if (IN(pb + 1)) { set_ptrs(F, args.ws);
            { pg8::Gemm g{F.XB, F.Win + (size_t)l * NB * DM, S, NB, DM, DM, DM}; pg8::StaticOrder So; So.init(S, NB, F.G, (int)blockIdx.x);
              EpiInProj E{F.P, F.RS, F.KRM, F.ROPEC, F.ROPES, F.SSQ_Q + l * S, F.SSQ_KV + l * S, true};
              pg8::gemm_phase<EpiInProj, pg8::StaticOrder, true, true>(F.lds + RING_OFF, g, So, E); }
            set_ptrs(F, args.ws);
            { pg8::Gemm g{(const bf16*)F.XQ, (const bf16*)(F.WG8 + (size_t)l * NG * DM), S, NG, DM / 2, DM / 2, DM / 2}; pg8::StaticOrder So; So.init(S, NG, F.G, (int)blockIdx.x);
              EpiGateI8 E{F.P, F.RS, F.SA, F.SB + l * NG, F.SSQ_Q + l * S, F.KRM, F.ROPEC, F.ROPES, F.GT, F.SSQ_KV + l * S};
              pg8::gemm_phase<EpiGateI8, pg8::StaticOrder, true, true>(F.lds + RING_OFF, g, So, E); }
        } }
        SEAM(pb + 1);
        { if (IN(pb + 2)) { set_ptrs(F, args.ws);
            { pg8::Gemm g{F.P + C_CQ, F.Wq + (size_t)l * 768 * 1024, S, 768, 1024, PP, 1024}; pg8::StaticOrder So; So.init(S, 768, F.G, (int)blockIdx.x);
              EpiQUp E{F.QM, F.SSQ_Q + l * S, F.ROPEC, F.ROPES};
              pg8::gemm_phase<EpiQUp, pg8::StaticOrder, true, true>(F.lds + RING_OFF, g, So, E); }
            set_ptrs(F, args.ws);
            { pg8::Gemm g{F.P + C_CKV, F.Wkv + (size_t)l * 1024 * 512, S, 1024, 512, PP, 512}; pg8::StaticOrder So; So.init(S, 1024, F.G, (int)blockIdx.x);
              EpiKvUp E{F.KVM, F.SSQ_KV + l * S};
              pg8::gemm_phase<EpiKvUp, pg8::StaticOrder, true, true>(F.lds + RING_OFF, g, So, E); }
        } }
        SEAM(pb + 2);
        { if (IN(pb + 3)) { set_ptrs(F, args.ws); attn_phase(F, args, l, 0); if (ATTN_MFMA_MASK != 7) { __syncthreads(); naive_attn_phase(F, args, l); } } }
        SEAM(pb + 3);
        { if (IN(pb + 4)) {
            { set_ptrs(F, args.ws); pg8::Gemm g{F.Y, F.Wproj + (size_t)l * DM * YW, S, DM, YW, YW, YW}; pg8::StaticOrder So; So.init(S, DM, F.G, (int)blockIdx.x);
              EpiProjFused E{F.GT, F.MBF, 16, 24}; pg8::gemm_phase<EpiProjFused, pg8::StaticOrder, true, true>(F.lds + RING_OFF, g, So, E); }
        } }
        SEAM(pb + 4);
        { if (IN(pb + 5)) { set_ptrs(F, args.ws);
            pg8::Gemm g{F.MBF, F.Wout + (size_t)l * DM * DM, S, DM, DM, DM, DM}; pg8::StaticOrder So; So.init(S, DM, F.G, (int)blockIdx.x);
            EpiOut E{(l == 0) ? args.x : F.X1, (l == 0) ? F.X1 : args.out, F.XB, F.SSQ_X + l * S, F.ROWMAX + l * S, false, true, l == DEPTH - 1, l > 0, l < DEPTH - 1};
            pg8::gemm_phase<EpiOut, pg8::StaticOrder, true, true>(F.lds + RING_OFF, g, So, E);
        } }
        SEAM(pb + 5);
    }
    if (IN(14)) { set_ptrs(F, args.ws); final_norm(F, F.XB, F.SSQ_X + (DEPTH - 1) * S, args.out, args.final_g); }
#undef IN
#undef SEAM
}

extern "C" void kernel_launch(void* const* d_in, const int* in_sizes, int n_in, void* d_out, int out_size, void* d_ws, size_t ws_size, hipStream_t stream) {
    static int grid = 0;
    if (grid == 0) {
        if (n_in != 14 || in_sizes[0] != S * DM || out_size != S * DM || ws_size < WS_END) { fprintf(stderr, "kernel_launch: unexpected shapes (n_in %d, in0 %d, out %d, ws %zu)\n", n_in, n_in > 0 ? in_sizes[0] : -1, out_size, ws_size); grid = -1; return; }
        int dev = 0, cus = 0, per_cu = 0;
        if (hipGetDevice(&dev) != hipSuccess || hipDeviceGetAttribute(&cus, hipDeviceAttributeMultiprocessorCount, dev) != hipSuccess) { grid = -1; return; }
        if (hipFuncSetAttribute((const void*)hybrid_fwd, hipFuncAttributeMaxDynamicSharedMemorySize, LDS_BYTES) != hipSuccess) { fprintf(stderr, "kernel_launch: hipFuncSetAttribute failed\n"); grid = -1; return; }
        if (hipOccupancyMaxActiveBlocksPerMultiprocessor(&per_cu, (const void*)hybrid_fwd, NWAVES * 64, LDS_BYTES) != hipSuccess || per_cu < 1)
            fprintf(stderr, "kernel_launch: occupancy query reports %d workgroups per CU\n", per_cu);
        (void)hipGetLastError();
        grid = cus;
    }
    if (grid < 0) return;
    if (hipMemsetAsync((char*)d_ws + WS_CTL, 0, CTL_ZERO_BYTES, stream) != hipSuccess) { fprintf(stderr, "kernel_launch: memset failed\n"); return; }
    Args a{};
    a.x = (const float*)d_in[0]; a.norm_g = (const float*)d_in[1]; a.w_in = (const float*)d_in[2]; a.sinks = (const float*)d_in[3]; a.rel_bias = (const float*)d_in[4];
    a.g_q = (const float*)d_in[5]; a.w_q_up = (const float*)d_in[6]; a.g_kv = (const float*)d_in[7]; a.w_kv_up = (const float*)d_in[8];
    a.w_pa = (const float*)d_in[9]; a.w_pb = (const float*)d_in[10]; a.w_pc = (const float*)d_in[11]; a.w_out = (const float*)d_in[12]; a.final_g = (const float*)d_in[13];
    a.out = (float*)d_out; a.ws = (unsigned char*)d_ws;
    constexpr int NPH = 15;
    if (MK_PER_PHASE) {
        for (int p = 0; p < NPH; ++p) { a.ph_lo = p; a.ph_hi = p + 1; hipLaunchKernelGGL(hybrid_fwd, dim3(grid), dim3(NWAVES * 64), LDS_BYTES, stream, a); }
    } else {
        a.ph_lo = 0; a.ph_hi = NPH;
        hipLaunchKernelGGL(hybrid_fwd, dim3(grid), dim3(NWAVES * 64), LDS_BYTES, stream, a);
    }
    const hipError_t le = hipPeekAtLastError();
    if (le != hipSuccess) fprintf(stderr, "kernel_launch: launch failed: %s\n", hipGetErrorName(le));
}
```
